# Optimizing an MI355X kernel written in HIP

```python
import math
import jax, jax.numpy as jnp
from jax import lax
import numpy as np

D_MODEL = 2048
BATCH = 4
SEQ = 2048
DEPTH = 2
DEC_BATCH = 32
DEC_SEQ = 8
PAST_LEN = 16384
PAGE_SIZE = 128

N_EVEN = (DEPTH + 1) // 2
N_ODD = DEPTH // 2
SSM_HEADS = 32
SSM_HEAD_DIM = 64
SSM_INNER = SSM_HEADS * SSM_HEAD_DIM
SSM_GROUPS = 8
SSM_STATE = 128
SSM_CONV = 4
SSM_CHUNK = 128
SSM_CONV_DIM = SSM_INNER + 2 * SSM_GROUPS * SSM_STATE
LRU_WIDTH = D_MODEL
LRU_BLOCKS = 8
LRU_BLOCK = LRU_WIDTH // LRU_BLOCKS
LRU_CONV = 4
LRU_C = 8.0
ATT_HEADS = 32
KV_HEADS = 8
HEAD_DIM = 64
Q_PER_KV = ATT_HEADS // KV_HEADS
WINDOW = 128
ROPE_THETA = 10000.0
QKV_COLS = (ATT_HEADS + 2 * KV_HEADS) * HEAD_DIM
D_FF = 4 * D_MODEL
EPS = 1e-6
HYB_COLS = SSM_INNER + SSM_CONV_DIM + SSM_HEADS + 2 * LRU_WIDTH
HYB_SPLITS = [SSM_INNER, SSM_INNER + SSM_CONV_DIM, SSM_INNER + SSM_CONV_DIM + SSM_HEADS,
              SSM_INNER + SSM_CONV_DIM + SSM_HEADS + LRU_WIDTH]
MIX_HYB = SSM_INNER + LRU_WIDTH

kernel_name = 'hybrid_ssd_rglru_swa_sink_step'


def rmsnorm(x, g):
    xf = x.astype(jnp.float32)
    y = xf * lax.rsqrt(jnp.mean(xf * xf, axis=-1, keepdims=True) + EPS)
    return (y * g.astype(jnp.float32)).astype(x.dtype)


def adaln(c, w_mod, b_mod):
    m = jax.nn.silu(c) @ w_mod + b_mod
    return jnp.split(m[:, None, :], 6, axis=-1)


def causal_dwconv(x, buf, w, b):
    k = w.shape[0]
    l = x.shape[1]
    xp = jnp.concatenate([buf.astype(x.dtype), x], axis=1)
    y = b + xp[:, k - 1:k - 1 + l] * w[k - 1]
    for j in range(k - 1):
        y = y + xp[:, j:j + l] * w[j]
    return y, xp[:, xp.shape[1] - (k - 1):]


def ssd_chunked(x, dt, a, bmat, cmat, h0):
    f32 = jnp.float32
    b, l, nh, p = x.shape
    g, n = bmat.shape[-2:]
    r = nh // g
    q = math.gcd(l, SSM_CHUNK)
    nc = l // q
    xs = (x.astype(f32) * dt[..., None]).reshape(b, nc, q, g, r, p)
    acs = jnp.cumsum((dt * a).reshape(b, nc, q, g, r), axis=2)
    bc = bmat.astype(f32).reshape(b, nc, q, g, n)
    cc = cmat.astype(f32).reshape(b, nc, q, g, n)
    causal = jnp.tril(jnp.ones((q, q), dtype=bool))[:, :, None, None]
    seg = jnp.exp(jnp.where(causal, acs[:, :, :, None] - acs[:, :, None, :], -jnp.inf))
    cb = jnp.einsum('bctgn,bcsgn->bctsg', cc, bc)
    y_diag = jnp.einsum('bctsgr,bcsgrp->bctgrp', cb[..., None] * seg, xs)
    xw = xs * jnp.exp(acs[:, :, -1:] - acs)[..., None]
    chunk_states = jnp.einsum('bcsgn,bcsgrp->bcgrpn', bc, xw)
    chunk_decay = jnp.exp(acs[:, :, -1])

    def step(h, inp):
        st, dec = inp
        return h * dec[..., None, None] + st, h

    h_last, h_in = lax.scan(step, h0.astype(f32).reshape(b, g, r, p, n),
                            (jnp.moveaxis(chunk_states, 1, 0), jnp.moveaxis(chunk_decay, 1, 0)))
    h_in = jnp.moveaxis(h_in, 0, 1)
    y_off = jnp.einsum('bctgn,bcgrpn->bctgrp', cc, h_in) * jnp.exp(acs)[..., None]
    return (y_diag + y_off).reshape(b, l, nh, p), h_last.reshape(b, nh, p, n)


def mamba2_branch(z, xbc, dt_raw, conv_buf, h0, conv_w, conv_b, dt_bias, a_log, d_skip, norm_g):
    f32 = jnp.float32
    b, l, _ = z.shape
    xbc, new_buf = causal_dwconv(xbc, conv_buf, conv_w, conv_b)
    xbc = jax.nn.silu(xbc)
    xs, bm, cm = jnp.split(xbc, [SSM_INNER, SSM_INNER + SSM_GROUPS * SSM_STATE], axis=-1)
    xs = xs.reshape(b, l, SSM_HEADS, SSM_HEAD_DIM)
    bm = bm.reshape(b, l, SSM_GROUPS, SSM_STATE)
    cm = cm.reshape(b, l, SSM_GROUPS, SSM_STATE)
    dt = jax.nn.softplus(dt_raw.astype(f32) + dt_bias.astype(f32))
    a = -jnp.exp(a_log.astype(f32))
    y, h_last = ssd_chunked(xs, dt, a, bm, cm, h0)
    y = (y + xs.astype(f32) * d_skip.astype(f32)[:, None]).reshape(b, l, SSM_INNER)
    y = (y * jax.nn.silu(z.astype(f32))).reshape(b, l, SSM_GROUPS, SSM_INNER // SSM_GROUPS)
    y = y * lax.rsqrt(jnp.mean(y * y, axis=-1, keepdims=True) + EPS)
    y = y.reshape(b, l, SSM_INNER) * norm_g.astype(f32)
    return y.astype(z.dtype), new_buf, h_last.astype(z.dtype)


def rglru_branch(gate_in, xr, conv_buf, h0, conv_w, conv_b, w_a, b_a, w_x, b_x, lam):
    f32 = jnp.float32
    b, l, _ = xr.shape
    xc, new_buf = causal_dwconv(xr, conv_buf, conv_w, conv_b)
    xb = xc.astype(f32).reshape(b, l, LRU_BLOCKS, LRU_BLOCK)
    gate_r = jax.nn.sigmoid(jnp.einsum('blki,kij->blkj', xb, w_a.astype(f32)) + b_a.astype(f32))
    gate_i = jax.nn.sigmoid(jnp.einsum('blki,kij->blkj', xb, w_x.astype(f32)) + b_x.astype(f32))
    log_a = -LRU_C * gate_r * jax.nn.softplus(-lam.astype(f32)).reshape(LRU_BLOCKS, LRU_BLOCK)
    a = jnp.exp(log_a).reshape(b, l, LRU_WIDTH)
    u = (jnp.sqrt(-jnp.expm1(2.0 * log_a)) * gate_i * xb).reshape(b, l, LRU_WIDTH)

    def step(h, inp):
        a_t, u_t = inp
        h = a_t * h + u_t
        return h, h

    h_last, hs = lax.scan(step, h0.astype(f32), (jnp.moveaxis(a, 1, 0), jnp.moveaxis(u, 1, 0)))
    y = jnp.moveaxis(hs, 0, 1) * jax.nn.gelu(gate_in.astype(f32))
    return y.astype(xr.dtype), new_buf, h_last.astype(xr.dtype)


def rope(x, pos):
    half = x.shape[-1] // 2
    inv_freq = ROPE_THETA ** (-jnp.arange(half, dtype=jnp.float32) / half)
    ang = pos.astype(jnp.float32)[:, None] * inv_freq[None, :]
    cos = jnp.cos(ang)[None, :, None, :]
    sin = jnp.sin(ang)[None, :, None, :]
    xf = x.astype(jnp.float32)
    x1, x2 = xf[..., :half], xf[..., half:]
    return jnp.concatenate([x1 * cos - x2 * sin, x2 * cos + x1 * sin], axis=-1).astype(x.dtype)


def sink_attention(q, k, v, q_pos, k_pos, sinks):
    f32 = jnp.float32
    s = jnp.einsum('bnqhrd,bnkhd->bnhrqk', q.astype(f32), k.astype(f32)) * (HEAD_DIM ** -0.5)
    rel = q_pos[:, :, None] - k_pos[:, None, :]
    valid = (rel >= 0) & (rel < WINDOW)
    s = jnp.where(valid[None, :, None, None], s, -jnp.inf)
    sink = jnp.broadcast_to(sinks.astype(f32).reshape(KV_HEADS, Q_PER_KV)[None, None, :, :, None, None],
                            s.shape[:-1] + (1,))
    p = jax.nn.softmax(jnp.concatenate([s, sink], axis=-1), axis=-1)[..., :-1]
    return jnp.einsum('bnhrqk,bnkhd->bnqhrd', p, v.astype(f32))


def prev_block(t):
    return jnp.concatenate([jnp.zeros_like(t[:, :1]), t[:, :-1]], axis=1)


def attention_mixer(h, pos, kv, w_qkv, b_qkv, sinks, w_out):
    b, l, _ = h.shape
    qkv = h @ w_qkv + b_qkv
    q, k, v = jnp.split(qkv, [ATT_HEADS * HEAD_DIM, (ATT_HEADS + KV_HEADS) * HEAD_DIM], axis=-1)
    q = rope(q.reshape(b, l, ATT_HEADS, HEAD_DIM), pos)
    k = rope(k.reshape(b, l, KV_HEADS, HEAD_DIM), pos)
    v = v.reshape(b, l, KV_HEADS, HEAD_DIM)
    if kv is None:
        nb = l // WINDOW
        qb = q.reshape(b, nb, WINDOW, KV_HEADS, Q_PER_KV, HEAD_DIM)
        kb = k.reshape(b, nb, WINDOW, KV_HEADS, HEAD_DIM)
        vb = v.reshape(b, nb, WINDOW, KV_HEADS, HEAD_DIM)
        kb = jnp.concatenate([prev_block(kb), kb], axis=2)
        vb = jnp.concatenate([prev_block(vb), vb], axis=2)
        qpos = pos.reshape(nb, WINDOW)
        kpos = jnp.concatenate([qpos - WINDOW, qpos], axis=1)
        o = sink_attention(qb, kb, vb, qpos, kpos, sinks)
        n_keep = min(WINDOW, l)
        k_new, v_new = k[:, l - n_keep:], v[:, l - n_keep:]
    else:
        k_buf, v_buf = kv
        n_keep = k_buf.shape[1]
        k_all = jnp.concatenate([k_buf.astype(k.dtype), k], axis=1)
        v_all = jnp.concatenate([v_buf.astype(v.dtype), v], axis=1)
        kpos = jnp.concatenate([pos[0] - n_keep + jnp.arange(n_keep, dtype=pos.dtype), pos])
        o = sink_attention(q.reshape(b, 1, l, KV_HEADS, Q_PER_KV, HEAD_DIM), k_all[:, None], v_all[:, None],
                           pos[None], kpos[None], sinks)
        k_new = k_all[:, k_all.shape[1] - n_keep:]
        v_new = v_all[:, v_all.shape[1] - n_keep:]
    o = o.reshape(b, l, ATT_HEADS * HEAD_DIM).astype(h.dtype)
    return o @ w_out, k_new, v_new


def squared_relu_mlp(h, w_up, w_down):
    return jnp.square(jax.nn.relu(h @ w_up)) @ w_down


def run_trunk(x, c, pos, st, pr):
    b = x.shape[0]
    new = ([], [], [], [], [], [])
    for layer in range(DEPTH):
        i = layer // 2
        sh1, sc1, gt1, sh2, sc2, gt2 = adaln(c, pr['w_mod'][layer], pr['b_mod'][layer])
        g = pr['norms'][layer]
        h = rmsnorm(x, g[0]) * (1 + sc1) + sh1
        if layer % 2 == 0:
            if st is None:
                ssm_buf = jnp.zeros((b, SSM_CONV - 1, SSM_CONV_DIM), x.dtype)
                ssm_h = jnp.zeros((b, SSM_HEADS, SSM_HEAD_DIM, SSM_STATE), x.dtype)
                lru_buf = jnp.zeros((b, LRU_CONV - 1, LRU_WIDTH), x.dtype)
                lru_h = jnp.zeros((b, LRU_WIDTH), x.dtype)
            else:
                ssm_buf, ssm_h = st['ssm_conv'][i], st['ssm'][i]
                lru_buf, lru_h = st['lru_conv'][i], st['lru'][i]
            proj = h @ pr['w_in_hyb'][i]
            z, xbc, dt_raw, gate_in, xr = jnp.split(proj, HYB_SPLITS, axis=-1)
            y_ssm, ssm_buf, ssm_h = mamba2_branch(z, xbc, dt_raw, ssm_buf, ssm_h, pr['ssm_conv_w'][i],
                                                  pr['ssm_conv_b'][i], pr['ssm_dt_bias'][i], pr['ssm_a_log'][i],
                                                  pr['ssm_d'][i], pr['ssm_norm'][i])
            y_lru, lru_buf, lru_h = rglru_branch(gate_in, xr, lru_buf, lru_h, pr['lru_conv_w'][i],
                                                 pr['lru_conv_b'][i], pr['lru_w_a'][i], pr['lru_b_a'][i],
                                                 pr['lru_w_x'][i], pr['lru_b_x'][i], pr['lru_lambda'][i])
            mix = jnp.concatenate([y_ssm, y_lru], axis=-1) @ pr['w_out_hyb'][i]
            new[0].append(ssm_buf)
            new[1].append(ssm_h)
            new[2].append(lru_buf)
            new[3].append(lru_h)
        else:
            kv = None if st is None else (st['k'][i], st['v'][i])
            mix, k_new, v_new = attention_mixer(h, pos, kv, pr['w_qkv'][i], pr['b_qkv'][i],
                                                pr['attn_sinks'][i], pr['w_out_attn'][i])
            new[4].append(k_new)
            new[5].append(v_new)
        x = x + gt1 * rmsnorm(mix, g[1])
        h = rmsnorm(x, g[2]) * (1 + sc2) + sh2
        x = x + gt2 * rmsnorm(squared_relu_mlp(h, pr['w_up'][layer], pr['w_down'][layer]), g[3])
    return x, tuple(jnp.stack(v) for v in new)


def setup_inputs(seed: int = 0) -> dict:
    key = jax.random.key(seed)
    ks = iter(jax.random.split(key, 64))
    f32 = jnp.float32

    def nrm(shape, scale):
        return jax.random.normal(next(ks), shape, f32) * scale

    n_win = min(WINDOW, PAST_LEN)
    dt0 = jnp.exp(jax.random.uniform(next(ks), (N_EVEN, SSM_HEADS), f32, math.log(1e-3), math.log(1e-1)))
    dt_bias = dt0 + jnp.log(-jnp.expm1(-dt0))
    a_log = jnp.log(jax.random.uniform(next(ks), (N_EVEN, SSM_HEADS), f32, 1.0, 16.0))
    a0 = jax.random.uniform(next(ks), (N_EVEN, LRU_WIDTH), f32, 0.9, 0.999)
    s0 = a0 ** (1.0 / LRU_C)
    lam = jnp.log(s0) - jnp.log1p(-s0)
    return {
        'x_prompt': nrm((BATCH, SEQ, D_MODEL), 1.0),
        'x_sample': nrm((DEC_BATCH, DEC_SEQ, D_MODEL), 1.0),
        'state_ssm_conv': nrm((N_EVEN, DEC_BATCH, SSM_CONV - 1, SSM_CONV_DIM), 1.0),
        'state_ssm': nrm((N_EVEN, DEC_BATCH, SSM_HEADS, SSM_HEAD_DIM, SSM_STATE), 0.1),
        'state_lru_conv': nrm((N_EVEN, DEC_BATCH, LRU_CONV - 1, LRU_WIDTH), 1.0),
        'state_lru': nrm((N_EVEN, DEC_BATCH, LRU_WIDTH), 0.5),
        'cache_k': nrm((N_ODD, DEC_BATCH, n_win, KV_HEADS, HEAD_DIM), 1.0),
        'cache_v': nrm((N_ODD, DEC_BATCH, n_win, KV_HEADS, HEAD_DIM), 1.0),
        'c_prompt': nrm((BATCH, D_MODEL), 1.0),
        'c_sample': nrm((DEC_BATCH, D_MODEL), 1.0),
        'w_mod': nrm((DEPTH, D_MODEL, 6 * D_MODEL), 0.5 * D_MODEL ** -0.5),
        'b_mod': nrm((DEPTH, 6 * D_MODEL), 0.01),
        'norms': 1.0 + nrm((DEPTH, 4, D_MODEL), 0.05),
        'w_in_hyb': nrm((N_EVEN, D_MODEL, HYB_COLS), D_MODEL ** -0.5),
        'ssm_conv_w': nrm((N_EVEN, SSM_CONV, SSM_CONV_DIM), SSM_CONV ** -0.5),
        'ssm_conv_b': nrm((N_EVEN, SSM_CONV_DIM), 0.01),
        'ssm_dt_bias': dt_bias,
        'ssm_a_log': a_log,
        'ssm_d': 1.0 + nrm((N_EVEN, SSM_HEADS), 0.05),
        'ssm_norm': 1.0 + nrm((N_EVEN, SSM_INNER), 0.05),
        'lru_conv_w': nrm((N_EVEN, LRU_CONV, LRU_WIDTH), LRU_CONV ** -0.5),
        'lru_conv_b': nrm((N_EVEN, LRU_WIDTH), 0.01),
        'lru_w_a': nrm((N_EVEN, LRU_BLOCKS, LRU_BLOCK, LRU_BLOCK), LRU_BLOCK ** -0.5),
        'lru_b_a': nrm((N_EVEN, LRU_BLOCKS, LRU_BLOCK), 0.01),
        'lru_w_x': nrm((N_EVEN, LRU_BLOCKS, LRU_BLOCK, LRU_BLOCK), LRU_BLOCK ** -0.5),
        'lru_b_x': nrm((N_EVEN, LRU_BLOCKS, LRU_BLOCK), 0.01),
        'lru_lambda': lam,
        'w_out_hyb': nrm((N_EVEN, MIX_HYB, D_MODEL), MIX_HYB ** -0.5),
        'w_qkv': nrm((N_ODD, D_MODEL, QKV_COLS), D_MODEL ** -0.5),
        'b_qkv': nrm((N_ODD, QKV_COLS), 0.01),
        'attn_sinks': nrm((N_ODD, ATT_HEADS), 0.5),
        'w_out_attn': nrm((N_ODD, ATT_HEADS * HEAD_DIM, D_MODEL), (ATT_HEADS * HEAD_DIM) ** -0.5),
        'w_up': nrm((DEPTH, D_MODEL, D_FF), D_MODEL ** -0.5),
        'w_down': nrm((DEPTH, D_FF, D_MODEL), D_FF ** -0.5),
    }


def reference(x_prompt, x_sample, state_ssm_conv, state_ssm, state_lru_conv, state_lru, cache_k, cache_v,
              c_prompt, c_sample, w_mod, b_mod, norms, w_in_hyb, ssm_conv_w, ssm_conv_b, ssm_dt_bias,
              ssm_a_log, ssm_d, ssm_norm, lru_conv_w, lru_conv_b, lru_w_a, lru_b_a, lru_w_x, lru_b_x,
              lru_lambda, w_out_hyb, w_qkv, b_qkv, attn_sinks, w_out_attn, w_up, w_down):
    params = {'w_mod': w_mod, 'b_mod': b_mod, 'norms': norms, 'w_in_hyb': w_in_hyb,
              'ssm_conv_w': ssm_conv_w, 'ssm_conv_b': ssm_conv_b, 'ssm_dt_bias': ssm_dt_bias,
              'ssm_a_log': ssm_a_log, 'ssm_d': ssm_d, 'ssm_norm': ssm_norm,
              'lru_conv_w': lru_conv_w, 'lru_conv_b': lru_conv_b, 'lru_w_a': lru_w_a, 'lru_b_a': lru_b_a,
              'lru_w_x': lru_w_x, 'lru_b_x': lru_b_x, 'lru_lambda': lru_lambda, 'w_out_hyb': w_out_hyb,
              'w_qkv': w_qkv, 'b_qkv': b_qkv, 'attn_sinks': attn_sinks, 'w_out_attn': w_out_attn,
              'w_up': w_up, 'w_down': w_down}
    pos_p = jnp.arange(x_prompt.shape[1], dtype=jnp.int32)
    pos_s = PAST_LEN + jnp.arange(x_sample.shape[1], dtype=jnp.int32)
    y_prompt, (p_ssm_conv, p_ssm, p_lru_conv, p_lru, p_k, p_v) = run_trunk(x_prompt, c_prompt, pos_p, None, params)
    states = {'ssm_conv': state_ssm_conv, 'ssm': state_ssm, 'lru_conv': state_lru_conv, 'lru': state_lru,
              'k': cache_k, 'v': cache_v}
    y_sample, (s_ssm_conv, s_ssm, s_lru_conv, s_lru, s_k, s_v) = run_trunk(x_sample, c_sample, pos_s, states, params)
    return (y_prompt, y_sample, p_ssm_conv, p_ssm, p_lru_conv, p_lru, p_k, p_v,
            s_ssm_conv, s_ssm, s_lru_conv, s_lru, s_k, s_v)
```

```cpp
#include <hip/hip_runtime.h>
#include <hip/hip_cooperative_groups.h>
namespace cg = cooperative_groups;

#define LAS __attribute__((address_space(3)))
#define DEV __device__ __forceinline__
typedef unsigned short bf16_t;
typedef short bf16x8 __attribute__((ext_vector_type(8)));
typedef short bf16x4 __attribute__((ext_vector_type(4)));
typedef float f32x2 __attribute__((ext_vector_type(2)));
typedef float f32x4 __attribute__((ext_vector_type(4)));
typedef float f32x16 __attribute__((ext_vector_type(16)));
typedef unsigned u32x2 __attribute__((ext_vector_type(2)));
typedef unsigned u32x4 __attribute__((ext_vector_type(4)));

constexpr int TP = 8192, TS = 256, TT = TP + TS, DM = 2048, NPROJ = 10496, DFF = 8192, NQKV = 3072;
constexpr int PC_XBC = 2048, PC_GATE = 6144, PC_XR = 8192;
constexpr float EPSN = 1e-6f;
constexpr size_t MiB = 1u << 20;
constexpr size_t WS_CDEC = 0, WS_ROPE = 1 * MiB, WS_MOD = 2 * MiB, WS_WIN = 6 * MiB, WS_WOH = 47 * MiB, WS_WQKV = 63 * MiB, WS_WOA = 75 * MiB, WS_WUP = 83 * MiB,
                 WS_WDN = 147 * MiB, WS_WLRU = 211 * MiB, WS_DT = 213 * MiB, WS_H = 215 * MiB, WS_A = 248 * MiB, WS_B = 418 * MiB, WS_YMIX = 550 * MiB, WS_MIX = 616 * MiB;
constexpr size_t WS_X16 = 682 * MiB;
constexpr size_t WS_PART = WS_B, WS_AU_U = WS_B + 66 * MiB, WS_QKV = WS_B, WS_ATTO = WS_B + 50 * MiB, WS_CS = WS_MIX, WS_HIN = WS_H, WS_PROJ = WS_A, WS_UP = WS_A;
constexpr size_t O_YP = 0, O_YS = O_YP + (size_t)4 * 2048 * 2048, O_PSC = O_YS + 32 * 8 * 2048, O_PSSM = O_PSC + 4 * 3 * 4096, O_PLC = O_PSSM + (size_t)4 * 32 * 64 * 128,
                 O_PL = O_PLC + 4 * 3 * 2048, O_PK = O_PL + 4 * 2048, O_PV = O_PK + 4 * 128 * 8 * 64, O_SSC = O_PV + 4 * 128 * 8 * 64, O_SSSM = O_SSC + 32 * 3 * 4096,
                 O_SLC = O_SSSM + (size_t)32 * 32 * 64 * 128, O_SL = O_SLC + 32 * 3 * 2048, O_SK = O_SL + 32 * 2048, O_SV = O_SK + (size_t)32 * 128 * 8 * 64;
constexpr int LDS_BYTES = 147456 + 64;
constexpr size_t WS_BAR = 65536;
constexpr int NTHREADS = 512;

#ifndef DBL
#define DBL -1
#endif
#ifndef TAILS
#define TAILS 1
#endif
#define REP(k) for (int rep_ = 0; rep_ < ((DBL) == (k) ? 2 : 1); ++rep_, __syncthreads())
struct Params { const float* in[34]; float* out; unsigned char* ws; };

DEV unsigned f2bf(float f) { unsigned u = __float_as_uint(f); return (u + 0x7fffu + ((u >> 16) & 1u)) >> 16; }
DEV unsigned pk2(float lo, float hi) { return f2bf(lo) | (f2bf(hi) << 16); }
DEV float bf2f(unsigned short b) { return __uint_as_float(((unsigned)b) << 16); }
DEV float bflo(unsigned w) { return __uint_as_float(w << 16); }
DEV float bfhi(unsigned w) { return __uint_as_float(w & 0xffff0000u); }
DEV float sigm(float x) { return 1.f / (1.f + __expf(-x)); }
DEV float siluf(float x) { return x * sigm(x); }
DEV float softplusf(float x) { return x > 20.f ? x : log1pf(__expf(x)); }
DEV float geluf(float x) { return x * sigm(1.5957691216057308f * (x + 0.044715f * x * x * x)); }
DEV float wave_sum(float v) {
#pragma unroll
    for (int o = 1; o < 64; o <<= 1) v += __shfl_xor(v, o);
    return v;
}
DEV void ld8(const bf16_t* p, float (&v)[8]) {
    const u32x4 w = *(const u32x4*)p;
    v[0] = bflo(w.x); v[1] = bfhi(w.x); v[2] = bflo(w.y); v[3] = bfhi(w.y); v[4] = bflo(w.z); v[5] = bfhi(w.z); v[6] = bflo(w.w); v[7] = bfhi(w.w);
}
DEV void ldf8(const float* p, float (&v)[8]) {
    const f32x4 a = *(const f32x4*)p, b = *(const f32x4*)(p + 4);
    v[0] = a.x; v[1] = a.y; v[2] = a.z; v[3] = a.w; v[4] = b.x; v[5] = b.y; v[6] = b.z; v[7] = b.w;
}
DEV u32x4 pack8(const float (&v)[8]) { u32x4 w; w.x = pk2(v[0], v[1]); w.y = pk2(v[2], v[3]); w.z = pk2(v[4], v[5]); w.w = pk2(v[6], v[7]); return w; }
DEV int rowmap(int reg, int h) { return (reg & 3) + 8 * (reg >> 2) + 4 * h; }
#define LDS_WAIT() asm volatile("s_waitcnt lgkmcnt(0)" ::: "memory")

DEV void conv8(const bf16_t* PROJ, int r, int tl, int pcol, const float* hist, int C, const float (&w)[4][8], const float (&bias)[8], float (&o)[8]) {
#pragma unroll
    for (int e = 0; e < 8; ++e) o[e] = bias[e];
#pragma unroll
    for (int d = 0; d < 4; ++d) {
        float v[8];
        if (tl - d >= 0) ld8(PROJ + (size_t)(r - d) * NPROJ + pcol, v);
        else if (hist) ldf8(hist + (size_t)(3 + tl - d) * C, v);
        else {
#pragma unroll
            for (int e = 0; e < 8; ++e) v[e] = 0.f;
        }
#pragma unroll
        for (int e = 0; e < 8; ++e) o[e] += w[3 - d][e] * v[e];
    }
}
DEV void ldconvw(const float* W, const float* B, int C, int c0, float (&w)[4][8], float (&bias)[8]) {
#pragma unroll
    for (int j = 0; j < 4; ++j) ldf8(W + (size_t)j * C + c0, w[j]);
    ldf8(B + c0, bias);
}
DEV void mma_tile(f32x16& acc, const LAS bf16_t* A, int lda, const LAS bf16_t* B, int ldb, int K, int lane) {
    const int r = lane & 31, h = lane >> 5;
    const LAS bf16_t* ap = A + r * lda + 8 * h; const LAS bf16_t* bp = B + r * ldb + 8 * h;
    for (int k = 0; k < K; k += 16) {
        const bf16x8 a = *(const LAS bf16x8*)(ap + k); const bf16x8 b = *(const LAS bf16x8*)(bp + k);
        acc = __builtin_amdgcn_mfma_f32_32x32x16_bf16(a, b, acc, 0, 0, 0);
    }
}
DEV f32x16 zero16() { f32x16 z;
#pragma unroll
    for (int i = 0; i < 16; ++i) z[i] = 0.f;
    return z; }

#define XB_TMO      128
#define XB_XCNT(j)  (256  + 64 * (j))
#define XB_XSUB(j)  (1280 + 64 * (j))
#define XB_XGEN(j)  (2304 + 64 * (j))
#define XB_TOP      3328
#define XB_TOPGEN   3392
#define XCD_BAR_WORDS 3456
#define XB_SPIN_CAP (1u << 18)

__device__ __forceinline__ unsigned xb_ld(unsigned* p)              { return __hip_atomic_load(p, __ATOMIC_RELAXED, __HIP_MEMORY_SCOPE_AGENT); }
__device__ __forceinline__ unsigned xb_add(unsigned* p, unsigned v) { return __hip_atomic_fetch_add(p, v, __ATOMIC_RELAXED, __HIP_MEMORY_SCOPE_AGENT); }
__device__ __forceinline__ unsigned xb_xcc_id() { return (unsigned)__builtin_amdgcn_s_getreg((3 << 11) | 20) & 0xFu; }
#define XB_SPIN(cond, bar) do { unsigned _sp = 0; while (cond) { __builtin_amdgcn_s_sleep(1); \
    if ((++_sp & 255u) == 0u) { if (xb_ld(&(bar)[XB_TMO])) break; if (_sp > XB_SPIN_CAP) { atomicAdd(&(bar)[XB_TMO], 1u); break; } } } } while (0)

struct XcdBarrier {
    unsigned* bar; unsigned x;
    volatile LAS unsigned* st;
};

__device__ __forceinline__ XcdBarrier xcd_barrier_post(unsigned* bar, volatile LAS unsigned* st) {
    XcdBarrier b; b.bar = bar; b.x = xb_xcc_id(); b.st = st;
    if (threadIdx.x == 0) (void)xb_add(&bar[XB_XCNT(b.x)], 1u);
    return b;
}
__device__ __forceinline__ void xcd_barrier_complete(unsigned* bar, unsigned x, unsigned& nloc, unsigned& nx) {
    const unsigned G = gridDim.x * gridDim.y * gridDim.z;
    unsigned sum, cnt, mine, sp = 0u;
    for (;;) {
        sum = 0u; cnt = 0u; mine = 0u;
#pragma unroll
        for (unsigned j = 0; j < 16; ++j) { const unsigned c = xb_ld(&bar[XB_XCNT(j)]); sum += c; cnt += (c > 0u) ? 1u : 0u; mine = (j == x) ? c : mine; }
        if (sum == G) break;
        __builtin_amdgcn_s_sleep(1);
        if ((++sp & 255u) == 0u) { if (xb_ld(&bar[XB_TMO])) break; if (sp > XB_SPIN_CAP) { atomicAdd(&bar[XB_TMO], 1u); break; } }
    }
    nloc = mine > 0u ? mine : 1u; nx = cnt > 0u ? cnt : 1u;
}

__device__ __forceinline__ void xcd_barrier(const XcdBarrier& b) {
    asm volatile("s_waitcnt vmcnt(0)" ::: "memory");
    __syncthreads();
    if (threadIdx.x == 0) {
        unsigned* bar = b.bar;
        __builtin_amdgcn_s_waitcnt(0);
        unsigned nloc = b.st[0], nx = b.st[1];
        if (nloc == 0u) { xcd_barrier_complete(bar, b.x, nloc, nx); b.st[0] = nloc; b.st[1] = nx; }
        const unsigned old = xb_add(&bar[XB_XSUB(b.x)], 1u);
        const unsigned gen = old / nloc;
        if (old + 1u == (gen + 1u) * nloc) {
            __builtin_amdgcn_fence(__ATOMIC_RELEASE, "agent");
            asm volatile("s_waitcnt vmcnt(0)" ::: "memory");
            const unsigned og = xb_add(&bar[XB_TOP], 1u);
            const unsigned tg = og / nx;
            if (og + 1u == (tg + 1u) * nx) xb_add(&bar[XB_TOPGEN], 1u);
            else XB_SPIN(xb_ld(&bar[XB_TOPGEN]) == tg, bar);
            __builtin_amdgcn_fence(__ATOMIC_ACQUIRE, "agent");
            xb_add(&bar[XB_XGEN(b.x)], 1u);
            asm volatile("s_waitcnt vmcnt(0)" ::: "memory");
        } else {
            XB_SPIN(xb_ld(&bar[XB_XGEN(b.x)]) == gen, bar);
            __builtin_amdgcn_fence(__ATOMIC_ACQUIRE, "agent");
            asm volatile("s_waitcnt vmcnt(0)" ::: "memory");
        }
    }
    __syncthreads();
}

namespace pg8 {
constexpr int BM = 256, BK = 64, HALF = 128, HTB = HALF * BK * 2, NXCD = 8, WGM = 8;
__host__ __device__ __forceinline__ int lds_byte(int r, int c) { const int st = (r >> 4) * 2 + (c >> 5), rr = r & 15, cc = c & 31, ob = rr * 64 + cc * 2; return st * 1024 + (ob ^ (((ob >> 9) & 1) << 5)); }
__host__ __device__ __forceinline__ void stage_rc(int b, int& R, int& C) { const int st = b / 1024, sb = b % 1024, swz = sb ^ (((sb >> 9) & 1) << 5); R = (st >> 1) * 16 + swz / 64; C = (st & 1) * 32 + (swz % 64) / 2; }
__host__ __device__ __forceinline__ int perm32(int rho) { const int n = rho >> 4, i = rho & 15; return 8 * (i >> 2) + 4 * n + (i & 3); }
struct Unit { int pm, pn, k0; };
struct Gemm { const bf16_t* A; const bf16_t* Bt; int K, lda, ldb; };
struct StaticOrder {
    int nM, nN, nwg, G, c;
    __device__ void init(int M, int N, int G_, int c_) { nM = M / BM; nN = N / BM; nwg = nM * nN; G = G_; c = c_; }
    __device__ bool next(int i, Unit& u) const {
        const long L = (long)i * G + c; if (L >= nwg) return false;
        int wgid = (int)L; { const int q = nwg / NXCD, r = nwg % NXCD, xcd = wgid % NXCD, off = wgid / NXCD; wgid = (xcd < r ? xcd * (q + 1) : r * (q + 1) + (xcd - r) * q) + off; }
        const int nig = WGM * nN, gid = wgid / nig, fm = gid * WGM, gsz = (nM - fm) < WGM ? (nM - fm) : WGM;
        u.pm = fm + ((wgid % nig) % gsz); u.pn = (wgid % nig) / gsz; u.k0 = 0; return true;
    }
};
struct SplitKOrder {
    int nN, nsplit, Kc, G, c;
    __device__ bool next(int i, Unit& u) const { const long L = (long)i * G + c; if (L >= (long)nN * nsplit) return false; u.pm = 0; u.pn = (int)(L % nN); u.k0 = (int)(L / nN) * Kc; return true; }
};
DEV unsigned cvt_pk_bf16(float lo, float hi) { unsigned r; asm volatile("v_cvt_pk_bf16_f32 %0, %1, %2" : "=v"(r) : "v"(lo), "v"(hi)); return r; }

struct EpiF32 {
    static constexpr bool PERM = false;
    float* C; int ldc; int kc;
    DEV void operator()(const f32x4 (&acc)[2][2][4][2], const Unit& u, int wr, int wc, int fr, int fq) const {
        float* Cb = C + (kc > 0 ? (size_t)(u.k0 / kc) * 256 * ldc : (size_t)0);
        const unsigned base = (unsigned)((u.pm * BM + wr * 64 + fr) * ldc + u.pn * BM + wc * 32 + 4 * fq);
#pragma unroll
        for (int ai = 0; ai < 2; ++ai)
#pragma unroll
            for (int m = 0; m < 4; ++m) { const unsigned o = base + (unsigned)((ai * HALF + m * 16) * ldc);
#pragma unroll
                for (int bj = 0; bj < 2; ++bj)
#pragma unroll
                    for (int n = 0; n < 2; ++n) *(f32x4*)(Cb + o + bj * HALF + n * 16) = acc[ai][bj][m][n];
                asm volatile("" ::: "memory"); }
    }
};
template <int MODE  > struct EpiBf16 {
    static constexpr bool PERM = true;
    bf16_t* O; int ldc; const float* bias; float* DT; int dt_pn;
    DEV void operator()(const f32x4 (&acc)[2][2][4][2], const Unit& u, int wr, int wc, int fr, int fq) const {
        const int row0 = u.pm * BM + wr * 64 + fr; const int col0 = u.pn * BM + wc * 32 + 8 * fq;
        if (MODE == 0 && u.pn == dt_pn) {
            if (wc == 0) {
#pragma unroll
                for (int ai = 0; ai < 2; ++ai)
#pragma unroll
                    for (int m = 0; m < 4; ++m) { float* rowp = DT + (size_t)(row0 + ai * HALF + m * 16) * 32 + 8 * fq;
                        *(f32x4*)(rowp) = acc[ai][0][m][0]; *(f32x4*)(rowp + 4) = acc[ai][0][m][1]; }
            }
            return;
        }
        f32x4 bv[2][2];
#pragma unroll
        for (int bj = 0; bj < 2; ++bj)
#pragma unroll
            for (int n = 0; n < 2; ++n) bv[bj][n] = (MODE == 2) ? *(const f32x4*)(bias + col0 + bj * HALF + 4 * n) : (f32x4){0.f, 0.f, 0.f, 0.f};
#pragma unroll
        for (int ai = 0; ai < 2; ++ai)
#pragma unroll
            for (int m = 0; m < 4; ++m) { bf16_t* rowp = O + (size_t)(row0 + ai * HALF + m * 16) * ldc + col0;
#pragma unroll
                for (int bj = 0; bj < 2; ++bj) { f32x4 v0 = acc[ai][bj][m][0] + bv[bj][0], v1 = acc[ai][bj][m][1] + bv[bj][1];
                    if (MODE == 1) {
#pragma unroll
                        for (int j = 0; j < 4; ++j) { const float a = fmaxf(v0[j], 0.f), b = fmaxf(v1[j], 0.f); v0[j] = a * a; v1[j] = b * b; } }
                    u32x4 w; w.x = cvt_pk_bf16(v0[0], v0[1]); w.y = cvt_pk_bf16(v0[2], v0[3]); w.z = cvt_pk_bf16(v1[0], v1[1]); w.w = cvt_pk_bf16(v1[2], v1[3]);
                    *(u32x4*)(rowp + bj * HALF) = w; } }
    }
};

template <class Epi, class Sched>
DEV void gemm_phase(LAS unsigned char* lds, const Gemm g, const Sched& S, const Epi& E) {
    int tid_l = threadIdx.x; asm volatile("" : "+v"(tid_l));
    const int tid = tid_l, wid = __builtin_amdgcn_readfirstlane(tid >> 6), lane = tid & 63, wr = wid >> 2, wc = wid & 3, fr = lane & 15, fq = lane >> 4;
    const int nt = g.K / BK;
    unsigned voffA[2], voffB[2];
#pragma unroll
    for (int i = 0; i < 2; ++i) { int R, C; stage_rc(tid * 16 + i * 8192, R, C); const int Rb = Epi::PERM ? ((R & ~31) + perm32(R & 31)) : R;
        voffA[i] = (unsigned)(R * g.lda + C) * 2u; voffB[i] = (unsigned)(Rb * g.ldb + C) * 2u; }
    const size_t kstep = (size_t)(BK * 2);
    const size_t hsA = (size_t)HALF * g.lda * 2, hsB = (size_t)HALF * g.ldb * 2;
    const size_t tsA = 2 * hsA, tsB = 2 * hsB;
    const unsigned ldsw = (unsigned)wid * 1024u;
    const int aoff = lds_byte(wr * 64 + fr, fq * 8), boff = lds_byte(wc * 32 + fr, fq * 8);
#define PG8_SA(b, h) (((b) * 2 + (h)) * HTB)
#define PG8_SB(b, h) ((4 + (b) * 2 + (h)) * HTB)
#define PG8_STAGE(bufoff, gbase, voff) do { _Pragma("unroll") for (int _i = 0; _i < 2; ++_i) \
        __builtin_amdgcn_global_load_lds((const unsigned*)((const char*)(gbase) + (voff)[_i]), (LAS unsigned*)(lds + (bufoff) + ldsw + _i * 8192), 16, 0, 0); } while (0)
#define PG8_LDA(dst, b, h) do { _Pragma("unroll") for (int m = 0; m < 4; ++m) _Pragma("unroll") for (int k = 0; k < 2; ++k) dst[m][k] = *(const LAS bf16x8*)(lds + PG8_SA(b, h) + aoff + m * 2048 + k * 1024); } while (0)
#define PG8_LDB(dst, b, h) do { _Pragma("unroll") for (int n = 0; n < 2; ++n) _Pragma("unroll") for (int k = 0; k < 2; ++k) dst[n][k] = *(const LAS bf16x8*)(lds + PG8_SB(b, h) + boff + n * 2048 + k * 1024); } while (0)
#define PG8_MMA(ai, bj, At, Bt) do { __builtin_amdgcn_s_setprio(1); _Pragma("unroll") for (int m = 0; m < 4; ++m) _Pragma("unroll") for (int n = 0; n < 2; ++n) _Pragma("unroll") for (int k = 0; k < 2; ++k) \
        acc[ai][bj][m][n] = __builtin_amdgcn_mfma_f32_16x16x32_bf16(Bt[n][k], At[m][k], acc[ai][bj][m][n], 0, 0, 0); __builtin_amdgcn_s_setprio(0); } while (0)
#define PG8_WAIT_V(n) asm volatile("s_waitcnt vmcnt(" #n ")" ::: "memory")
#define PG8_WAIT_L(n) asm volatile("s_waitcnt lgkmcnt(" #n ")" ::: "memory")
#define PG8_BAR __builtin_amdgcn_s_barrier()
#define PG8_SCHED __builtin_amdgcn_sched_barrier(0)
    Unit cur, nxt; int ui = 0;
    if (!S.next(0, cur)) return;
    f32x4 acc[2][2][4][2];
#pragma unroll
    for (int a = 0; a < 2; ++a)
#pragma unroll
        for (int b = 0; b < 2; ++b)
#pragma unroll
            for (int m = 0; m < 4; ++m)
#pragma unroll
                for (int n = 0; n < 2; ++n) acc[a][b][m][n] = (f32x4){0.f, 0.f, 0.f, 0.f};
    bf16x8 At[4][2], B0[2][2], B1[2][2];
    const char* cA = (const char*)g.A + (size_t)cur.pm * tsA + (size_t)cur.k0 * 2; const char* cB = (const char*)g.Bt + (size_t)cur.pn * tsB + (size_t)cur.k0 * 2;
    PG8_STAGE(PG8_SB(0, 0), cB, voffB); PG8_STAGE(PG8_SA(0, 0), cA, voffA); PG8_STAGE(PG8_SB(0, 1), cB + hsB, voffB); PG8_STAGE(PG8_SA(0, 1), cA + hsA, voffA);
    if (wr == 1) PG8_BAR;
    PG8_WAIT_V(4); PG8_BAR;
    PG8_STAGE(PG8_SB(1, 0), cB + kstep, voffB); PG8_STAGE(PG8_SA(1, 0), cA + kstep, voffA); PG8_STAGE(PG8_SB(1, 1), cB + hsB + kstep, voffB);
    PG8_WAIT_V(6); PG8_BAR;
    for (;;) {
        const bool has_next = S.next(ui + 1, nxt);
        const char* nA = has_next ? (const char*)g.A + (size_t)nxt.pm * tsA + (size_t)nxt.k0 * 2 : cA; const char* nB = has_next ? (const char*)g.Bt + (size_t)nxt.pn * tsB + (size_t)nxt.k0 * 2 : cB;
        for (int t = 0; t < nt; t += 2) {
            const bool last = (t == nt - 2);
            const char* a1 = cA + (size_t)(t + 1) * kstep;
            const char* a2 = last ? nA : cA + (size_t)(t + 2) * kstep; const char* b2 = last ? nB : cB + (size_t)(t + 2) * kstep;
            const char* a3 = a2 + kstep; const char* b3 = b2 + kstep;
            PG8_LDB(B0, 0, 0); PG8_SCHED; PG8_LDA(At, 0, 0); PG8_STAGE(PG8_SA(1, 1), a1 + hsA, voffA);
            PG8_WAIT_L(8); PG8_BAR; PG8_WAIT_L(0); PG8_MMA(0, 0, At, B0); PG8_BAR; PG8_SCHED;
            PG8_LDB(B1, 0, 1); PG8_STAGE(PG8_SB(0, 0), b2, voffB);
            PG8_BAR; PG8_WAIT_L(0); PG8_MMA(0, 1, At, B1); PG8_BAR;
            PG8_LDA(At, 0, 1); PG8_STAGE(PG8_SA(0, 0), a2, voffA);
            PG8_BAR; PG8_WAIT_L(0); PG8_MMA(1, 0, At, B0); PG8_BAR; PG8_SCHED;
            PG8_STAGE(PG8_SB(0, 1), b2 + hsB, voffB);
            PG8_WAIT_V(6); PG8_BAR; PG8_MMA(1, 1, At, B1); PG8_BAR;
            PG8_LDB(B0, 1, 0); PG8_SCHED; PG8_LDA(At, 1, 0); PG8_STAGE(PG8_SA(0, 1), a2 + hsA, voffA);
            PG8_WAIT_L(8); PG8_BAR; PG8_WAIT_L(0); PG8_MMA(0, 0, At, B0); PG8_BAR; PG8_SCHED;
            PG8_LDB(B1, 1, 1); PG8_STAGE(PG8_SB(1, 0), b3, voffB);
            PG8_BAR; PG8_WAIT_L(0); PG8_MMA(0, 1, At, B1); PG8_BAR;
            PG8_LDA(At, 1, 1); PG8_STAGE(PG8_SA(1, 0), a3, voffA);
            PG8_BAR; PG8_WAIT_L(0); PG8_MMA(1, 0, At, B0); PG8_BAR; PG8_SCHED;
            PG8_STAGE(PG8_SB(1, 1), b3 + hsB, voffB);
            PG8_WAIT_V(6); PG8_BAR; PG8_MMA(1, 1, At, B1); PG8_BAR;
        }
        E(acc, cur, wr, wc, fr, fq);
        if (!has_next) break;
#pragma unroll
        for (int a = 0; a < 2; ++a)
#pragma unroll
            for (int b = 0; b < 2; ++b)
#pragma unroll
                for (int m = 0; m < 4; ++m)
#pragma unroll
                    for (int n = 0; n < 2; ++n) acc[a][b][m][n] = (f32x4){0.f, 0.f, 0.f, 0.f};
        cur = nxt; cA = nA; cB = nB; ++ui;
    }
    PG8_WAIT_V(0);
    if (wr == 0) PG8_BAR;
    PG8_BAR;
#undef PG8_SA
#undef PG8_SB
#undef PG8_STAGE
#undef PG8_LDA
#undef PG8_LDB
#undef PG8_MMA
#undef PG8_WAIT_V
#undef PG8_WAIT_L
#undef PG8_BAR
#undef PG8_SCHED
}
}

DEV void mod_item(const Params& P, LAS unsigned char* lds, int item, int tid, int lane, int wave) {
    const int colg = item * 128, layer = colg / 12288, n0 = colg % 12288;
    LAS float* cs = (LAS float*)(lds + wave * 9216);
    LAS float* red = (LAS float*)(lds + 73728);
    float acc[36][2];
#pragma unroll
    for (int s = 0; s < 36; ++s) { acc[s][0] = 0.f; acc[s][1] = 0.f; }
#define MOD_LOADW(dst, kq) do { const float* wr_ = Wu + (size_t)(kq) * 12288; _Pragma("unroll") for (int j_ = 0; j_ < 16; ++j_) dst[j_] = *(const f32x2*)(wr_ + (size_t)j_ * 12288 + voff); } while (0)
#define MOD_COMP(wv, koff) do { _Pragma("unroll") for (int j4_ = 0; j4_ < 4; ++j4_) { _Pragma("unroll") for (int sg = 0; sg < 4; ++sg) { \
        _Pragma("unroll") for (int s = 9 * sg; s < 9 * sg + 9; ++s) { const f32x4 c = *(const LAS f32x4*)(cs + s * 64 + (koff) + 4 * j4_); \
            acc[s][0] += c.x * wv[4 * j4_].x + c.y * wv[4 * j4_ + 1].x + c.z * wv[4 * j4_ + 2].x + c.w * wv[4 * j4_ + 3].x; \
            acc[s][1] += c.x * wv[4 * j4_].y + c.y * wv[4 * j4_ + 1].y + c.z * wv[4 * j4_ + 2].y + c.w * wv[4 * j4_ + 3].y; } \
        _Pragma("unroll") for (int s = 9 * sg; s < 9 * sg + 9; ++s) asm volatile("" : "+v"(acc[s][0]), "+v"(acc[s][1]) :: "memory"); } } } while (0)
    const float* Wu = P.in[10] + (size_t)layer * 2048 * 12288 + n0; const unsigned voff = 2u * (unsigned)lane;
    f32x2 wa[16], wb[16];
    MOD_LOADW(wa, wave * 256);
#pragma nounroll
    for (int sub = 0; sub < 4; ++sub) {
        const int kb = wave * 256 + sub * 64;
#pragma unroll 4
        for (int i = 0; i < 36; ++i) { const float v = (i < 4) ? P.in[8][i * 2048 + kb + lane] : P.in[9][(i - 4) * 2048 + kb + lane]; cs[i * 64 + lane] = siluf(v); }
        LDS_WAIT();
#pragma nounroll
        for (int g2 = 0; g2 < 2; ++g2) {
            MOD_LOADW(wb, kb + 32 * g2 + 16); MOD_COMP(wa, 32 * g2);
            if (kb + 32 * g2 + 32 < 2048) MOD_LOADW(wa, kb + 32 * g2 + 32);
            MOD_COMP(wb, 32 * g2 + 16);
        }
        LDS_WAIT();
    }
#undef MOD_LOADW
#undef MOD_COMP
    __syncthreads();
    float* MOD = (float*)(P.ws + WS_MOD);
#pragma unroll
    for (int half = 0; half < 2; ++half) {
#pragma unroll
        for (int s = 0; s < 18; ++s) *(LAS f32x2*)(red + (wave * 18 + s) * 128 + 2 * lane) = (f32x2){acc[18 * half + s][0], acc[18 * half + s][1]};
        __syncthreads();
        for (int o = tid; o < 18 * 128; o += NTHREADS) { const int s = o >> 7, c = o & 127; float v = 0.f;
#pragma unroll
            for (int w = 0; w < 8; ++w) v += red[(w * 18 + s) * 128 + c];
            MOD[(size_t)(layer * 36 + 18 * half + s) * 12288 + n0 + c] = v + P.in[11][layer * 12288 + n0 + c]; }
        __syncthreads();
    }
}
DEV void transpose_item(const float* W, int ldw, int k0, int n0, int ncols, bf16_t* WT, int ldt, int drow0, LAS float* scr, int lane) {
    if (lane < ncols) {
        float v[64];
        const float* wp = W + (size_t)k0 * ldw + n0 + lane;
#pragma unroll
        for (int kk = 0; kk < 64; ++kk) v[kk] = __builtin_nontemporal_load(wp + (size_t)kk * ldw);
#pragma unroll
        for (int kk = 0; kk < 64; ++kk) scr[kk * 65 + lane] = v[kk];
    }
    LDS_WAIT();
    const int c = lane & 7;
#pragma unroll
    for (int j = 0; j < 8; ++j) { const int n = (lane >> 3) + 8 * j;
        if (n < ncols) { const LAS float* s = scr + (8 * c) * 65 + n;
            u32x4 o; o.x = pk2(s[0], s[65]); o.y = pk2(s[2 * 65], s[3 * 65]); o.z = pk2(s[4 * 65], s[5 * 65]); o.w = pk2(s[6 * 65], s[7 * 65]);
            *(u32x4*)(WT + (size_t)(drow0 + n) * ldt + k0 + 8 * c) = o; } }
    LDS_WAIT();
}
DEV void transpose_range(const Params& P, LAS unsigned char* lds, int lo, int hi, int slot0, int myslots, int nslots, int lane, int wave) {
    unsigned char* ws = P.ws; bf16_t* WIN = (bf16_t*)(ws + WS_WIN);
    LAS float* scr = (LAS float*)(lds + wave * 16640);
    for (int sl = 0; sl < myslots; ++sl)
    for (int it = lo + slot0 + sl; it < hi; it += nslots) {
        int r = it;
        if (r < 3072) { const int kb = r / 96, nb = r % 96; transpose_item(P.in[13], 10272, kb * 64, nb * 64, 64, WIN, 2048, nb * 64, scr, lane); continue; } r -= 3072;
        if (r < 2048) { const int kb = r / 64, nb = r % 64; transpose_item(P.in[13], 10272, kb * 64, 6176 + nb * 64, 64, WIN, 2048, 6144 + nb * 64, scr, lane); continue; } r -= 2048;
        if (r < 32) { transpose_item(P.in[13], 10272, r * 64, 6144, 32, WIN, 2048, 10240, scr, lane); continue; } r -= 32;
        if (r < 2048) { const int kb = r / 32, nb = r % 32; transpose_item(P.in[27], 2048, kb * 64, nb * 64, 64, (bf16_t*)(ws + WS_WOH), 4096, nb * 64, scr, lane); continue; } r -= 2048;
        if (r < 1536) { const int kb = r / 48, nb = r % 48; transpose_item(P.in[28], 3072, kb * 64, nb * 64, 64, (bf16_t*)(ws + WS_WQKV), 2048, nb * 64, scr, lane); continue; } r -= 1536;
        if (r < 1024) { const int kb = r / 32, nb = r % 32; transpose_item(P.in[31], 2048, kb * 64, nb * 64, 64, (bf16_t*)(ws + WS_WOA), 2048, nb * 64, scr, lane); continue; } r -= 1024;
        if (r < 8192) { const int l = r / 4096; r %= 4096; const int kb = r / 128, nb = r % 128;
            transpose_item(P.in[32] + (size_t)l * 2048 * 8192, 8192, kb * 64, nb * 64, 64, (bf16_t*)(ws + WS_WUP) + (size_t)l * 8192 * 2048, 2048, nb * 64, scr, lane); continue; } r -= 8192;
        if (r < 8192) { const int l = r / 4096; r %= 4096; const int kb = r / 32, nb = r % 32;
            transpose_item(P.in[33] + (size_t)l * 8192 * 2048, 2048, kb * 64, nb * 64, 64, (bf16_t*)(ws + WS_WDN) + (size_t)l * 2048 * 8192, 8192, nb * 64, scr, lane); continue; } r -= 8192;
        { const int mat = r / 128; r %= 128; const int blk = r / 16; r %= 16; const int kb = r / 4, nb = r % 4;
            transpose_item((mat ? P.in[24] : P.in[22]) + (size_t)blk * 65536, 256, kb * 64, nb * 64, 64, (bf16_t*)(ws + WS_WLRU) + (size_t)mat * 8 * 65536 + (size_t)blk * 65536, 256, nb * 64, scr, lane); }
    }
}
DEV void phase0(const Params& P, LAS unsigned char* lds, int tid, int lane, int wave) {
    const int G = gridDim.x, bid = blockIdx.x;
    unsigned char* ws = P.ws;
    REP(20) for (int it = bid; it < 192; it += G) mod_item(P, lds, it, tid, lane, wave);
    __syncthreads();
    bf16_t* WIN = (bf16_t*)(ws + WS_WIN);
    REP(21) {
    const int nmod = G > 192 ? 192 : G, nslots = (G - nmod) * 8 * 9 + nmod * 8;
    const int myslots = bid >= nmod ? 9 : 1, slot0 = bid >= nmod ? 9 * ((bid - nmod) * 8 + wave) : (G - nmod) * 72 + (bid * 8 + wave);
#if TAILS
    transpose_range(P, lds, 0, 5152, slot0, myslots, nslots, lane, wave);
    transpose_range(P, lds, 26144, 26400, bid * 8 + wave, 1, G * 8, lane, wave);
    if (G > 192 && bid >= nmod) transpose_range(P, lds, 5152, 7200, (bid - nmod) * 8 + wave, 1, (G - nmod) * 8, lane, wave);
#else
    { const int ns2 = (G - nmod) * 8 * 3 + nmod * 8 * 2, my2 = bid >= nmod ? 3 : 2, s02 = bid >= nmod ? 3 * ((bid - nmod) * 8 + wave) : (G - nmod) * 24 + 2 * (bid * 8 + wave);
      transpose_range(P, lds, 0, 26400, s02, my2, ns2, lane, wave); }
#endif
    }
    const int gt = bid * NTHREADS + tid, NGT = G * NTHREADS;
    for (int q = gt; q < 57344; q += NGT) *((u32x4*)(WIN + (size_t)10272 * 2048) + q) = (u32x4){0u, 0u, 0u, 0u};
    float* ROPE = (float*)(ws + WS_ROPE);
    for (int q = gt; q < 2056 * 32; q += NGT) {
        const int pi = q >> 5, i = q & 31; const int pos = pi < 2048 ? pi : 16384 + (pi - 2048);
        const float invf = powf(10000.0f, -(float)i / 32.0f);
        const float ang = (float)pos * invf;
        const double a = (double)ang; const double n = rint(a * 0.15915494309189535); const float rr = (float)(a - n * 6.283185307179586);
        ROPE[2 * q] = cosf(rr); ROPE[2 * q + 1] = sinf(rr);
    }
}

DEV void norm_phase(const Params& P, LAS unsigned char* lds, bool first, bool last, int l_post, int gpost_idx, int gate_j, int l_pre, int gpre_idx, int sh_j, int sc_j, int nsplit, int lane, int wave, float gscale = 1.f, bool xin = false) {
    const int G = gridDim.x; const int gw = blockIdx.x * 8 + wave, NGW = G * 8;
    float* X = P.out; bf16_t* X16 = (bf16_t*)(P.ws + WS_X16); const bf16_t* MIXB = (const bf16_t*)(P.ws + WS_MIX); bf16_t* H = (bf16_t*)(P.ws + WS_H); const float* MOD = (const float*)(P.ws + WS_MOD);
    const float* gpo = P.in[12] + (size_t)(l_post * 4 + gpost_idx) * DM; const float* gpr = P.in[12] + (size_t)(l_pre * 4 + gpre_idx) * DM;
    const int nrows = first ? TT : TP;
    f32x4 xa[8], ma[8];
    int r = gw;
    if (r < nrows) {
        const float* xs = r < TP ? P.in[0] + (size_t)r * DM : P.in[1] + (size_t)(r - TP) * DM;
#pragma unroll
        for (int j = 0; j < 8; ++j) { if (first || xin) xa[j] = *(const f32x4*)(xs + 4 * lane + 256 * j); else { const u32x2 xw = *(const u32x2*)(X16 + (size_t)r * DM + 4 * lane + 256 * j); xa[j] = (f32x4){bflo(xw.x), bfhi(xw.x), bflo(xw.y), bfhi(xw.y)}; } if (first) ma[j] = xa[j]; else { const u32x2 mw = *(const u32x2*)(MIXB + (size_t)r * DM + 4 * lane + 256 * j); ma[j] = (f32x4){bflo(mw.x), bfhi(mw.x), bflo(mw.y), bfhi(mw.y)}; } }
    }
    for (; r < nrows; r += NGW) {
        const int rn = r + NGW; f32x4 xb[8], mb[8];
        if (rn < nrows) {
            const float* xs = rn < TP ? P.in[0] + (size_t)rn * DM : P.in[1] + (size_t)(rn - TP) * DM;
#pragma unroll
            for (int j = 0; j < 8; ++j) { if (first || xin) xb[j] = *(const f32x4*)(xs + 4 * lane + 256 * j); else { const u32x2 xw = *(const u32x2*)(X16 + (size_t)rn * DM + 4 * lane + 256 * j); xb[j] = (f32x4){bflo(xw.x), bfhi(xw.x), bflo(xw.y), bfhi(xw.y)}; } if (first) mb[j] = xb[j]; else { const u32x2 mw = *(const u32x2*)(MIXB + (size_t)rn * DM + 4 * lane + 256 * j); mb[j] = (f32x4){bflo(mw.x), bfhi(mw.x), bflo(mw.y), bfhi(mw.y)}; } }
        } else {
#pragma unroll
            for (int j = 0; j < 8; ++j) { xb[j] = xa[j]; mb[j] = ma[j]; }
        }
        const int seq = r < TP ? (r >> 11) : 4 + ((r - TP) >> 3);
        if (!first) {
            float ss = 0.f;
#pragma unroll
            for (int j = 0; j < 8; ++j) ss += ma[j].x * ma[j].x + ma[j].y * ma[j].y + ma[j].z * ma[j].z + ma[j].w * ma[j].w;
            const float rinv = rsqrtf(wave_sum(ss) * (1.f / DM) + EPSN);
            const float* gt = MOD + (size_t)(l_post * 36 + seq) * 12288 + gate_j * DM;
#pragma unroll
            for (int j = 0; j < 8; ++j) { const f32x4 g = *(const f32x4*)(gpo + 4 * lane + 256 * j), ga = *(const f32x4*)(gt + 4 * lane + 256 * j);
                xa[j] = xa[j] + ga * gscale * (ma[j] * rinv * g);
                if (last) *(f32x4*)(X + (size_t)r * DM + 4 * lane + 256 * j) = xa[j];
                else { u32x2 xw; xw.x = pk2(xa[j].x, xa[j].y); xw.y = pk2(xa[j].z, xa[j].w); *(u32x2*)(X16 + (size_t)r * DM + 4 * lane + 256 * j) = xw; } }
        }
        if (!last) {
            float ss = 0.f;
#pragma unroll
            for (int j = 0; j < 8; ++j) ss += xa[j].x * xa[j].x + xa[j].y * xa[j].y + xa[j].z * xa[j].z + xa[j].w * xa[j].w;
            const float rinv = rsqrtf(wave_sum(ss) * (1.f / DM) + EPSN);
            const float* mbp = MOD + (size_t)(l_pre * 36 + seq) * 12288;
#pragma unroll
            for (int j = 0; j < 8; ++j) { const f32x4 g = *(const f32x4*)(gpr + 4 * lane + 256 * j), sc = *(const f32x4*)(mbp + sc_j * DM + 4 * lane + 256 * j), sh = *(const f32x4*)(mbp + sh_j * DM + 4 * lane + 256 * j);
                const f32x4 h = xa[j] * rinv * g * (sc + 1.f) + sh;
                u32x2 w; w.x = pk2(h.x, h.y); w.y = pk2(h.z, h.w);
                *(u32x2*)(H + (size_t)r * DM + 4 * lane + 256 * j) = w; }
        }
#pragma unroll
        for (int j = 0; j < 8; ++j) { xa[j] = xb[j]; ma[j] = mb[j]; }
    }
    if (first) return;
    LAS float* red = (LAS float*)lds;
    for (int rs = blockIdx.x; rs < TS; rs += G) {
        const int rr = TP + rs, seq = 4 + (rs >> 3), col = 256 * wave + 4 * lane;
        const float* pp = (const float*)(P.ws + WS_PART) + (size_t)rs * DM + col;
        f32x4 mv = (f32x4){0.f, 0.f, 0.f, 0.f};
#pragma unroll 8
        for (int ks = 0; ks < nsplit; ++ks) mv = mv + *(const f32x4*)(pp + (size_t)ks * 256 * DM);
        f32x4 xv;
        if (xin) xv = *(const f32x4*)(P.in[1] + (size_t)rs * DM + col); else { const u32x2 xw = *(const u32x2*)(X16 + (size_t)rr * DM + col); xv = (f32x4){bflo(xw.x), bfhi(xw.x), bflo(xw.y), bfhi(xw.y)}; }
        const float s1 = wave_sum(mv.x * mv.x + mv.y * mv.y + mv.z * mv.z + mv.w * mv.w);
        if (lane == 0) red[wave] = s1;
        __syncthreads();
        float tot = 0.f;
#pragma unroll
        for (int w = 0; w < 8; ++w) tot += red[w];
        const float rinv = rsqrtf(tot * (1.f / DM) + EPSN);
        const f32x4 g = *(const f32x4*)(gpo + col), ga = *(const f32x4*)(MOD + (size_t)(l_post * 36 + seq) * 12288 + gate_j * DM + col);
        xv = xv + ga * gscale * (mv * rinv * g);
        if (last) *(f32x4*)(X + (size_t)rr * DM + col) = xv; else { u32x2 xw; xw.x = pk2(xv.x, xv.y); xw.y = pk2(xv.z, xv.w); *(u32x2*)(X16 + (size_t)rr * DM + col) = xw; }
        if (!last) {
            const float s2 = wave_sum(xv.x * xv.x + xv.y * xv.y + xv.z * xv.z + xv.w * xv.w);
            if (lane == 0) red[8 + wave] = s2;
            __syncthreads();
            float tot2 = 0.f;
#pragma unroll
            for (int w = 0; w < 8; ++w) tot2 += red[8 + w];
            const float rinv2 = rsqrtf(tot2 * (1.f / DM) + EPSN);
            const float* mbp = MOD + (size_t)(l_pre * 36 + seq) * 12288;
            const f32x4 g2 = *(const f32x4*)(gpr + col), sc = *(const f32x4*)(mbp + sc_j * DM + col), sh = *(const f32x4*)(mbp + sh_j * DM + col);
            const f32x4 h = xv * rinv2 * g2 * (sc + 1.f) + sh;
            u32x2 w; w.x = pk2(h.x, h.y); w.y = pk2(h.z, h.w);
            *(u32x2*)(H + (size_t)rr * DM + col) = w;
        }
        __syncthreads();
    }
}

DEV void lru_gate_item(const Params& P, LAS unsigned char* lds, int r0, int nrows  , int kb, int tid, int lane, int wave) {
    LAS bf16_t* XC = (LAS bf16_t*)lds;
    const bf16_t* PROJ = (const bf16_t*)(P.ws + WS_PROJ);
    {
        const int cgp = tid & 31, ch0 = kb * 256 + cgp * 8;
        float w[4][8], bias[8]; ldconvw(P.in[20], P.in[21], 2048, ch0, w, bias);
#pragma unroll 4
        for (int i = 0; i < nrows / 16; ++i) { const int q = tid + NTHREADS * i, row = q >> 5, r = r0 + row; int tl; const float* hist = nullptr;
            if (r < TP) tl = r & 2047; else { const int rs = r - TP; tl = rs & 7; hist = P.in[4] + (size_t)(rs >> 3) * 3 * 2048 + ch0; }
            float o[8]; conv8(PROJ, r, tl, PC_XR + ch0, hist, 2048, w, bias, o);
            *(LAS u32x4*)(XC + row * 264 + cgp * 8) = pack8(o); }
    }
    __syncthreads();
    const int r = lane & 31, h = lane >> 5;
    const int ch = kb * 256 + 32 * wave + r;
    const float ba_ = P.in[23][ch], bx_ = P.in[25][ch], sp = softplusf(-P.in[26][ch]);
    float* Aa = (float*)(P.ws + WS_B); float* Uu = (float*)(P.ws + WS_AU_U);
    const bf16_t* Wa = (const bf16_t*)(P.ws + WS_WLRU) + (size_t)(kb * 256 + 32 * wave + r) * 256 + 8 * h; const bf16_t* Wx = Wa + 8 * 65536;
#pragma nounroll
    for (int mh = 0; mh < nrows / 64; ++mh) {
        f32x16 aa[2], ax[2];
#pragma unroll
        for (int m = 0; m < 2; ++m) { aa[m] = zero16(); ax[m] = zero16(); }
        bf16x8 bA[4], bX[4], nA[4], nX[4];
#pragma unroll
        for (int j = 0; j < 4; ++j) { bA[j] = *(const bf16x8*)(Wa + 16 * j); bX[j] = *(const bf16x8*)(Wx + 16 * j); }
#pragma unroll
        for (int kb4 = 0; kb4 < 4; ++kb4) {
            if (kb4 < 3) {
#pragma unroll
                for (int j = 0; j < 4; ++j) { nA[j] = *(const bf16x8*)(Wa + 64 * (kb4 + 1) + 16 * j); nX[j] = *(const bf16x8*)(Wx + 64 * (kb4 + 1) + 16 * j); } }
#pragma unroll
            for (int j = 0; j < 4; ++j)
#pragma unroll
                for (int m = 0; m < 2; ++m) { const bf16x8 a = *(const LAS bf16x8*)(XC + (64 * mh + 32 * m + r) * 264 + 64 * kb4 + 16 * j + 8 * h);
                    aa[m] = __builtin_amdgcn_mfma_f32_32x32x16_bf16(a, bA[j], aa[m], 0, 0, 0); ax[m] = __builtin_amdgcn_mfma_f32_32x32x16_bf16(a, bX[j], ax[m], 0, 0, 0); }
            if (kb4 < 3) {
#pragma unroll
                for (int j = 0; j < 4; ++j) { bA[j] = nA[j]; bX[j] = nX[j]; } }
        }
#pragma unroll
        for (int m = 0; m < 2; ++m)
#pragma unroll
            for (int reg = 0; reg < 16; ++reg) { const int t = 64 * mh + 32 * m + rowmap(reg, h);
                const float xb = bf2f(XC[t * 264 + 32 * wave + r]);
                const float gr = sigm(aa[m][reg] + ba_), gi = sigm(ax[m][reg] + bx_);
                const float la = -8.0f * gr * sp; const float a = __expf(la); const float mult = sqrtf(fmaxf(-expm1f(2.0f * la), 0.f));
                Aa[(size_t)(r0 + t) * 2048 + ch] = a; Uu[(size_t)(r0 + t) * 2048 + ch] = mult * gi * xb; }
    }
    __syncthreads();
}
DEV void ssd_dt_acs(const Params& P, LAS float* acs, LAS float* dts, LAS float* tmp, int R0, int g, int tid) {
    const int hh = tid >> 7, s = tid & 127, hd = 4 * g + hh;
    const float* DT = (const float*)(P.ws + WS_DT);
    const float dtv = softplusf(DT[(size_t)(R0 + s) * 32 + hd] + P.in[16][hd]);
    const float a = -__expf(P.in[17][hd]);
    tmp[tid] = dtv * a; dts[tid] = dtv;
    __syncthreads();
    float c = 0.f; for (int i = 0; i <= s; ++i) c += tmp[hh * 128 + i];
    acs[tid] = c;
    __syncthreads();
}
DEV void ssd_state_item(const Params& P, LAS unsigned char* lds, int it, int tid, int lane, int wave) {
    const int g = it & 7, c = (it >> 3) & 15, b = it >> 7; const int R0 = b * 2048 + c * 128;
    LAS bf16_t* BT = (LAS bf16_t*)lds;
    LAS bf16_t* XWT = (LAS bf16_t*)(lds + 34816);
    LAS float* acs = (LAS float*)(lds + 52224); LAS float* dts = acs + 512; LAS float* tmp = dts + 512;
    const bf16_t* PROJ = (const bf16_t*)(P.ws + WS_PROJ);
    ssd_dt_acs(P, acs, dts, tmp, R0, g, tid);
    {
        const int cgb = tid & 15, cidx = 2048 + g * 128 + cgb * 8;
        float w[4][8], bias[8]; ldconvw(P.in[14], P.in[15], 4096, cidx, w, bias);
#pragma unroll 4
        for (int i = 0; i < 4; ++i) { const int q = tid + NTHREADS * i, s = q >> 4; float o[8];
            conv8(PROJ, R0 + s, c * 128 + s, PC_XBC + cidx, nullptr, 4096, w, bias, o);
#pragma unroll
            for (int e = 0; e < 8; ++e) BT[(cgb * 8 + e) * 136 + s] = (bf16_t)f2bf(siluf(o[e])); }
    }
    float* CS = (float*)(P.ws + WS_CS); float* CDEC = (float*)(P.ws + WS_CDEC);
    for (int hh = 0; hh < 4; ++hh) {
        const int hd = 4 * g + hh;
        {
            const int cgp = tid & 7, cidx = hd * 64 + cgp * 8;
            float w[4][8], bias[8]; ldconvw(P.in[14], P.in[15], 4096, cidx, w, bias);
            const float alast = acs[hh * 128 + 127];
#pragma unroll 2
            for (int i = 0; i < 2; ++i) { const int q = tid + NTHREADS * i, s = q >> 3; float o[8];
                conv8(PROJ, R0 + s, c * 128 + s, PC_XBC + cidx, nullptr, 4096, w, bias, o);
                const float sc = dts[hh * 128 + s] * __expf(alast - acs[hh * 128 + s]);
#pragma unroll
                for (int e = 0; e < 8; ++e) XWT[(cgp * 8 + e) * 136 + s] = (bf16_t)f2bf(siluf(o[e]) * sc); }
        }
        __syncthreads();
        const int pt = wave >> 2, nt = wave & 3;
        f32x16 acc = zero16();
        mma_tile(acc, XWT + 32 * pt * 136, 136, BT + 32 * nt * 136, 136, 128, lane);
        float* dst = CS + ((size_t)((b * 16 + c) * 32 + hd)) * 8192;
#pragma unroll
        for (int reg = 0; reg < 16; ++reg) dst[(32 * pt + rowmap(reg, lane >> 5)) * 128 + 32 * nt + (lane & 31)] = acc[reg];
        if (tid == 0) CDEC[(b * 16 + c) * 32 + hd] = __expf(acs[hh * 128 + 127]);
        __syncthreads();
    }
}
DEV void phase3(const Params& P, LAS unsigned char* lds, int tid, int lane, int wave) {
    const int G = gridDim.x, bid = blockIdx.x;
    REP(14) { for (int it = bid; it < 512; it += G) lru_gate_item(P, lds, (it >> 3) * 128, 128, it & 7, tid, lane, wave);
              for (int it = bid; it < 32; it += G) lru_gate_item(P, lds, TP + (it >> 3) * 64, 64, it & 7, tid, lane, wave); }
    REP(15) for (int it = bid; it < 512; it += G) ssd_state_item(P, lds, it, tid, lane, wave);
    const bf16_t* PROJ = (const bf16_t*)(P.ws + WS_PROJ);
    const int gt = bid * NTHREADS + tid, NGT = G * NTHREADS;
    for (int q = gt; q < 49152 + 24576 + 393216 + 196608; q += NGT) {
        int r = q;
        if (r < 49152) { const int b = r / 12288, j = (r / 4096) % 3, cc = r % 4096; P.out[O_PSC + r] = bf2f(PROJ[(size_t)(b * 2048 + 2045 + j) * NPROJ + PC_XBC + cc]); continue; } r -= 49152;
        if (r < 24576) { const int b = r / 6144, j = (r / 2048) % 3, cc = r % 2048; P.out[O_PLC + r] = bf2f(PROJ[(size_t)(b * 2048 + 2045 + j) * NPROJ + PC_XR + cc]); continue; } r -= 24576;
        if (r < 393216) { const int b = r / 12288, j = (r / 4096) % 3, cc = r % 4096; P.out[O_SSC + r] = bf2f(PROJ[(size_t)(TP + b * 8 + 5 + j) * NPROJ + PC_XBC + cc]); continue; } r -= 393216;
        { const int b = r / 6144, j = (r / 2048) % 3, cc = r % 2048; P.out[O_SLC + r] = bf2f(PROJ[(size_t)(TP + b * 8 + 5 + j) * NPROJ + PC_XR + cc]); }
    }
}

DEV void lru_scan_item(const Params& P, LAS unsigned char* lds, int it, int tid) {
    const int b = it >> 6, cgp = it & 63, cl = tid & 31, ch = cgp * 32 + cl, seg = tid >> 5;
    const size_t rbase = (size_t)b * 2048 + seg * 128;
    const float* Aa = (const float*)(P.ws + WS_B) + rbase * 2048 + ch; const float* Uu = (const float*)(P.ws + WS_AU_U) + rbase * 2048 + ch;
    LAS float* sA = (LAS float*)lds; LAS float* sH = sA + 512;
    float p1 = 1.f, h1 = 0.f, p2 = 1.f, h2 = 0.f;
#pragma unroll 16
    for (int t = 0; t < 64; ++t) { const float a1 = Aa[(size_t)t * 2048], u1 = Uu[(size_t)t * 2048], a2 = Aa[(size_t)(64 + t) * 2048], u2 = Uu[(size_t)(64 + t) * 2048];
        h1 = a1 * h1 + u1; p1 *= a1; h2 = a2 * h2 + u2; p2 *= a2; }
    sA[seg * 32 + cl] = p1 * p2; sH[seg * 32 + cl] = p2 * h1 + h2;
    __syncthreads();
    float hin = 0.f;
    for (int s = 0; s < seg; ++s) hin = sA[s * 32 + cl] * hin + sH[s * 32 + cl];
    const bf16_t* GATE = (const bf16_t*)(P.ws + WS_PROJ) + rbase * NPROJ + PC_GATE + ch;
    bf16_t* Y = (bf16_t*)(P.ws + WS_YMIX) + rbase * 4096 + 2048 + ch;
    float g1 = hin, g2 = p1 * hin + h1;
#pragma unroll 8
    for (int t = 0; t < 64; ++t) { const float a1 = Aa[(size_t)t * 2048], u1 = Uu[(size_t)t * 2048], a2 = Aa[(size_t)(64 + t) * 2048], u2 = Uu[(size_t)(64 + t) * 2048];
        const float z1 = bf2f(GATE[(size_t)t * NPROJ]), z2 = bf2f(GATE[(size_t)(64 + t) * NPROJ]);
        g1 = a1 * g1 + u1; g2 = a2 * g2 + u2;
        Y[(size_t)t * 4096] = (bf16_t)f2bf(g1 * geluf(z1)); Y[(size_t)(64 + t) * 4096] = (bf16_t)f2bf(g2 * geluf(z2)); }
    const float h = g2;
    if (seg == 15) P.out[O_PL + b * 2048 + ch] = h;
    __syncthreads();
}
DEV void phase4(const Params& P, LAS unsigned char* lds, int tid, int lane, int wave) {
    const int G = gridDim.x, bid = blockIdx.x;
    REP(22) for (int it = bid; it < 256; it += G) lru_scan_item(P, lds, it, tid);
    const int gt = bid * NTHREADS + tid, NGT = G * NTHREADS;
    for (int q = gt; q < 65536; q += NGT) { const int b = q >> 11, ch = q & 2047; float h = P.in[5][q];
        const size_t r0 = (size_t)TP + b * 8;
#pragma unroll
        for (int t = 0; t < 8; ++t) { const float a = ((const float*)(P.ws + WS_B))[(r0 + t) * 2048 + ch], u = ((const float*)(P.ws + WS_AU_U))[(r0 + t) * 2048 + ch]; h = a * h + u;
            ((bf16_t*)(P.ws + WS_YMIX))[(r0 + t) * 4096 + 2048 + ch] = (bf16_t)f2bf(h * geluf(bf2f(((const bf16_t*)(P.ws + WS_PROJ))[(r0 + t) * NPROJ + PC_GATE + ch]))); }
        P.out[O_SL + q] = h; }
    const f32x4* CS4 = (const f32x4*)(P.ws + WS_CS); const float* CDEC = (const float*)(P.ws + WS_CDEC); u32x2* HIN = (u32x2*)(P.ws + WS_HIN);
    REP(23) for (int q = gt; q < 262144; q += NGT) { const int b = q >> 16, rem = q & 65535, hd = rem >> 11, e4 = rem & 2047;
        f32x4 h = (f32x4){0.f, 0.f, 0.f, 0.f};
        f32x4 csv[16]; float decv[16];
#pragma unroll
        for (int c = 0; c < 16; ++c) { const int idx = (b * 16 + c) * 32 + hd; decv[c] = CDEC[idx]; csv[c] = CS4[(size_t)idx * 2048 + e4]; }
#pragma unroll
        for (int c = 0; c < 16; ++c) { const int idx = (b * 16 + c) * 32 + hd;
            u32x2 w; w.x = pk2(h.x, h.y); w.y = pk2(h.z, h.w); HIN[(size_t)idx * 2048 + e4] = w;
            h = h * decv[c] + csv[c]; }
        *(f32x4*)(P.out + O_PSSM + (size_t)(b * 32 + hd) * 8192 + e4 * 4) = h; }
}

DEV void ssd_out_item(const Params& P, LAS unsigned char* lds, int it, int tid, int lane, int wave) {
    const int g = it & 7, c = (it >> 3) & 15, b = it >> 7; const int R0 = b * 2048 + c * 128;
    LAS bf16_t* Cs = (LAS bf16_t*)lds; LAS bf16_t* Bs = (LAS bf16_t*)(lds + 34816); LAS bf16_t* Ms = (LAS bf16_t*)(lds + 69632);
    LAS bf16_t* XT = (LAS bf16_t*)(lds + 104448); LAS bf16_t* Hs = (LAS bf16_t*)(lds + 121856);
    LAS float* acs = (LAS float*)(lds + 139264); LAS float* dts = acs + 512; LAS float* ssq = dts + 512; LAS float* tmp = (LAS float*)Ms;
    const bf16_t* PROJ = (const bf16_t*)(P.ws + WS_PROJ);
    ssd_dt_acs(P, acs, dts, tmp, R0, g, tid);
    {
        const int cgb = tid & 15;
#pragma unroll
        for (int mat = 0; mat < 2; ++mat) { const int cidx = 2048 + mat * 1024 + g * 128 + cgb * 8;
            float w[4][8], bias[8]; ldconvw(P.in[14], P.in[15], 4096, cidx, w, bias);
            LAS bf16_t* dstm = mat ? Cs : Bs;
#pragma unroll 4
            for (int i = 0; i < 4; ++i) { const int q = tid + NTHREADS * i, s = q >> 4; float o[8];
                conv8(PROJ, R0 + s, c * 128 + s, PC_XBC + cidx, nullptr, 4096, w, bias, o);
#pragma unroll
                for (int e = 0; e < 8; ++e) o[e] = siluf(o[e]);
                *(LAS u32x4*)(dstm + s * 136 + cgb * 8) = pack8(o); } }
    }
    __syncthreads();
    const int tt = wave >> 1;
    f32x16 cb[2];
#pragma unroll
    for (int j = 0; j < 2; ++j) { const int st = 2 * (wave & 1) + j; cb[j] = zero16();
        if (st <= tt) mma_tile(cb[j], Cs + 32 * tt * 136, 136, Bs + 32 * st * 136, 136, 128, lane); }
    const int pt = wave & 1;
    f32x16 yv[4];
#pragma unroll
    for (int k = 0; k < 4; ++k) yv[k] = zero16();
    for (int hh = 0; hh < 4; ++hh) {
        const int hd = 4 * g + hh;
        int lane_l = lane, tid_l = tid; asm volatile("" : "+v"(lane_l), "+v"(tid_l));
        const int r = lane_l & 31, h = lane_l >> 5;
        const u32x4* hsrc = (const u32x4*)((const bf16_t*)(P.ws + WS_HIN) + ((size_t)((b * 16 + c) * 32 + hd)) * 8192);
        const u32x4 hpre0 = hsrc[tid_l], hpre1 = hsrc[tid_l + NTHREADS];
        unsigned short zv[16];
        { const bf16_t* zp = PROJ + (size_t)(R0 + 32 * tt + 4 * h) * NPROJ + hd * 64 + 32 * pt + r;
#pragma unroll
          for (int reg = 0; reg < 16; ++reg) zv[reg] = zp[(size_t)((reg & 3) + 8 * (reg >> 2)) * NPROJ]; }
        __builtin_amdgcn_sched_barrier(0);
#pragma unroll
        for (int j = 0; j < 2; ++j) { const int st = 2 * (wave & 1) + j; const int s = 32 * st + r; const float as = acs[hh * 128 + s], ds = dts[hh * 128 + s];
#pragma unroll
            for (int reg = 0; reg < 16; ++reg) { const int t = 32 * tt + rowmap(reg, h);
                const float v = (s <= t) ? cb[j][reg] * __expf(acs[hh * 128 + t] - as) * ds : 0.f;
                Ms[t * 136 + s] = (bf16_t)f2bf(v); } }
        __builtin_amdgcn_sched_barrier(0);
        {
            const int cgp = tid_l & 7, cidx = hd * 64 + cgp * 8;
            float w[4][8], bias[8]; ldconvw(P.in[14], P.in[15], 4096, cidx, w, bias);
#pragma unroll 2
            for (int i = 0; i < 2; ++i) { const int q = tid_l + NTHREADS * i, s = q >> 3; float o[8];
                conv8(PROJ, R0 + s, c * 128 + s, PC_XBC + cidx, nullptr, 4096, w, bias, o);
#pragma unroll
                for (int e = 0; e < 8; ++e) XT[(cgp * 8 + e) * 136 + s] = (bf16_t)f2bf(siluf(o[e])); }
            { const int q0 = tid_l, q1 = tid_l + NTHREADS; *(LAS u32x4*)(Hs + (q0 >> 4) * 136 + (q0 & 15) * 8) = hpre0; *(LAS u32x4*)(Hs + (q1 >> 4) * 136 + (q1 & 15) * 8) = hpre1; }
        }
        __builtin_amdgcn_sched_barrier(0);
        __syncthreads();
        __builtin_amdgcn_sched_barrier(0);
        f32x16 ad = zero16(), ao = zero16();
        mma_tile(ad, Ms + 32 * tt * 136, 136, XT + 32 * pt * 136, 136, 32 * (tt + 1), lane_l);
        mma_tile(ao, Cs + 32 * tt * 136, 136, Hs + 32 * pt * 136, 136, 128, lane_l);
        const float dsk = P.in[18][hd];
        const int p = 32 * pt + r;
#pragma unroll
        for (int reg = 0; reg < 16; ++reg) { const int t = 32 * tt + rowmap(reg, h);
            float y = ad[reg] + __expf(acs[hh * 128 + t]) * ao[reg] + dsk * bf2f(XT[p * 136 + t]);
            const float z = bf2f(zv[reg]);
            ad[reg] = y * siluf(z); }
#pragma unroll
        for (int k = 0; k < 4; ++k) yv[k] = (hh == k) ? ad : yv[k];
        __syncthreads();
    }
    int lane_m = lane; asm volatile("" : "+v"(lane_m));
    const int r = lane_m & 31, h = lane_m >> 5;
#pragma unroll
    for (int reg = 0; reg < 16; ++reg) { float s = 0.f;
#pragma unroll
        for (int hh = 0; hh < 4; ++hh) s += yv[hh][reg] * yv[hh][reg];
#pragma unroll
        for (int o = 1; o < 32; o <<= 1) s += __shfl_xor(s, o);
        if (r == 0) ssq[pt * 128 + 32 * tt + rowmap(reg, h)] = s; }
    __syncthreads();
    bf16_t* Y = (bf16_t*)(P.ws + WS_YMIX);
#pragma unroll
    for (int reg = 0; reg < 16; ++reg) { const int t = 32 * tt + rowmap(reg, h);
        const float rinv = rsqrtf((ssq[t] + ssq[128 + t]) * (1.f / 256.f) + EPSN);
#pragma unroll
        for (int hh = 0; hh < 4; ++hh) { const int ch = (4 * g + hh) * 64 + 32 * pt + r;
            Y[(size_t)(R0 + t) * 4096 + ch] = (bf16_t)f2bf(yv[hh][reg] * rinv * P.in[19][ch]); } }
    __syncthreads();
}
DEV void ssd_sample_item(const Params& P, LAS unsigned char* lds, int it, int tid, int lane, int wave) {
    const int b = it >> 3, g = it & 7; const int R0 = TP + b * 8;
    LAS float* xs = (LAS float*)lds;
    LAS float* Bv = xs + 2048;
    LAS float* Cv = Bv + 1024;
    LAS float* dtv = Cv + 1024;
    LAS float* yv = dtv + 32;
    const bf16_t* PROJ = (const bf16_t*)(P.ws + WS_PROJ);
    {
        const int cc = tid; const int cidx = cc < 256 ? g * 256 + cc : (cc < 384 ? 2048 + g * 128 + (cc - 256) : 3072 + g * 128 + (cc - 384));
        const float w0 = P.in[14][cidx], w1 = P.in[14][4096 + cidx], w2 = P.in[14][8192 + cidx], w3 = P.in[14][12288 + cidx], bias = P.in[15][cidx];
        const float* hist = P.in[2] + (size_t)b * 3 * 4096 + cidx;
        float x0 = hist[0], x1 = hist[4096], x2 = hist[8192];
        LAS float* dst = cc < 256 ? xs + cc : (cc < 384 ? Bv + (cc - 256) : Cv + (cc - 384)); const int dstride = cc < 256 ? 256 : 128;
#pragma unroll
        for (int t = 0; t < 8; ++t) { const float x3 = bf2f(PROJ[(size_t)(R0 + t) * NPROJ + PC_XBC + cidx]);
            dst[t * dstride] = siluf(bias + w0 * x0 + w1 * x1 + w2 * x2 + w3 * x3); x0 = x1; x1 = x2; x2 = x3; }
        if (tid < 32) { const int hh = tid >> 3, t = tid & 7, hd = 4 * g + hh; dtv[tid] = softplusf(((const float*)(P.ws + WS_DT))[(size_t)(R0 + t) * 32 + hd] + P.in[16][hd]); }
    }
    __syncthreads();
    const int p = tid >> 3, n0 = (tid & 7) * 16;
    for (int hh = 0; hh < 4; ++hh) {
        const int hd = 4 * g + hh; const float a = -__expf(P.in[17][hd]), dsk = P.in[18][hd];
        const size_t sidx = ((size_t)(b * 32 + hd) * 64 + p) * 128 + n0;
        float hst[16];
#pragma unroll
        for (int i = 0; i < 4; ++i) { const f32x4 v = *(const f32x4*)(P.in[3] + sidx + 4 * i); hst[4 * i] = v.x; hst[4 * i + 1] = v.y; hst[4 * i + 2] = v.z; hst[4 * i + 3] = v.w; }
#pragma unroll
        for (int t = 0; t < 8; ++t) { const float dt = dtv[hh * 8 + t], dec = __expf(dt * a), xv = xs[t * 256 + hh * 64 + p], xdt = xv * dt; float yp = 0.f;
#pragma unroll
            for (int i = 0; i < 16; ++i) { hst[i] = hst[i] * dec + xdt * Bv[t * 128 + n0 + i]; yp += Cv[t * 128 + n0 + i] * hst[i]; }
            yp += __shfl_xor(yp, 1); yp += __shfl_xor(yp, 2); yp += __shfl_xor(yp, 4);
            if ((tid & 7) == 0) yv[t * 256 + hh * 64 + p] = yp + dsk * xv; }
#pragma unroll
        for (int i = 0; i < 4; ++i) *(f32x4*)(P.out + O_SSSM + sidx + 4 * i) = (f32x4){hst[4 * i], hst[4 * i + 1], hst[4 * i + 2], hst[4 * i + 3]};
    }
    __syncthreads();
    {
        const int t = wave; float v[4]; float ss = 0.f;
#pragma unroll
        for (int i = 0; i < 4; ++i) { const int ch = lane + 64 * i; const float z = bf2f(PROJ[(size_t)(R0 + t) * NPROJ + g * 256 + ch]); v[i] = yv[t * 256 + ch] * siluf(z); ss += v[i] * v[i]; }
        const float rinv = rsqrtf(wave_sum(ss) * (1.f / 256.f) + EPSN);
#pragma unroll
        for (int i = 0; i < 4; ++i) { const int ch = g * 256 + lane + 64 * i; ((bf16_t*)(P.ws + WS_YMIX))[(size_t)(R0 + t) * 4096 + ch] = (bf16_t)f2bf(v[i] * rinv * P.in[19][ch]); }
    }
    __syncthreads();
}
DEV void phase5(const Params& P, LAS unsigned char* lds, int tid, int lane, int wave) {
    const int G = gridDim.x, bid = blockIdx.x;
    const int gt = bid * NTHREADS + tid, NGT = G * NTHREADS;
#if !defined(ONLY) || ONLY == 5
    for (int it = bid; it < 512; it += G) ssd_out_item(P, lds, it, tid, lane, wave);
#endif
#if !defined(ONLY) || ONLY == 11
    for (int it = bid; it < 256; it += G) ssd_sample_item(P, lds, it, tid, lane, wave);
#endif
}

DEV void rope_stage(const bf16_t* src, const float* ropep  , int c, float scale, LAS bf16_t* dst, float* fout, bool zero) {
    float lo[8], hi[8], o1[8], o2[8];
    if (zero) {
#pragma unroll
        for (int e = 0; e < 8; ++e) { o1[e] = 0.f; o2[e] = 0.f; }
    } else {
        ld8(src + 8 * c, lo); ld8(src + 32 + 8 * c, hi);
        float csA[8], csB[8]; ldf8(ropep + 16 * c, csA); ldf8(ropep + 16 * c + 8, csB);
#pragma unroll
        for (int e = 0; e < 8; ++e) { const float co = e < 4 ? csA[2 * e] : csB[2 * e - 8], si = e < 4 ? csA[2 * e + 1] : csB[2 * e - 7]; o1[e] = (lo[e] * co - hi[e] * si) * scale; o2[e] = (hi[e] * co + lo[e] * si) * scale; }
    }
    *(LAS u32x4*)(dst + 8 * c) = pack8(o1); *(LAS u32x4*)(dst + 32 + 8 * c) = pack8(o2);
    if (fout) {
#pragma unroll
        for (int e = 0; e < 8; ++e) { fout[8 * c + e] = o1[e]; fout[32 + 8 * c + e] = o2[e]; } }
}
DEV void attn_prompt_item(const Params& P, LAS unsigned char* lds, int it, int tid, int lane, int wave) {
    const int hp = it & 1, qb = (it >> 1) & 15, kvh = (it >> 5) & 7, b = it >> 8;
    LAS bf16_t* Ks = (LAS bf16_t*)lds;
    LAS bf16_t* VT = (LAS bf16_t*)(lds + 36864);
    LAS bf16_t* Qs = (LAS bf16_t*)(lds + 70656);
    const bf16_t* QKV = (const bf16_t*)(P.ws + WS_QKV); const float* ROPE = (const float*)(P.ws + WS_ROPE);
    const bool wr_state = (qb == 15 && hp == 0);
    for (int i = 0; i < 2; ++i) { const int q = tid + NTHREADS * i, jj = q >> 2, c = q & 3; const int pos = qb * 128 - 128 + jj; const bool zero = pos < 0;
        const int posc = zero ? 0 : pos;
        float* fo = (wr_state && jj >= 128) ? P.out + O_PK + ((size_t)(b * 128 + (jj - 128)) * 8 + kvh) * 64 : nullptr;
        rope_stage(QKV + (size_t)(b * 2048 + posc) * NQKV + 2048 + kvh * 64, ROPE + (size_t)posc * 64, c, 1.0f, Ks + jj * 72, fo, zero); }
    for (int i = 0; i < 4; ++i) { const int q = tid + NTHREADS * i, jj = q >> 3, c = q & 7; const int pos = qb * 128 - 128 + jj; float v[8];
        if (pos < 0) {
#pragma unroll
            for (int e = 0; e < 8; ++e) v[e] = 0.f;
        } else ld8(QKV + (size_t)(b * 2048 + pos) * NQKV + 2560 + kvh * 64 + 8 * c, v);
#pragma unroll
        for (int e = 0; e < 8; ++e) VT[(8 * c + e) * 264 + jj] = (bf16_t)f2bf(v[e]);
        if (wr_state && jj >= 128) { float* fo = P.out + O_PV + ((size_t)(b * 128 + (jj - 128)) * 8 + kvh) * 64 + 8 * c;
#pragma unroll
            for (int e = 0; e < 8; ++e) fo[e] = v[e]; } }
    for (int i = 0; i < 2; ++i) { const int q = tid + NTHREADS * i, qr = q >> 2, c = q & 3; const int hsel = qr >> 7, qi = qr & 127, head = kvh * 4 + hp * 2 + hsel, pos = qb * 128 + qi;
        rope_stage(QKV + (size_t)(b * 2048 + pos) * NQKV + head * 64, ROPE + (size_t)pos * 64, c, 0.125f, Qs + qr * 72, nullptr, false); }
    __syncthreads();
    const int r = lane & 31, h = lane >> 5;
    const int hsel = wave >> 2, q0 = 32 * (wave & 3), head = kvh * 4 + hp * 2 + hsel;
    f32x16 st[5];
#pragma unroll
    for (int kt = 0; kt < 5; ++kt) { st[kt] = zero16(); mma_tile(st[kt], Ks + (q0 + 32 * kt) * 72, 72, Qs + (hsel * 128 + q0) * 72, 72, 64, lane); }
    const float sink = P.in[30][head];
    float m = sink;
#pragma unroll
    for (int kt = 0; kt < 5; ++kt)
#pragma unroll
        for (int reg = 0; reg < 16; ++reg) { const int dk = 32 * kt + rowmap(reg, h); const bool valid = (dk > r) && (dk <= r + 128);
            st[kt][reg] = valid ? st[kt][reg] : -1e30f; m = fmaxf(m, st[kt][reg]); }
    m = fmaxf(m, __shfl_xor(m, 32));
    float l = 0.f;
#pragma unroll
    for (int kt = 0; kt < 5; ++kt)
#pragma unroll
        for (int reg = 0; reg < 16; ++reg) { const float p = __expf(st[kt][reg] - m); st[kt][reg] = p; l += p; }
    l += __shfl_xor(l, 32);
    l += __expf(sink - m);
    const float linv = 1.f / l;
    bf16_t* O = (bf16_t*)(P.ws + WS_ATTO) + (size_t)(b * 2048 + qb * 128 + q0 + r) * 2048 + head * 64;
#pragma unroll
    for (int dt = 0; dt < 2; ++dt) {
        f32x16 ao = zero16();
#pragma unroll
        for (int kt = 0; kt < 5; ++kt)
#pragma unroll
            for (int s = 0; s < 2; ++s) {
                u32x4 pb; pb.x = pk2(st[kt][8 * s], st[kt][8 * s + 1]); pb.y = pk2(st[kt][8 * s + 2], st[kt][8 * s + 3]); pb.z = pk2(st[kt][8 * s + 4], st[kt][8 * s + 5]); pb.w = pk2(st[kt][8 * s + 6], st[kt][8 * s + 7]);
                const LAS bf16_t* vp = VT + (32 * dt + r) * 264 + q0 + 32 * kt + 16 * s + 4 * h;
                const u32x2 v0 = *(const LAS u32x2*)vp, v1 = *(const LAS u32x2*)(vp + 8);
                u32x4 va; va.x = v0.x; va.y = v0.y; va.z = v1.x; va.w = v1.y;
                ao = __builtin_amdgcn_mfma_f32_32x32x16_bf16(__builtin_bit_cast(bf16x8, va), __builtin_bit_cast(bf16x8, pb), ao, 0, 0, 0);
            }
#pragma unroll
        for (int gq = 0; gq < 4; ++gq) { u32x2 w; w.x = pk2(ao[4 * gq] * linv, ao[4 * gq + 1] * linv); w.y = pk2(ao[4 * gq + 2] * linv, ao[4 * gq + 3] * linv);
            *(u32x2*)(O + 32 * dt + 8 * gq + 4 * h) = w; }
    }
    __syncthreads();
}
DEV void attn_sample_item(const Params& P, LAS unsigned char* lds, int it, int tid, int lane, int wave) {
    const int b = it >> 3, kvh = it & 7;
    LAS float* Kf = (LAS float*)lds;
    LAS float* Vf = Kf + 136 * 65;
    LAS float* Qf = Vf + 136 * 64;
    LAS float* Sc = Qf + 32 * 65;
    const bf16_t* QKV = (const bf16_t*)(P.ws + WS_QKV); const float* ROPE = (const float*)(P.ws + WS_ROPE);
    for (int q = tid; q < 136 * 32; q += NTHREADS) { const int jj = q >> 5, d = q & 31; float k1, k2, v1, v2;
        if (jj < 128) { const size_t o = ((size_t)(b * 128 + jj) * 8 + kvh) * 64; k1 = P.in[6][o + d]; k2 = P.in[6][o + 32 + d]; v1 = P.in[7][o + d]; v2 = P.in[7][o + 32 + d]; }
        else { const int t = jj - 128; const bf16_t* row = QKV + (size_t)(TP + b * 8 + t) * NQKV; const float a = bf2f(row[2048 + kvh * 64 + d]), c2 = bf2f(row[2048 + kvh * 64 + 32 + d]);
            const float co = ROPE[((size_t)(2048 + t) * 32 + d) * 2], si = ROPE[((size_t)(2048 + t) * 32 + d) * 2 + 1];
            k1 = a * co - c2 * si; k2 = c2 * co + a * si; v1 = bf2f(row[2560 + kvh * 64 + d]); v2 = bf2f(row[2560 + kvh * 64 + 32 + d]); }
        Kf[jj * 65 + d] = k1; Kf[jj * 65 + 32 + d] = k2; Vf[jj * 64 + d] = v1; Vf[jj * 64 + 32 + d] = v2;
        if (jj >= 8) { const size_t o = ((size_t)(b * 128 + (jj - 8)) * 8 + kvh) * 64; P.out[O_SK + o + d] = k1; P.out[O_SK + o + 32 + d] = k2; P.out[O_SV + o + d] = v1; P.out[O_SV + o + 32 + d] = v2; } }
    for (int q = tid; q < 32 * 32; q += NTHREADS) { const int qr = q >> 5, d = q & 31, hq = qr >> 3, t = qr & 7, head = kvh * 4 + hq; const bf16_t* row = QKV + (size_t)(TP + b * 8 + t) * NQKV + head * 64;
        const float a = bf2f(row[d]), c2 = bf2f(row[32 + d]); const float co = ROPE[((size_t)(2048 + t) * 32 + d) * 2], si = ROPE[((size_t)(2048 + t) * 32 + d) * 2 + 1];
        Qf[qr * 65 + d] = (a * co - c2 * si) * 0.125f; Qf[qr * 65 + 32 + d] = (c2 * co + a * si) * 0.125f; }
    __syncthreads();
    const int qr = tid >> 4, kl = tid & 15, t = qr & 7, head = kvh * 4 + (qr >> 3);
    const float sink = P.in[30][head];
    float m = sink;
    for (int i = 0; i < 9; ++i) { const int jj = kl + 16 * i; if (jj < 136) { float s = 0.f;
#pragma unroll 16
            for (int d = 0; d < 64; ++d) s += Qf[qr * 65 + d] * Kf[jj * 65 + d];
            const bool valid = jj < 128 ? (jj >= t + 1) : ((jj - 128) <= t);
            s = valid ? s : -1e30f; Sc[qr * 136 + jj] = s; m = fmaxf(m, s); } }
    m = fmaxf(m, __shfl_xor(m, 1)); m = fmaxf(m, __shfl_xor(m, 2)); m = fmaxf(m, __shfl_xor(m, 4)); m = fmaxf(m, __shfl_xor(m, 8));
    float l = 0.f;
    for (int i = 0; i < 9; ++i) { const int jj = kl + 16 * i; if (jj < 136) { const float p = __expf(Sc[qr * 136 + jj] - m); Sc[qr * 136 + jj] = p; l += p; } }
    l += __shfl_xor(l, 1); l += __shfl_xor(l, 2); l += __shfl_xor(l, 4); l += __shfl_xor(l, 8);
    l += __expf(sink - m);
    __syncthreads();
    f32x4 o = (f32x4){0.f, 0.f, 0.f, 0.f};
    for (int jj = 0; jj < 136; ++jj) { const float p = Sc[qr * 136 + jj]; const f32x4 v = *(const LAS f32x4*)(Vf + jj * 64 + 4 * kl); o = o + v * p; }
    const float linv = 1.f / l;
    u32x2 w; w.x = pk2(o.x * linv, o.y * linv); w.y = pk2(o.z * linv, o.w * linv);
    *(u32x2*)((bf16_t*)(P.ws + WS_ATTO) + (size_t)(TP + b * 8 + t) * 2048 + head * 64 + 4 * kl) = w;
    __syncthreads();
}

DEV void gemm_to_mix(const Params& P, LAS unsigned char* lds, const bf16_t* A, const bf16_t* Bt, int K) {
    const int G = gridDim.x, bid = blockIdx.x;
    { pg8::Gemm g{A, Bt, K, K, K}; pg8::StaticOrder S; S.init(TP, DM, G, bid); pg8::EpiBf16<3> E{(bf16_t*)(P.ws + WS_MIX), DM, nullptr, nullptr, -1}; pg8::gemm_phase(lds, g, S, E); }
    { pg8::Gemm g{A + (size_t)TP * K, Bt, 256, K, K}; pg8::SplitKOrder S{8, K / 256, 256, G, bid}; pg8::EpiF32 E{(float*)(P.ws + WS_PART), DM, 256}; pg8::gemm_phase(lds, g, S, E); }
}

__global__ void __launch_bounds__(NTHREADS, 2) hybrid_fwd(Params P) {
    extern __shared__ __attribute__((aligned(16))) unsigned char lds_raw[];
    LAS unsigned char* lds = (LAS unsigned char*)lds_raw;
    cg::grid_group grid = cg::this_grid();
    const int tid0 = threadIdx.x;
    const int G = gridDim.x, bid = blockIdx.x;
    unsigned char* ws = P.ws;
    if (tid0 < 16) ((LAS unsigned*)(lds + 147456))[tid0] = 0u;
    __syncthreads();
    const XcdBarrier bar = xcd_barrier_post((unsigned*)(ws + WS_BAR), (volatile LAS unsigned*)(lds + 147456));
    if (G == 0x7ffffff) grid.sync();
#define GSYNC() xcd_barrier(bar)

#define LAUNDER() int tid = tid0; asm volatile("" : "+v"(tid)); const int lane = tid & 63, wave = __builtin_amdgcn_readfirstlane(tid >> 6)
#ifndef ONLY
#define PH(k) true
#else
#define PH(k) ((k) == ONLY)
#endif
    REP(16) { for (int i_ = 0; i_ < ((DBL) == 16 ? 10 : 0); ++i_) GSYNC(); }
    if (PH(0)) REP(0) { LAUNDER(); phase0(P, lds, tid, lane, wave); }
    GSYNC();
    if (PH(1)) REP(1) { LAUNDER(); norm_phase(P, lds, true, false, 0, 0, 0,   0, 0,   0,   1, 0, lane, wave); }
    GSYNC();
    if (PH(2)) REP(2) {
        pg8::Gemm g{(const bf16_t*)(ws + WS_H), (const bf16_t*)(ws + WS_WIN), DM, DM, DM}; pg8::StaticOrder S; S.init(TT, NPROJ, G, bid);
        pg8::EpiBf16<0> E{(bf16_t*)(ws + WS_PROJ), NPROJ, nullptr, (float*)(ws + WS_DT), 40}; pg8::gemm_phase(lds, g, S, E);
        const int nbusy = (33 * 41) % G;
        if (TAILS && bid >= nbusy) { LAUNDER(); const int widx = (bid - nbusy) * 8 + wave, nw = (G - nbusy) * 8;
            if (G <= 192) transpose_range(P, lds, 5152, 7200, widx, 1, nw, lane, wave);
            transpose_range(P, lds, 9760, 13856, widx, 1, nw, lane, wave); }
    }
    GSYNC();
    if (PH(3)) REP(3) { LAUNDER(); phase3(P, lds, tid, lane, wave); }
    GSYNC();
    if (PH(4)) REP(4) { LAUNDER(); phase4(P, lds, tid, lane, wave); }
    GSYNC();
    if (PH(5) || PH(11)) REP(5) { LAUNDER(); phase5(P, lds, tid, lane, wave); }
    GSYNC();
    if (PH(6)) REP(6) gemm_to_mix(P, lds, (const bf16_t*)(ws + WS_YMIX), (const bf16_t*)(ws + WS_WOH), 4096);
    GSYNC();
    for (int layer = 0; layer < 2; ++layer) {
        if (PH(1)) { LAUNDER(); norm_phase(P, lds, false, false, layer, 1, 2, layer, 2, 3, 4, layer == 0 ? 16 : 8, lane, wave, 1.f, layer == 0); }
        if (DBL == 30) { GSYNC(); LAUNDER(); norm_phase(P, lds, false, false, layer, 1, 2, layer, 2, 3, 4, layer == 0 ? 16 : 8, lane, wave, 0.f, false); }
        GSYNC();
        if (PH(7)) REP(7) {
            pg8::Gemm g{(const bf16_t*)(ws + WS_H), (const bf16_t*)(ws + WS_WUP) + (size_t)layer * DFF * DM, DM, DM, DM}; pg8::StaticOrder S; S.init(TT, DFF, G, bid);
            pg8::EpiBf16<1> E{(bf16_t*)(ws + WS_UP), DFF, nullptr, nullptr, -1}; pg8::gemm_phase(lds, g, S, E);
            const int nbusy = (33 * 32) % G;
            if (TAILS && bid >= nbusy) { LAUNDER(); const int widx = (bid - nbusy) * 8 + wave, nw = (G - nbusy) * 8;
                if (layer == 0) { transpose_range(P, lds, 17952, 22048, widx, 1, nw, lane, wave); transpose_range(P, lds, 7200, 9760, widx, 1, nw, lane, wave); }
                else transpose_range(P, lds, 22048, 26144, widx, 1, nw, lane, wave); }
        }
        GSYNC();
        if (PH(6)) REP(12) gemm_to_mix(P, lds, (const bf16_t*)(ws + WS_UP), (const bf16_t*)(ws + WS_WDN) + (size_t)layer * DM * DFF, DFF);
        GSYNC();
        if (layer == 0) {
            if (PH(1)) { LAUNDER(); norm_phase(P, lds, false, false, 0, 3, 5, 1, 0, 0, 1, 32, lane, wave); }
            if (DBL == 30) { GSYNC(); LAUNDER(); norm_phase(P, lds, false, false, 0, 3, 5, 1, 0, 0, 1, 32, lane, wave, 0.f); }
            GSYNC();
            if (PH(8)) REP(8) {
                pg8::Gemm g{(const bf16_t*)(ws + WS_H), (const bf16_t*)(ws + WS_WQKV), DM, DM, DM}; pg8::StaticOrder S; S.init(TT, NQKV, G, bid);
                pg8::EpiBf16<2> E{(bf16_t*)(ws + WS_QKV), NQKV, P.in[29], nullptr, -1}; pg8::gemm_phase(lds, g, S, E);
                const int nbusy = (33 * 12) % G;
                if (TAILS && bid >= nbusy) { LAUNDER(); const int widx = (bid - nbusy) * 8 + wave, nw = (G - nbusy) * 8;
                    transpose_range(P, lds, 13856, 17952, widx, 1, nw, lane, wave); }
            }
            GSYNC();
            if (PH(9)) REP(9) { LAUNDER(); for (int it = bid; it < 1024; it += G) attn_prompt_item(P, lds, it, tid, lane, wave); }
            if (PH(10)) REP(10) { LAUNDER(); for (int it = bid; it < 256; it += G) attn_sample_item(P, lds, it, tid, lane, wave); }
            GSYNC();
            if (PH(6)) REP(13) gemm_to_mix(P, lds, (const bf16_t*)(ws + WS_ATTO), (const bf16_t*)(ws + WS_WOA), DM);
            GSYNC();
        } else {
            if (PH(1)) { LAUNDER(); norm_phase(P, lds, false, true, 1, 3, 5, 0, 0, 0, 0, 32, lane, wave); }
        }
    }
}

extern "C" void kernel_launch(void* const* d_in, const int* in_sizes, int n_in, void* d_out, int out_size, void* d_ws, size_t ws_size, hipStream_t stream) {
    static int inited = 0;
    if (!inited) { (void)hipFuncSetAttribute((const void*)hybrid_fwd, hipFuncAttributeMaxDynamicSharedMemorySize, LDS_BYTES); inited = 1; }
    (void)hipMemsetAsync((char*)d_ws + WS_BAR, 0, 16384, stream);
    Params p{};
    for (int i = 0; i < 34; ++i) p.in[i] = (const float*)d_in[i];
    p.out = (float*)d_out; p.ws = (unsigned char*)d_ws;
    void* args[] = {&p};
    (void)hipLaunchCooperativeKernel((const void*)hybrid_fwd, dim3(256), dim3(NTHREADS), args, LDS_BYTES, stream);
}
```

```cpp
#include <hip/hip_runtime.h>
#include <hip/hip_cooperative_groups.h>
namespace cg = cooperative_groups;

#define LAS __attribute__((address_space(3)))
#define DEV __device__ __forceinline__
typedef unsigned short bf16_t;
typedef short bf16x8 __attribute__((ext_vector_type(8)));
typedef short bf16x4 __attribute__((ext_vector_type(4)));
typedef float f32x2 __attribute__((ext_vector_type(2)));
typedef float f32x4 __attribute__((ext_vector_type(4)));
typedef float f32x16 __attribute__((ext_vector_type(16)));
typedef unsigned u32x2 __attribute__((ext_vector_type(2)));
typedef unsigned u32x4 __attribute__((ext_vector_type(4)));

constexpr int TP = 8192, TS = 256, TT = TP + TS, DM = 2048, NPROJ = 10496, DFF = 8192, NQKV = 3072;
constexpr int PC_XBC = 2048, PC_GATE = 6144, PC_XR = 8192;
constexpr float EPSN = 1e-6f;
constexpr size_t MiB = 1u << 20;
constexpr size_t WS_CDEC = 0, WS_ROPE = 1 * MiB, WS_MOD = 2 * MiB, WS_WIN = 6 * MiB, WS_WOH = 47 * MiB, WS_WQKV = 63 * MiB, WS_WOA = 75 * MiB, WS_WUP = 83 * MiB,
                 WS_WDN = 147 * MiB, WS_WLRU = 211 * MiB, WS_DT = 213 * MiB, WS_H = 215 * MiB, WS_A = 248 * MiB, WS_B = 418 * MiB, WS_YMIX = 550 * MiB, WS_MIX = 616 * MiB;
constexpr size_t WS_X16 = 682 * MiB;
constexpr size_t WS_PART = WS_B, WS_AU_U = WS_B + 66 * MiB, WS_QKV = WS_B, WS_ATTO = WS_B + 50 * MiB, WS_CS = WS_MIX, WS_HIN = WS_H, WS_PROJ = WS_A, WS_UP = WS_A;
constexpr size_t O_YP = 0, O_YS = O_YP + (size_t)4 * 2048 * 2048, O_PSC = O_YS + 32 * 8 * 2048, O_PSSM = O_PSC + 4 * 3 * 4096, O_PLC = O_PSSM + (size_t)4 * 32 * 64 * 128,
                 O_PL = O_PLC + 4 * 3 * 2048, O_PK = O_PL + 4 * 2048, O_PV = O_PK + 4 * 128 * 8 * 64, O_SSC = O_PV + 4 * 128 * 8 * 64, O_SSSM = O_SSC + 32 * 3 * 4096,
                 O_SLC = O_SSSM + (size_t)32 * 32 * 64 * 128, O_SL = O_SLC + 32 * 3 * 2048, O_SK = O_SL + 32 * 2048, O_SV = O_SK + (size_t)32 * 128 * 8 * 64;
constexpr int LDS_BYTES = 147456 + 64;
constexpr size_t WS_BAR = 65536;
constexpr int NTHREADS = 512;

#ifndef DBL
#define DBL -1
#endif
#ifndef TAILS
#define TAILS 1
#endif
#define REP(k) for (int rep_ = 0; rep_ < ((DBL) == (k) ? 2 : 1); ++rep_, __syncthreads())
struct Params { const float* in[34]; float* out; unsigned char* ws; };

DEV unsigned f2bf(float f) { unsigned u = __float_as_uint(f); return (u + 0x7fffu + ((u >> 16) & 1u)) >> 16; }
DEV unsigned pk2(float lo, float hi) { return f2bf(lo) | (f2bf(hi) << 16); }
DEV float bf2f(unsigned short b) { return __uint_as_float(((unsigned)b) << 16); }
DEV float bflo(unsigned w) { return __uint_as_float(w << 16); }
DEV float bfhi(unsigned w) { return __uint_as_float(w & 0xffff0000u); }
DEV float sigm(float x) { return 1.f / (1.f + __expf(-x)); }
DEV float siluf(float x) { return x * sigm(x); }
DEV float softplusf(float x) { return x > 20.f ? x : log1pf(__expf(x)); }
DEV float geluf(float x) { return x * sigm(1.5957691216057308f * (x + 0.044715f * x * x * x)); }
DEV float wave_sum(float v) {
#pragma unroll
    for (int o = 1; o < 64; o <<= 1) v += __shfl_xor(v, o);
    return v;
}
DEV void ld8(const bf16_t* p, float (&v)[8]) {
    const u32x4 w = *(const u32x4*)p;
    v[0] = bflo(w.x); v[1] = bfhi(w.x); v[2] = bflo(w.y); v[3] = bfhi(w.y); v[4] = bflo(w.z); v[5] = bfhi(w.z); v[6] = bflo(w.w); v[7] = bfhi(w.w);
}
DEV void ldf8(const float* p, float (&v)[8]) {
    const f32x4 a = *(const f32x4*)p, b = *(const f32x4*)(p + 4);
    v[0] = a.x; v[1] = a.y; v[2] = a.z; v[3] = a.w; v[4] = b.x; v[5] = b.y; v[6] = b.z; v[7] = b.w;
}
DEV u32x4 pack8(const float (&v)[8]) { u32x4 w; w.x = pk2(v[0], v[1]); w.y = pk2(v[2], v[3]); w.z = pk2(v[4], v[5]); w.w = pk2(v[6], v[7]); return w; }
DEV int rowmap(int reg, int h) { return (reg & 3) + 8 * (reg >> 2) + 4 * h; }
#define LDS_WAIT() asm volatile("s_waitcnt lgkmcnt(0)" ::: "memory")

DEV void conv8(const bf16_t* PROJ, int r, int tl, int pcol, const float* hist, int C, const float (&w)[4][8], const float (&bias)[8], float (&o)[8]) {
#pragma unroll
    for (int e = 0; e < 8; ++e) o[e] = bias[e];
#pragma unroll
    for (int d = 0; d < 4; ++d) {
        float v[8];
        if (tl - d >= 0) ld8(PROJ + (size_t)(r - d) * NPROJ + pcol, v);
        else if (hist) ldf8(hist + (size_t)(3 + tl - d) * C, v);
        else {
#pragma unroll
            for (int e = 0; e < 8; ++e) v[e] = 0.f;
        }
#pragma unroll
        for (int e = 0; e < 8; ++e) o[e] += w[3 - d][e] * v[e];
    }
}
DEV void ldconvw(const float* W, const float* B, int C, int c0, float (&w)[4][8], float (&bias)[8]) {
#pragma unroll
    for (int j = 0; j < 4; ++j) ldf8(W + (size_t)j * C + c0, w[j]);
    ldf8(B + c0, bias);
}
DEV void mma_tile(f32x16& acc, const LAS bf16_t* A, int lda, const LAS bf16_t* B, int ldb, int K, int lane) {
    const int r = lane & 31, h = lane >> 5;
    const LAS bf16_t* ap = A + r * lda + 8 * h; const LAS bf16_t* bp = B + r * ldb + 8 * h;
    for (int k = 0; k < K; k += 16) {
        const bf16x8 a = *(const LAS bf16x8*)(ap + k); const bf16x8 b = *(const LAS bf16x8*)(bp + k);
        acc = __builtin_amdgcn_mfma_f32_32x32x16_bf16(a, b, acc, 0, 0, 0);
    }
}
DEV f32x16 zero16() { f32x16 z;
#pragma unroll
    for (int i = 0; i < 16; ++i) z[i] = 0.f;
    return z; }

#define XB_TMO      128
#define XB_XCNT(j)  (256  + 64 * (j))
#define XB_XSUB(j)  (1280 + 64 * (j))
#define XB_XGEN(j)  (2304 + 64 * (j))
#define XB_TOP      3328
#define XB_TOPGEN   3392
#define XCD_BAR_WORDS 3456
#define XB_SPIN_CAP (1u << 18)

__device__ __forceinline__ unsigned xb_ld(unsigned* p)              { return __hip_atomic_load(p, __ATOMIC_RELAXED, __HIP_MEMORY_SCOPE_AGENT); }
__device__ __forceinline__ unsigned xb_add(unsigned* p, unsigned v) { return __hip_atomic_fetch_add(p, v, __ATOMIC_RELAXED, __HIP_MEMORY_SCOPE_AGENT); }
__device__ __forceinline__ unsigned xb_xcc_id() { return (unsigned)__builtin_amdgcn_s_getreg((3 << 11) | 20) & 0xFu; }
#define XB_SPIN(cond, bar) do { unsigned _sp = 0; while (cond) { __builtin_amdgcn_s_sleep(1); \
    if ((++_sp & 255u) == 0u) { if (xb_ld(&(bar)[XB_TMO])) break; if (_sp > XB_SPIN_CAP) { atomicAdd(&(bar)[XB_TMO], 1u); break; } } } } while (0)

struct XcdBarrier {
    unsigned* bar; unsigned x;
    volatile LAS unsigned* st;
};

__device__ __forceinline__ XcdBarrier xcd_barrier_post(unsigned* bar, volatile LAS unsigned* st) {
    XcdBarrier b; b.bar = bar; b.x = xb_xcc_id(); b.st = st;
    if (threadIdx.x == 0) (void)xb_add(&bar[XB_XCNT(b.x)], 1u);
    return b;
}
__device__ __forceinline__ void xcd_barrier_complete(unsigned* bar, unsigned x, unsigned& nloc, unsigned& nx) {
    const unsigned G = gridDim.x * gridDim.y * gridDim.z;
    unsigned sum, cnt, mine, sp = 0u;
    for (;;) {
        sum = 0u; cnt = 0u; mine = 0u;
#pragma unroll
        for (unsigned j = 0; j < 16; ++j) { const unsigned c = xb_ld(&bar[XB_XCNT(j)]); sum += c; cnt += (c > 0u) ? 1u : 0u; mine = (j == x) ? c : mine; }
        if (sum == G) break;
        __builtin_amdgcn_s_sleep(1);
        if ((++sp & 255u) == 0u) { if (xb_ld(&bar[XB_TMO])) break; if (sp > XB_SPIN_CAP) { atomicAdd(&bar[XB_TMO], 1u); break; } }
    }
    nloc = mine > 0u ? mine : 1u; nx = cnt > 0u ? cnt : 1u;
}

__device__ __forceinline__ void xcd_barrier(const XcdBarrier& b) {
    asm volatile("s_waitcnt vmcnt(0)" ::: "memory");
    __syncthreads();
    if (threadIdx.x == 0) {
        unsigned* bar = b.bar;
        __builtin_amdgcn_s_waitcnt(0);
        unsigned nloc = b.st[0], nx = b.st[1];
        if (nloc == 0u) { xcd_barrier_complete(bar, b.x, nloc, nx); b.st[0] = nloc; b.st[1] = nx; }
        const unsigned old = xb_add(&bar[XB_XSUB(b.x)], 1u);
        const unsigned gen = old / nloc;
        if (old + 1u == (gen + 1u) * nloc) {
            __builtin_amdgcn_fence(__ATOMIC_RELEASE, "agent");
            asm volatile("s_waitcnt vmcnt(0)" ::: "memory");
            const unsigned og = xb_add(&bar[XB_TOP], 1u);
            const unsigned tg = og / nx;
            if (og + 1u == (tg + 1u) * nx) xb_add(&bar[XB_TOPGEN], 1u);
            else XB_SPIN(xb_ld(&bar[XB_TOPGEN]) == tg, bar);
            __builtin_amdgcn_fence(__ATOMIC_ACQUIRE, "agent");
            xb_add(&bar[XB_XGEN(b.x)], 1u);
            asm volatile("s_waitcnt vmcnt(0)" ::: "memory");
        } else {
            XB_SPIN(xb_ld(&bar[XB_XGEN(b.x)]) == gen, bar);
            __builtin_amdgcn_fence(__ATOMIC_ACQUIRE, "agent");
            asm volatile("s_waitcnt vmcnt(0)" ::: "memory");
        }
    }
    __syncthreads();
}

namespace pg8 {
constexpr int BM = 256, BK = 64, HALF = 128, HTB = HALF * BK * 2, NXCD = 8, WGM = 8;
__host__ __device__ __forceinline__ int lds_byte(int r, int c) { const int st = (r >> 4) * 2 + (c >> 5), rr = r & 15, cc = c & 31, ob = rr * 64 + cc * 2; return st * 1024 + (ob ^ (((ob >> 9) & 1) << 5)); }
__host__ __device__ __forceinline__ void stage_rc(int b, int& R, int& C) { const int st = b / 1024, sb = b % 1024, swz = sb ^ (((sb >> 9) & 1) << 5); R = (st >> 1) * 16 + swz / 64; C = (st & 1) * 32 + (swz % 64) / 2; }
__host__ __device__ __forceinline__ int perm32(int rho) { const int n = rho >> 4, i = rho & 15; return 8 * (i >> 2) + 4 * n + (i & 3); }
struct Unit { int pm, pn, k0; };
struct Gemm { const bf16_t* A; const bf16_t* Bt; int K, lda, ldb; };
struct StaticOrder {
    int nM, nN, nwg, G, c;
    __device__ void init(int M, int N, int G_, int c_) { nM = M / BM; nN = N / BM; nwg = nM * nN; G = G_; c = c_; }
    __device__ bool next(int i, Unit& u) const {
        const long L = (long)i * G + c; if (L >= nwg) return false;
        int wgid = (int)L; { const int q = nwg / NXCD, r = nwg % NXCD, xcd = wgid % NXCD, off = wgid / NXCD; wgid = (xcd < r ? xcd * (q + 1) : r * (q + 1) + (xcd - r) * q) + off; }
        const int nig = WGM * nN, gid = wgid / nig, fm = gid * WGM, gsz = (nM - fm) < WGM ? (nM - fm) : WGM;
        u.pm = fm + ((wgid % nig) % gsz); u.pn = (wgid % nig) / gsz; u.k0 = 0; return true;
    }
};
struct SplitKOrder {
    int nN, nsplit, Kc, G, c;
    __device__ bool next(int i, Unit& u) const { const long L = (long)i * G + c; if (L >= (long)nN * nsplit) return false; u.pm = 0; u.pn = (int)(L % nN); u.k0 = (int)(L / nN) * Kc; return true; }
};
DEV unsigned cvt_pk_bf16(float lo, float hi) { unsigned r; asm volatile("v_cvt_pk_bf16_f32 %0, %1, %2" : "=v"(r) : "v"(lo), "v"(hi)); return r; }

struct EpiF32 {
    static constexpr bool PERM = false;
    float* C; int ldc; int kc;
    DEV void operator()(const f32x4 (&acc)[2][2][4][2], const Unit& u, int wr, int wc, int fr, int fq) const {
        float* Cb = C + (kc > 0 ? (size_t)(u.k0 / kc) * 256 * ldc : (size_t)0);
        const unsigned base = (unsigned)((u.pm * BM + wr * 64 + fr) * ldc + u.pn * BM + wc * 32 + 4 * fq);
#pragma unroll
        for (int ai = 0; ai < 2; ++ai)
#pragma unroll
            for (int m = 0; m < 4; ++m) { const unsigned o = base + (unsigned)((ai * HALF + m * 16) * ldc);
#pragma unroll
                for (int bj = 0; bj < 2; ++bj)
#pragma unroll
                    for (int n = 0; n < 2; ++n) *(f32x4*)(Cb + o + bj * HALF + n * 16) = acc[ai][bj][m][n];
                asm volatile("" ::: "memory"); }
    }
};
template <int MODE  > struct EpiBf16 {
    static constexpr bool PERM = true;
    bf16_t* O; int ldc; const float* bias; float* DT; int dt_pn;
    DEV void operator()(const f32x4 (&acc)[2][2][4][2], const Unit& u, int wr, int wc, int fr, int fq) const {
        const int row0 = u.pm * BM + wr * 64 + fr; const int col0 = u.pn * BM + wc * 32 + 8 * fq;
        if (MODE == 0 && u.pn == dt_pn) {
            if (wc == 0) {
#pragma unroll
                for (int ai = 0; ai < 2; ++ai)
#pragma unroll
                    for (int m = 0; m < 4; ++m) { float* rowp = DT + (size_t)(row0 + ai * HALF + m * 16) * 32 + 8 * fq;
                        *(f32x4*)(rowp) = acc[ai][0][m][0]; *(f32x4*)(rowp + 4) = acc[ai][0][m][1]; }
            }
            return;
        }
        f32x4 bv[2][2];
#pragma unroll
        for (int bj = 0; bj < 2; ++bj)
#pragma unroll
            for (int n = 0; n < 2; ++n) bv[bj][n] = (MODE == 2) ? *(const f32x4*)(bias + col0 + bj * HALF + 4 * n) : (f32x4){0.f, 0.f, 0.f, 0.f};
#pragma unroll
        for (int ai = 0; ai < 2; ++ai)
#pragma unroll
            for (int m = 0; m < 4; ++m) { bf16_t* rowp = O + (size_t)(row0 + ai * HALF + m * 16) * ldc + col0;
#pragma unroll
                for (int bj = 0; bj < 2; ++bj) { f32x4 v0 = acc[ai][bj][m][0] + bv[bj][0], v1 = acc[ai][bj][m][1] + bv[bj][1];
                    if (MODE == 1) {
#pragma unroll
                        for (int j = 0; j < 4; ++j) { const float a = fmaxf(v0[j], 0.f), b = fmaxf(v1[j], 0.f); v0[j] = a * a; v1[j] = b * b; } }
                    u32x4 w; w.x = cvt_pk_bf16(v0[0], v0[1]); w.y = cvt_pk_bf16(v0[2], v0[3]); w.z = cvt_pk_bf16(v1[0], v1[1]); w.w = cvt_pk_bf16(v1[2], v1[3]);
                    *(u32x4*)(rowp + bj * HALF) = w; } }
    }
};

template <class Epi, class Sched>
DEV void gemm_phase(LAS unsigned char* lds, const Gemm g, const Sched& S, const Epi& E) {
    int tid_l = threadIdx.x; asm volatile("" : "+v"(tid_l));
    const int tid = tid_l, wid = __builtin_amdgcn_readfirstlane(tid >> 6), lane = tid & 63, wr = wid >> 2, wc = wid & 3, fr = lane & 15, fq = lane >> 4;
    const int nt = g.K / BK;
    unsigned voffA[2], voffB[2];
#pragma unroll
    for (int i = 0; i < 2; ++i) { int R, C; stage_rc(tid * 16 + i * 8192, R, C); const int Rb = Epi::PERM ? ((R & ~31) + perm32(R & 31)) : R;
        voffA[i] = (unsigned)(R * g.lda + C) * 2u; voffB[i] = (unsigned)(Rb * g.ldb + C) * 2u; }
    const size_t kstep = (size_t)(BK * 2);
    const size_t hsA = (size_t)HALF * g.lda * 2, hsB = (size_t)HALF * g.ldb * 2;
    const size_t tsA = 2 * hsA, tsB = 2 * hsB;
    const unsigned ldsw = (unsigned)wid * 1024u;
    const int aoff = lds_byte(wr * 64 + fr, fq * 8), boff = lds_byte(wc * 32 + fr, fq * 8);
#define PG8_SA(b, h) (((b) * 2 + (h)) * HTB)
#define PG8_SB(b, h) ((4 + (b) * 2 + (h)) * HTB)
#define PG8_STAGE(bufoff, gbase, voff) do { _Pragma("unroll") for (int _i = 0; _i < 2; ++_i) \
        __builtin_amdgcn_global_load_lds((const unsigned*)((const char*)(gbase) + (voff)[_i]), (LAS unsigned*)(lds + (bufoff) + ldsw + _i * 8192), 16, 0, 0); } while (0)
#define PG8_LDA(dst, b, h) do { _Pragma("unroll") for (int m = 0; m < 4; ++m) _Pragma("unroll") for (int k = 0; k < 2; ++k) dst[m][k] = *(const LAS bf16x8*)(lds + PG8_SA(b, h) + aoff + m * 2048 + k * 1024); } while (0)
#define PG8_LDB(dst, b, h) do { _Pragma("unroll") for (int n = 0; n < 2; ++n) _Pragma("unroll") for (int k = 0; k < 2; ++k) dst[n][k] = *(const LAS bf16x8*)(lds + PG8_SB(b, h) + boff + n * 2048 + k * 1024); } while (0)
#define PG8_MMA(ai, bj, At, Bt) do { __builtin_amdgcn_s_setprio(1); _Pragma("unroll") for (int m = 0; m < 4; ++m) _Pragma("unroll") for (int n = 0; n < 2; ++n) _Pragma("unroll") for (int k = 0; k < 2; ++k) \
        acc[ai][bj][m][n] = __builtin_amdgcn_mfma_f32_16x16x32_bf16(Bt[n][k], At[m][k], acc[ai][bj][m][n], 0, 0, 0); __builtin_amdgcn_s_setprio(0); } while (0)
#define PG8_WAIT_V(n) asm volatile("s_waitcnt vmcnt(" #n ")" ::: "memory")
#define PG8_WAIT_L(n) asm volatile("s_waitcnt lgkmcnt(" #n ")" ::: "memory")
#define PG8_BAR __builtin_amdgcn_s_barrier()
#define PG8_SCHED __builtin_amdgcn_sched_barrier(0)
    Unit cur, nxt; int ui = 0;
    if (!S.next(0, cur)) return;
    f32x4 acc[2][2][4][2];
#pragma unroll
    for (int a = 0; a < 2; ++a)
#pragma unroll
        for (int b = 0; b < 2; ++b)
#pragma unroll
            for (int m = 0; m < 4; ++m)
#pragma unroll
                for (int n = 0; n < 2; ++n) acc[a][b][m][n] = (f32x4){0.f, 0.f, 0.f, 0.f};
    bf16x8 At[4][2], B0[2][2], B1[2][2];
    const char* cA = (const char*)g.A + (size_t)cur.pm * tsA + (size_t)cur.k0 * 2; const char* cB = (const char*)g.Bt + (size_t)cur.pn * tsB + (size_t)cur.k0 * 2;
    PG8_STAGE(PG8_SB(0, 0), cB, voffB); PG8_STAGE(PG8_SA(0, 0), cA, voffA); PG8_STAGE(PG8_SB(0, 1), cB + hsB, voffB); PG8_STAGE(PG8_SA(0, 1), cA + hsA, voffA);
    if (wr == 1) PG8_BAR;
    PG8_WAIT_V(4); PG8_BAR;
    PG8_STAGE(PG8_SB(1, 0), cB + kstep, voffB); PG8_STAGE(PG8_SA(1, 0), cA + kstep, voffA); PG8_STAGE(PG8_SB(1, 1), cB + hsB + kstep, voffB);
    PG8_WAIT_V(6); PG8_BAR;
    for (;;) {
        const bool has_next = S.next(ui + 1, nxt);
        const char* nA = has_next ? (const char*)g.A + (size_t)nxt.pm * tsA + (size_t)nxt.k0 * 2 : cA; const char* nB = has_next ? (const char*)g.Bt + (size_t)nxt.pn * tsB + (size_t)nxt.k0 * 2 : cB;
        for (int t = 0; t < nt; t += 2) {
            const bool last = (t == nt - 2);
            const char* a1 = cA + (size_t)(t + 1) * kstep;
            const char* a2 = last ? nA : cA + (size_t)(t + 2) * kstep; const char* b2 = last ? nB : cB + (size_t)(t + 2) * kstep;
            const char* a3 = a2 + kstep; const char* b3 = b2 + kstep;
            PG8_LDB(B0, 0, 0); PG8_SCHED; PG8_LDA(At, 0, 0); PG8_STAGE(PG8_SA(1, 1), a1 + hsA, voffA);
            PG8_WAIT_L(8); PG8_BAR; PG8_WAIT_L(0); PG8_MMA(0, 0, At, B0); PG8_BAR; PG8_SCHED;
            PG8_LDB(B1, 0, 1); PG8_STAGE(PG8_SB(0, 0), b2, voffB);
            PG8_BAR; PG8_WAIT_L(0); PG8_MMA(0, 1, At, B1); PG8_BAR;
            PG8_LDA(At, 0, 1); PG8_STAGE(PG8_SA(0, 0), a2, voffA);
            PG8_BAR; PG8_WAIT_L(0); PG8_MMA(1, 0, At, B0); PG8_BAR; PG8_SCHED;
            PG8_STAGE(PG8_SB(0, 1), b2 + hsB, voffB);
            PG8_WAIT_V(6); PG8_BAR; PG8_MMA(1, 1, At, B1); PG8_BAR;
            PG8_LDB(B0, 1, 0); PG8_SCHED; PG8_LDA(At, 1, 0); PG8_STAGE(PG8_SA(0, 1), a2 + hsA, voffA);
            PG8_WAIT_L(8); PG8_BAR; PG8_WAIT_L(0); PG8_MMA(0, 0, At, B0); PG8_BAR; PG8_SCHED;
            PG8_LDB(B1, 1, 1); PG8_STAGE(PG8_SB(1, 0), b3, voffB);
            PG8_BAR; PG8_WAIT_L(0); PG8_MMA(0, 1, At, B1); PG8_BAR;
            PG8_LDA(At, 1, 1); PG8_STAGE(PG8_SA(1, 0), a3, voffA);
            PG8_BAR; PG8_WAIT_L(0); PG8_MMA(1, 0, At, B0); PG8_BAR; PG8_SCHED;
            PG8_STAGE(PG8_SB(1, 1), b3 + hsB, voffB);
            PG8_WAIT_V(6); PG8_BAR; PG8_MMA(1, 1, At, B1); PG8_BAR;
        }
        E(acc, cur, wr, wc, fr, fq);
        if (!has_next) break;
#pragma unroll
        for (int a = 0; a < 2; ++a)
#pragma unroll
            for (int b = 0; b < 2; ++b)
#pragma unroll
                for (int m = 0; m < 4; ++m)
#pragma unroll
                    for (int n = 0; n < 2; ++n) acc[a][b][m][n] = (f32x4){0.f, 0.f, 0.f, 0.f};
        cur = nxt; cA = nA; cB = nB; ++ui;
    }
    PG8_WAIT_V(0);
    if (wr == 0) PG8_BAR;
    PG8_BAR;
#undef PG8_SA
#undef PG8_SB
#undef PG8_STAGE
#undef PG8_LDA
#undef PG8_LDB
#undef PG8_MMA
#undef PG8_WAIT_V
#undef PG8_WAIT_L
#undef PG8_BAR
#undef PG8_SCHED
}
}

DEV void mod_item(const Params& P, LAS unsigned char* lds, int item, int tid, int lane, int wave) {
    const int colg = item * 128, layer = colg / 12288, n0 = colg % 12288;
    LAS float* cs = (LAS float*)(lds + wave * 9216);
    LAS float* red = (LAS float*)(lds + 73728);
    float acc[36][2];
#pragma unroll
    for (int s = 0; s < 36; ++s) { acc[s][0] = 0.f; acc[s][1] = 0.f; }
#define MOD_LOADW(dst, kq) do { const float* wr_ = Wu + (size_t)(kq) * 12288; _Pragma("unroll") for (int j_ = 0; j_ < 16; ++j_) dst[j_] = *(const f32x2*)(wr_ + (size_t)j_ * 12288 + voff); } while (0)
#define MOD_COMP(wv, koff) do { _Pragma("unroll") for (int j4_ = 0; j4_ < 4; ++j4_) { _Pragma("unroll") for (int sg = 0; sg < 4; ++sg) { \
        _Pragma("unroll") for (int s = 9 * sg; s < 9 * sg + 9; ++s) { const f32x4 c = *(const LAS f32x4*)(cs + s * 64 + (koff) + 4 * j4_); \
            acc[s][0] += c.x * wv[4 * j4_].x + c.y * wv[4 * j4_ + 1].x + c.z * wv[4 * j4_ + 2].x + c.w * wv[4 * j4_ + 3].x; \
            acc[s][1] += c.x * wv[4 * j4_].y + c.y * wv[4 * j4_ + 1].y + c.z * wv[4 * j4_ + 2].y + c.w * wv[4 * j4_ + 3].y; } \
        _Pragma("unroll") for (int s = 9 * sg; s < 9 * sg + 9; ++s) asm volatile("" : "+v"(acc[s][0]), "+v"(acc[s][1]) :: "memory"); } } } while (0)
    const float* Wu = P.in[10] + (size_t)layer * 2048 * 12288 + n0; const unsigned voff = 2u * (unsigned)lane;
    f32x2 wa[16], wb[16];
    MOD_LOADW(wa, wave * 256);
#pragma nounroll
    for (int sub = 0; sub < 4; ++sub) {
        const int kb = wave * 256 + sub * 64;
#pragma unroll 4
        for (int i = 0; i < 36; ++i) { const float v = (i < 4) ? P.in[8][i * 2048 + kb + lane] : P.in[9][(i - 4) * 2048 + kb + lane]; cs[i * 64 + lane] = siluf(v); }
        LDS_WAIT();
#pragma nounroll
        for (int g2 = 0; g2 < 2; ++g2) {
            MOD_LOADW(wb, kb + 32 * g2 + 16); MOD_COMP(wa, 32 * g2);
            if (kb + 32 * g2 + 32 < 2048) MOD_LOADW(wa, kb + 32 * g2 + 32);
            MOD_COMP(wb, 32 * g2 + 16);
        }
        LDS_WAIT();
    }
#undef MOD_LOADW
#undef MOD_COMP
    __syncthreads();
    float* MOD = (float*)(P.ws + WS_MOD);
#pragma unroll
    for (int half = 0; half < 2; ++half) {
#pragma unroll
        for (int s = 0; s < 18; ++s) *(LAS f32x2*)(red + (wave * 18 + s) * 128 + 2 * lane) = (f32x2){acc[18 * half + s][0], acc[18 * half + s][1]};
        __syncthreads();
        for (int o = tid; o < 18 * 128; o += NTHREADS) { const int s = o >> 7, c = o & 127; float v = 0.f;
#pragma unroll
            for (int w = 0; w < 8; ++w) v += red[(w * 18 + s) * 128 + c];
            MOD[(size_t)(layer * 36 + 18 * half + s) * 12288 + n0 + c] = v + P.in[11][layer * 12288 + n0 + c]; }
        __syncthreads();
    }
}
DEV void transpose_item(const float* W, int ldw, int k0, int n0, int ncols, bf16_t* WT, int ldt, int drow0, LAS float* scr, int lane) {
    if (lane < ncols) {
        float v[64];
        const float* wp = W + (size_t)k0 * ldw + n0 + lane;
#pragma unroll
        for (int kk = 0; kk < 64; ++kk) v[kk] = __builtin_nontemporal_load(wp + (size_t)kk * ldw);
#pragma unroll
        for (int kk = 0; kk < 64; ++kk) scr[kk * 65 + lane] = v[kk];
    }
    LDS_WAIT();
    const int c = lane & 7;
#pragma unroll
    for (int j = 0; j < 8; ++j) { const int n = (lane >> 3) + 8 * j;
        if (n < ncols) { const LAS float* s = scr + (8 * c) * 65 + n;
            u32x4 o; o.x = pk2(s[0], s[65]); o.y = pk2(s[2 * 65], s[3 * 65]); o.z = pk2(s[4 * 65], s[5 * 65]); o.w = pk2(s[6 * 65], s[7 * 65]);
            *(u32x4*)(WT + (size_t)(drow0 + n) * ldt + k0 + 8 * c) = o; } }
    LDS_WAIT();
}
DEV void transpose_range(const Params& P, LAS unsigned char* lds, int lo, int hi, int slot0, int myslots, int nslots, int lane, int wave) {
    unsigned char* ws = P.ws; bf16_t* WIN = (bf16_t*)(ws + WS_WIN);
    LAS float* scr = (LAS float*)(lds + wave * 16640);
    for (int sl = 0; sl < myslots; ++sl)
    for (int it = lo + slot0 + sl; it < hi; it += nslots) {
        int r = it;
        if (r < 3072) { const int kb = r / 96, nb = r % 96; transpose_item(P.in[13], 10272, kb * 64, nb * 64, 64, WIN, 2048, nb * 64, scr, lane); continue; } r -= 3072;
        if (r < 2048) { const int kb = r / 64, nb = r % 64; transpose_item(P.in[13], 10272, kb * 64, 6176 + nb * 64, 64, WIN, 2048, 6144 + nb * 64, scr, lane); continue; } r -= 2048;
        if (r < 32) { transpose_item(P.in[13], 10272, r * 64, 6144, 32, WIN, 2048, 10240, scr, lane); continue; } r -= 32;
        if (r < 2048) { const int kb = r / 32, nb = r % 32; transpose_item(P.in[27], 2048, kb * 64, nb * 64, 64, (bf16_t*)(ws + WS_WOH), 4096, nb * 64, scr, lane); continue; } r -= 2048;
        if (r < 1536) { const int kb = r / 48, nb = r % 48; transpose_item(P.in[28], 3072, kb * 64, nb * 64, 64, (bf16_t*)(ws + WS_WQKV), 2048, nb * 64, scr, lane); continue; } r -= 1536;
        if (r < 1024) { const int kb = r / 32, nb = r % 32; transpose_item(P.in[31], 2048, kb * 64, nb * 64, 64, (bf16_t*)(ws + WS_WOA), 2048, nb * 64, scr, lane); continue; } r -= 1024;
        if (r < 8192) { const int l = r / 4096; r %= 4096; const int kb = r / 128, nb = r % 128;
            transpose_item(P.in[32] + (size_t)l * 2048 * 8192, 8192, kb * 64, nb * 64, 64, (bf16_t*)(ws + WS_WUP) + (size_t)l * 8192 * 2048, 2048, nb * 64, scr, lane); continue; } r -= 8192;
        if (r < 8192) { const int l = r / 4096; r %= 4096; const int kb = r / 32, nb = r % 32;
            transpose_item(P.in[33] + (size_t)l * 8192 * 2048, 2048, kb * 64, nb * 64, 64, (bf16_t*)(ws + WS_WDN) + (size_t)l * 2048 * 8192, 8192, nb * 64, scr, lane); continue; } r -= 8192;
        { const int mat = r / 128; r %= 128; const int blk = r / 16; r %= 16; const int kb = r / 4, nb = r % 4;
            transpose_item((mat ? P.in[24] : P.in[22]) + (size_t)blk * 65536, 256, kb * 64, nb * 64, 64, (bf16_t*)(ws + WS_WLRU) + (size_t)mat * 8 * 65536 + (size_t)blk * 65536, 256, nb * 64, scr, lane); }
    }
}
DEV void phase0(const Params& P, LAS unsigned char* lds, int tid, int lane, int wave) {
    const int G = gridDim.x, bid = blockIdx.x;
    unsigned char* ws = P.ws;
    REP(20) for (int it = bid; it < 192; it += G) mod_item(P, lds, it, tid, lane, wave);
    __syncthreads();
    bf16_t* WIN = (bf16_t*)(ws + WS_WIN);
    REP(21) {
    const int nmod = G > 192 ? 192 : G, nslots = (G - nmod) * 8 * 9 + nmod * 8;
    const int myslots = bid >= nmod ? 9 : 1, slot0 = bid >= nmod ? 9 * ((bid - nmod) * 8 + wave) : (G - nmod) * 72 + (bid * 8 + wave);
#if TAILS
    transpose_range(P, lds, 0, 5152, slot0, myslots, nslots, lane, wave);
    transpose_range(P, lds, 26144, 26400, bid * 8 + wave, 1, G * 8, lane, wave);
    if (G > 192 && bid >= nmod) transpose_range(P, lds, 5152, 7200, (bid - nmod) * 8 + wave, 1, (G - nmod) * 8, lane, wave);
#else
    { const int ns2 = (G - nmod) * 8 * 3 + nmod * 8 * 2, my2 = bid >= nmod ? 3 : 2, s02 = bid >= nmod ? 3 * ((bid - nmod) * 8 + wave) : (G - nmod) * 24 + 2 * (bid * 8 + wave);
      transpose_range(P, lds, 0, 26400, s02, my2, ns2, lane, wave); }
#endif
    }
    const int gt = bid * NTHREADS + tid, NGT = G * NTHREADS;
    for (int q = gt; q < 57344; q += NGT) *((u32x4*)(WIN + (size_t)10272 * 2048) + q) = (u32x4){0u, 0u, 0u, 0u};
    float* ROPE = (float*)(ws + WS_ROPE);
    for (int q = gt; q < 2056 * 32; q += NGT) {
        const int pi = q >> 5, i = q & 31; const int pos = pi < 2048 ? pi : 16384 + (pi - 2048);
        const float invf = powf(10000.0f, -(float)i / 32.0f);
        const float ang = (float)pos * invf;
        const double a = (double)ang; const double n = rint(a * 0.15915494309189535); const float rr = (float)(a - n * 6.283185307179586);
        ROPE[2 * q] = cosf(rr); ROPE[2 * q + 1] = sinf(rr);
    }
}

DEV void norm_phase(const Params& P, LAS unsigned char* lds, bool first, bool last, int l_post, int gpost_idx, int gate_j, int l_pre, int gpre_idx, int sh_j, int sc_j, int nsplit, int lane, int wave, float gscale = 1.f, bool xin = false) {
    const int G = gridDim.x; const int gw = blockIdx.x * 8 + wave, NGW = G * 8;
    float* X = P.out; bf16_t* X16 = (bf16_t*)(P.ws + WS_X16); const bf16_t* MIXB = (const bf16_t*)(P.ws + WS_MIX); bf16_t* H = (bf16_t*)(P.ws + WS_H); const float* MOD = (const float*)(P.ws + WS_MOD);
    const float* gpo = P.in[12] + (size_t)(l_post * 4 + gpost_idx) * DM; const float* gpr = P.in[12] + (size_t)(l_pre * 4 + gpre_idx) * DM;
    const int nrows = first ? TT : TP;
#define NORM_LOADRAW(XF, XH, MH, rowi) do { const int r_ = (rowi); const float* xs_ = r_ < TP ? P.in[0] + (size_t)r_ * DM : P.in[1] + (size_t)(r_ - TP) * DM; \
        _Pragma("unroll") for (int j = 0; j < 8; ++j) { \
            if (first || xin) XF[j] = *(const f32x4*)(xs_ + 4 * lane + 256 * j); else XH[j] = *(const u32x2*)(X16 + (size_t)r_ * DM + 4 * lane + 256 * j); \
            if (!first) MH[j] = *(const u32x2*)(MIXB + (size_t)r_ * DM + 4 * lane + 256 * j); } } while (0)
#define NORM_COPYRAW(XFd, XHd, MHd, XFs, XHs, MHs) do { _Pragma("unroll") for (int j = 0; j < 8; ++j) { if (first || xin) XFd[j] = XFs[j]; else XHd[j] = XHs[j]; if (!first) MHd[j] = MHs[j]; } } while (0)
    f32x4 xa[8], ma[8];
    f32x4 xfB[8], xfC[8]; u32x2 xhB[8], xhC[8], mhB[8], mhC[8];
    int r = gw;
    if (r < nrows) NORM_LOADRAW(xfB, xhB, mhB, r);
    if (r + NGW < nrows) NORM_LOADRAW(xfC, xhC, mhC, r + NGW); else NORM_COPYRAW(xfC, xhC, mhC, xfB, xhB, mhB);
    for (; r < nrows; r += NGW) {
#pragma unroll
        for (int j = 0; j < 8; ++j) {
            if (first || xin) xa[j] = xfB[j]; else xa[j] = (f32x4){bflo(xhB[j].x), bfhi(xhB[j].x), bflo(xhB[j].y), bfhi(xhB[j].y)};
            if (first) ma[j] = xa[j]; else ma[j] = (f32x4){bflo(mhB[j].x), bfhi(mhB[j].x), bflo(mhB[j].y), bfhi(mhB[j].y)}; }
        NORM_COPYRAW(xfB, xhB, mhB, xfC, xhC, mhC);
        if (r + 2 * NGW < nrows) NORM_LOADRAW(xfC, xhC, mhC, r + 2 * NGW);
        const int seq = r < TP ? (r >> 11) : 4 + ((r - TP) >> 3);
        if (!first) {
            float ss = 0.f;
#pragma unroll
            for (int j = 0; j < 8; ++j) ss += ma[j].x * ma[j].x + ma[j].y * ma[j].y + ma[j].z * ma[j].z + ma[j].w * ma[j].w;
            const float rinv = rsqrtf(wave_sum(ss) * (1.f / DM) + EPSN);
            const float* gt = MOD + (size_t)(l_post * 36 + seq) * 12288 + gate_j * DM;
#pragma unroll
            for (int j = 0; j < 8; ++j) { const f32x4 g = *(const f32x4*)(gpo + 4 * lane + 256 * j), ga = *(const f32x4*)(gt + 4 * lane + 256 * j);
                xa[j] = xa[j] + ga * gscale * (ma[j] * rinv * g);
                if (last) *(f32x4*)(X + (size_t)r * DM + 4 * lane + 256 * j) = xa[j];
                else { u32x2 xw; xw.x = pk2(xa[j].x, xa[j].y); xw.y = pk2(xa[j].z, xa[j].w); *(u32x2*)(X16 + (size_t)r * DM + 4 * lane + 256 * j) = xw; } }
        }
        if (!last) {
            float ss = 0.f;
#pragma unroll
            for (int j = 0; j < 8; ++j) ss += xa[j].x * xa[j].x + xa[j].y * xa[j].y + xa[j].z * xa[j].z + xa[j].w * xa[j].w;
            const float rinv = rsqrtf(wave_sum(ss) * (1.f / DM) + EPSN);
            const float* mbp = MOD + (size_t)(l_pre * 36 + seq) * 12288;
#pragma unroll
            for (int j = 0; j < 8; ++j) { const f32x4 g = *(const f32x4*)(gpr + 4 * lane + 256 * j), sc = *(const f32x4*)(mbp + sc_j * DM + 4 * lane + 256 * j), sh = *(const f32x4*)(mbp + sh_j * DM + 4 * lane + 256 * j);
                const f32x4 h = xa[j] * rinv * g * (sc + 1.f) + sh;
                u32x2 w; w.x = pk2(h.x, h.y); w.y = pk2(h.z, h.w);
                *(u32x2*)(H + (size_t)r * DM + 4 * lane + 256 * j) = w; }
        }
    }
#undef NORM_LOADRAW
#undef NORM_COPYRAW
    if (first) return;
    LAS float* red = (LAS float*)lds;
    for (int rs = blockIdx.x; rs < TS; rs += G) {
        const int rr = TP + rs, seq = 4 + (rs >> 3), col = 256 * wave + 4 * lane;
        const float* pp = (const float*)(P.ws + WS_PART) + (size_t)rs * DM + col;
        f32x4 mv = (f32x4){0.f, 0.f, 0.f, 0.f};
#pragma unroll 8
        for (int ks = 0; ks < nsplit; ++ks) mv = mv + *(const f32x4*)(pp + (size_t)ks * 256 * DM);
        f32x4 xv;
        if (xin) xv = *(const f32x4*)(P.in[1] + (size_t)rs * DM + col); else { const u32x2 xw = *(const u32x2*)(X16 + (size_t)rr * DM + col); xv = (f32x4){bflo(xw.x), bfhi(xw.x), bflo(xw.y), bfhi(xw.y)}; }
        const float s1 = wave_sum(mv.x * mv.x + mv.y * mv.y + mv.z * mv.z + mv.w * mv.w);
        if (lane == 0) red[wave] = s1;
        __syncthreads();
        float tot = 0.f;
#pragma unroll
        for (int w = 0; w < 8; ++w) tot += red[w];
        const float rinv = rsqrtf(tot * (1.f / DM) + EPSN);
        const f32x4 g = *(const f32x4*)(gpo + col), ga = *(const f32x4*)(MOD + (size_t)(l_post * 36 + seq) * 12288 + gate_j * DM + col);
        xv = xv + ga * gscale * (mv * rinv * g);
        if (last) *(f32x4*)(X + (size_t)rr * DM + col) = xv; else { u32x2 xw; xw.x = pk2(xv.x, xv.y); xw.y = pk2(xv.z, xv.w); *(u32x2*)(X16 + (size_t)rr * DM + col) = xw; }
        if (!last) {
            const float s2 = wave_sum(xv.x * xv.x + xv.y * xv.y + xv.z * xv.z + xv.w * xv.w);
            if (lane == 0) red[8 + wave] = s2;
            __syncthreads();
            float tot2 = 0.f;
#pragma unroll
            for (int w = 0; w < 8; ++w) tot2 += red[8 + w];
            const float rinv2 = rsqrtf(tot2 * (1.f / DM) + EPSN);
            const float* mbp = MOD + (size_t)(l_pre * 36 + seq) * 12288;
            const f32x4 g2 = *(const f32x4*)(gpr + col), sc = *(const f32x4*)(mbp + sc_j * DM + col), sh = *(const f32x4*)(mbp + sh_j * DM + col);
            const f32x4 h = xv * rinv2 * g2 * (sc + 1.f) + sh;
            u32x2 w; w.x = pk2(h.x, h.y); w.y = pk2(h.z, h.w);
            *(u32x2*)(H + (size_t)rr * DM + col) = w;
        }
        __syncthreads();
    }
}

DEV void lru_gate_item(const Params& P, LAS unsigned char* lds, int r0, int nrows  , int kb, int tid, int lane, int wave) {
    LAS bf16_t* XC = (LAS bf16_t*)lds;
    const bf16_t* PROJ = (const bf16_t*)(P.ws + WS_PROJ);
    {
        const int cgp = tid & 31, ch0 = kb * 256 + cgp * 8;
        float w[4][8], bias[8]; ldconvw(P.in[20], P.in[21], 2048, ch0, w, bias);
#pragma unroll 4
        for (int i = 0; i < nrows / 16; ++i) { const int q = tid + NTHREADS * i, row = q >> 5, r = r0 + row; int tl; const float* hist = nullptr;
            if (r < TP) tl = r & 2047; else { const int rs = r - TP; tl = rs & 7; hist = P.in[4] + (size_t)(rs >> 3) * 3 * 2048 + ch0; }
            float o[8]; conv8(PROJ, r, tl, PC_XR + ch0, hist, 2048, w, bias, o);
            *(LAS u32x4*)(XC + row * 264 + cgp * 8) = pack8(o); }
    }
    __syncthreads();
    const int r = lane & 31, h = lane >> 5;
    const int ch = kb * 256 + 32 * wave + r;
    const float ba_ = P.in[23][ch], bx_ = P.in[25][ch], sp = softplusf(-P.in[26][ch]);
    float* Aa = (float*)(P.ws + WS_B); float* Uu = (float*)(P.ws + WS_AU_U);
    const bf16_t* Wa = (const bf16_t*)(P.ws + WS_WLRU) + (size_t)(kb * 256 + 32 * wave + r) * 256 + 8 * h; const bf16_t* Wx = Wa + 8 * 65536;
#pragma nounroll
    for (int mh = 0; mh < nrows / 64; ++mh) {
        f32x16 aa[2], ax[2];
#pragma unroll
        for (int m = 0; m < 2; ++m) { aa[m] = zero16(); ax[m] = zero16(); }
        bf16x8 bA[4], bX[4], nA[4], nX[4];
#pragma unroll
        for (int j = 0; j < 4; ++j) { bA[j] = *(const bf16x8*)(Wa + 16 * j); bX[j] = *(const bf16x8*)(Wx + 16 * j); }
#pragma unroll
        for (int kb4 = 0; kb4 < 4; ++kb4) {
            if (kb4 < 3) {
#pragma unroll
                for (int j = 0; j < 4; ++j) { nA[j] = *(const bf16x8*)(Wa + 64 * (kb4 + 1) + 16 * j); nX[j] = *(const bf16x8*)(Wx + 64 * (kb4 + 1) + 16 * j); } }
#pragma unroll
            for (int j = 0; j < 4; ++j)
#pragma unroll
                for (int m = 0; m < 2; ++m) { const bf16x8 a = *(const LAS bf16x8*)(XC + (64 * mh + 32 * m + r) * 264 + 64 * kb4 + 16 * j + 8 * h);
                    aa[m] = __builtin_amdgcn_mfma_f32_32x32x16_bf16(a, bA[j], aa[m], 0, 0, 0); ax[m] = __builtin_amdgcn_mfma_f32_32x32x16_bf16(a, bX[j], ax[m], 0, 0, 0); }
            if (kb4 < 3) {
#pragma unroll
                for (int j = 0; j < 4; ++j) { bA[j] = nA[j]; bX[j] = nX[j]; } }
        }
#pragma unroll
        for (int m = 0; m < 2; ++m)
#pragma unroll
            for (int reg = 0; reg < 16; ++reg) { const int t = 64 * mh + 32 * m + rowmap(reg, h);
                const float xb = bf2f(XC[t * 264 + 32 * wave + r]);
                const float gr = sigm(aa[m][reg] + ba_), gi = sigm(ax[m][reg] + bx_);
                const float la = -8.0f * gr * sp; const float a = __expf(la); const float mult = sqrtf(fmaxf(-expm1f(2.0f * la), 0.f));
                Aa[(size_t)(r0 + t) * 2048 + ch] = a; Uu[(size_t)(r0 + t) * 2048 + ch] = mult * gi * xb; }
    }
    __syncthreads();
}
DEV void ssd_dt_acs(const Params& P, LAS float* acs, LAS float* dts, LAS float* tmp, int R0, int g, int tid) {
    const int hh = tid >> 7, s = tid & 127, hd = 4 * g + hh;
    const float* DT = (const float*)(P.ws + WS_DT);
    const float dtv = softplusf(DT[(size_t)(R0 + s) * 32 + hd] + P.in[16][hd]);
    const float a = -__expf(P.in[17][hd]);
    tmp[tid] = dtv * a; dts[tid] = dtv;
    __syncthreads();
    float c = 0.f; for (int i = 0; i <= s; ++i) c += tmp[hh * 128 + i];
    acs[tid] = c;
    __syncthreads();
}
DEV void ssd_state_item(const Params& P, LAS unsigned char* lds, int it, int tid, int lane, int wave) {
    const int g = it & 7, c = (it >> 3) & 15, b = it >> 7; const int R0 = b * 2048 + c * 128;
    LAS bf16_t* BT = (LAS bf16_t*)lds;
    LAS bf16_t* XWT = (LAS bf16_t*)(lds + 34816);
    LAS float* acs = (LAS float*)(lds + 52224); LAS float* dts = acs + 512; LAS float* tmp = dts + 512;
    const bf16_t* PROJ = (const bf16_t*)(P.ws + WS_PROJ);
    ssd_dt_acs(P, acs, dts, tmp, R0, g, tid);
    {
        const int cgb = tid & 15, cidx = 2048 + g * 128 + cgb * 8;
        float w[4][8], bias[8]; ldconvw(P.in[14], P.in[15], 4096, cidx, w, bias);
#pragma unroll 4
        for (int i = 0; i < 4; ++i) { const int q = tid + NTHREADS * i, s = q >> 4; float o[8];
            conv8(PROJ, R0 + s, c * 128 + s, PC_XBC + cidx, nullptr, 4096, w, bias, o);
#pragma unroll
            for (int e = 0; e < 8; ++e) BT[(cgb * 8 + e) * 136 + s] = (bf16_t)f2bf(siluf(o[e])); }
    }
    float* CS = (float*)(P.ws + WS_CS); float* CDEC = (float*)(P.ws + WS_CDEC);
    for (int hh = 0; hh < 4; ++hh) {
        const int hd = 4 * g + hh;
        {
            const int cgp = tid & 7, cidx = hd * 64 + cgp * 8;
            float w[4][8], bias[8]; ldconvw(P.in[14], P.in[15], 4096, cidx, w, bias);
            const float alast = acs[hh * 128 + 127];
#pragma unroll 2
            for (int i = 0; i < 2; ++i) { const int q = tid + NTHREADS * i, s = q >> 3; float o[8];
                conv8(PROJ, R0 + s, c * 128 + s, PC_XBC + cidx, nullptr, 4096, w, bias, o);
                const float sc = dts[hh * 128 + s] * __expf(alast - acs[hh * 128 + s]);
#pragma unroll
                for (int e = 0; e < 8; ++e) XWT[(cgp * 8 + e) * 136 + s] = (bf16_t)f2bf(siluf(o[e]) * sc); }
        }
        __syncthreads();
        const int pt = wave >> 2, nt = wave & 3;
        f32x16 acc = zero16();
        mma_tile(acc, XWT + 32 * pt * 136, 136, BT + 32 * nt * 136, 136, 128, lane);
        float* dst = CS + ((size_t)((b * 16 + c) * 32 + hd)) * 8192;
#pragma unroll
        for (int reg = 0; reg < 16; ++reg) dst[(32 * pt + rowmap(reg, lane >> 5)) * 128 + 32 * nt + (lane & 31)] = acc[reg];
        if (tid == 0) CDEC[(b * 16 + c) * 32 + hd] = __expf(acs[hh * 128 + 127]);
        __syncthreads();
    }
}
DEV void phase3(const Params& P, LAS unsigned char* lds, int tid, int lane, int wave) {
    const int G = gridDim.x, bid = blockIdx.x;
    REP(14) { for (int it = bid; it < 512; it += G) lru_gate_item(P, lds, (it >> 3) * 128, 128, it & 7, tid, lane, wave);
              for (int it = bid; it < 32; it += G) lru_gate_item(P, lds, TP + (it >> 3) * 64, 64, it & 7, tid, lane, wave); }
    REP(15) for (int it = bid; it < 512; it += G) ssd_state_item(P, lds, it, tid, lane, wave);
    const bf16_t* PROJ = (const bf16_t*)(P.ws + WS_PROJ);
    const int gt = bid * NTHREADS + tid, NGT = G * NTHREADS;
    for (int q = gt; q < 49152 + 24576 + 393216 + 196608; q += NGT) {
        int r = q;
        if (r < 49152) { const int b = r / 12288, j = (r / 4096) % 3, cc = r % 4096; P.out[O_PSC + r] = bf2f(PROJ[(size_t)(b * 2048 + 2045 + j) * NPROJ + PC_XBC + cc]); continue; } r -= 49152;
        if (r < 24576) { const int b = r / 6144, j = (r / 2048) % 3, cc = r % 2048; P.out[O_PLC + r] = bf2f(PROJ[(size_t)(b * 2048 + 2045 + j) * NPROJ + PC_XR + cc]); continue; } r -= 24576;
        if (r < 393216) { const int b = r / 12288, j = (r / 4096) % 3, cc = r % 4096; P.out[O_SSC + r] = bf2f(PROJ[(size_t)(TP + b * 8 + 5 + j) * NPROJ + PC_XBC + cc]); continue; } r -= 393216;
        { const int b = r / 6144, j = (r / 2048) % 3, cc = r % 2048; P.out[O_SLC + r] = bf2f(PROJ[(size_t)(TP + b * 8 + 5 + j) * NPROJ + PC_XR + cc]); }
    }
}

DEV void lru_scan_item(const Params& P, LAS unsigned char* lds, int it, int tid) {
    const int b = it >> 6, cgp = it & 63, cl = tid & 31, ch = cgp * 32 + cl, seg = tid >> 5;
    const size_t rbase = (size_t)b * 2048 + seg * 128;
    const float* Aa = (const float*)(P.ws + WS_B) + rbase * 2048 + ch; const float* Uu = (const float*)(P.ws + WS_AU_U) + rbase * 2048 + ch;
    LAS float* sA = (LAS float*)lds; LAS float* sH = sA + 512;
    float p1 = 1.f, h1 = 0.f, p2 = 1.f, h2 = 0.f;
#pragma unroll 16
    for (int t = 0; t < 64; ++t) { const float a1 = Aa[(size_t)t * 2048], u1 = Uu[(size_t)t * 2048], a2 = Aa[(size_t)(64 + t) * 2048], u2 = Uu[(size_t)(64 + t) * 2048];
        h1 = a1 * h1 + u1; p1 *= a1; h2 = a2 * h2 + u2; p2 *= a2; }
    sA[seg * 32 + cl] = p1 * p2; sH[seg * 32 + cl] = p2 * h1 + h2;
    __syncthreads();
    float hin = 0.f;
    for (int s = 0; s < seg; ++s) hin = sA[s * 32 + cl] * hin + sH[s * 32 + cl];
    const bf16_t* GATE = (const bf16_t*)(P.ws + WS_PROJ) + rbase * NPROJ + PC_GATE + ch;
    bf16_t* Y = (bf16_t*)(P.ws + WS_YMIX) + rbase * 4096 + 2048 + ch;
    float g1 = hin, g2 = p1 * hin + h1;
#pragma unroll 8
    for (int t = 0; t < 64; ++t) { const float a1 = Aa[(size_t)t * 2048], u1 = Uu[(size_t)t * 2048], a2 = Aa[(size_t)(64 + t) * 2048], u2 = Uu[(size_t)(64 + t) * 2048];
        const float z1 = bf2f(GATE[(size_t)t * NPROJ]), z2 = bf2f(GATE[(size_t)(64 + t) * NPROJ]);
        g1 = a1 * g1 + u1; g2 = a2 * g2 + u2;
        Y[(size_t)t * 4096] = (bf16_t)f2bf(g1 * geluf(z1)); Y[(size_t)(64 + t) * 4096] = (bf16_t)f2bf(g2 * geluf(z2)); }
    const float h = g2;
    if (seg == 15) P.out[O_PL + b * 2048 + ch] = h;
    __syncthreads();
}
DEV void phase4(const Params& P, LAS unsigned char* lds, int tid, int lane, int wave) {
    const int G = gridDim.x, bid = blockIdx.x;
    REP(22) for (int it = bid; it < 256; it += G) lru_scan_item(P, lds, it, tid);
    const int gt = bid * NTHREADS + tid, NGT = G * NTHREADS;
    for (int q = gt; q < 65536; q += NGT) { const int b = q >> 11, ch = q & 2047; float h = P.in[5][q];
        const size_t r0 = (size_t)TP + b * 8;
#pragma unroll
        for (int t = 0; t < 8; ++t) { const float a = ((const float*)(P.ws + WS_B))[(r0 + t) * 2048 + ch], u = ((const float*)(P.ws + WS_AU_U))[(r0 + t) * 2048 + ch]; h = a * h + u;
            ((bf16_t*)(P.ws + WS_YMIX))[(r0 + t) * 4096 + 2048 + ch] = (bf16_t)f2bf(h * geluf(bf2f(((const bf16_t*)(P.ws + WS_PROJ))[(r0 + t) * NPROJ + PC_GATE + ch]))); }
        P.out[O_SL + q] = h; }
    const f32x4* CS4 = (const f32x4*)(P.ws + WS_CS); const float* CDEC = (const float*)(P.ws + WS_CDEC); u32x2* HIN = (u32x2*)(P.ws + WS_HIN);
    REP(23) for (int q = gt; q < 262144; q += NGT) { const int b = q >> 16, rem = q & 65535, hd = rem >> 11, e4 = rem & 2047;
        f32x4 h = (f32x4){0.f, 0.f, 0.f, 0.f};
        f32x4 csv[16]; float decv[16];
#pragma unroll
        for (int c = 0; c < 16; ++c) { const int idx = (b * 16 + c) * 32 + hd; decv[c] = CDEC[idx]; csv[c] = CS4[(size_t)idx * 2048 + e4]; }
#pragma unroll
        for (int c = 0; c < 16; ++c) { const int idx = (b * 16 + c) * 32 + hd;
            u32x2 w; w.x = pk2(h.x, h.y); w.y = pk2(h.z, h.w); HIN[(size_t)idx * 2048 + e4] = w;
            h = h * decv[c] + csv[c]; }
        *(f32x4*)(P.out + O_PSSM + (size_t)(b * 32 + hd) * 8192 + e4 * 4) = h; }
}

DEV void ssd_out_item(const Params& P, LAS unsigned char* lds, int it, int tid, int lane, int wave) {
    const int g = it & 7, c = (it >> 3) & 15, b = it >> 7; const int R0 = b * 2048 + c * 128;
    LAS bf16_t* Cs = (LAS bf16_t*)lds; LAS bf16_t* Bs = (LAS bf16_t*)(lds + 34816); LAS bf16_t* Ms = (LAS bf16_t*)(lds + 69632);
    LAS bf16_t* XT = (LAS bf16_t*)(lds + 104448); LAS bf16_t* Hs = (LAS bf16_t*)(lds + 121856);
    LAS float* acs = (LAS float*)(lds + 139264); LAS float* dts = acs + 512; LAS float* ssq = dts + 512; LAS float* tmp = (LAS float*)Ms;
    const bf16_t* PROJ = (const bf16_t*)(P.ws + WS_PROJ);
    ssd_dt_acs(P, acs, dts, tmp, R0, g, tid);
    {
        const int cgb = tid & 15;
#pragma unroll
        for (int mat = 0; mat < 2; ++mat) { const int cidx = 2048 + mat * 1024 + g * 128 + cgb * 8;
            float w[4][8], bias[8]; ldconvw(P.in[14], P.in[15], 4096, cidx, w, bias);
            LAS bf16_t* dstm = mat ? Cs : Bs;
#pragma unroll 4
            for (int i = 0; i < 4; ++i) { const int q = tid + NTHREADS * i, s = q >> 4; float o[8];
                conv8(PROJ, R0 + s, c * 128 + s, PC_XBC + cidx, nullptr, 4096, w, bias, o);
#pragma unroll
                for (int e = 0; e < 8; ++e) o[e] = siluf(o[e]);
                *(LAS u32x4*)(dstm + s * 136 + cgb * 8) = pack8(o); } }
    }
    __syncthreads();
    const int tt = wave >> 1;
    f32x16 cb[2];
#pragma unroll
    for (int j = 0; j < 2; ++j) { const int st = 2 * (wave & 1) + j; cb[j] = zero16();
        if (st <= tt) mma_tile(cb[j], Cs + 32 * tt * 136, 136, Bs + 32 * st * 136, 136, 128, lane); }
    const int pt = wave & 1;
    f32x16 yv[4];
#pragma unroll
    for (int k = 0; k < 4; ++k) yv[k] = zero16();
    for (int hh = 0; hh < 4; ++hh) {
        const int hd = 4 * g + hh;
        int lane_l = lane, tid_l = tid; asm volatile("" : "+v"(lane_l), "+v"(tid_l));
        const int r = lane_l & 31, h = lane_l >> 5;
        const u32x4* hsrc = (const u32x4*)((const bf16_t*)(P.ws + WS_HIN) + ((size_t)((b * 16 + c) * 32 + hd)) * 8192);
        const u32x4 hpre0 = hsrc[tid_l], hpre1 = hsrc[tid_l + NTHREADS];
        unsigned short zv[16];
        { const bf16_t* zp = PROJ + (size_t)(R0 + 32 * tt + 4 * h) * NPROJ + hd * 64 + 32 * pt + r;
#pragma unroll
          for (int reg = 0; reg < 16; ++reg) zv[reg] = zp[(size_t)((reg & 3) + 8 * (reg >> 2)) * NPROJ]; }
        __builtin_amdgcn_sched_barrier(0);
#pragma unroll
        for (int j = 0; j < 2; ++j) { const int st = 2 * (wave & 1) + j; const int s = 32 * st + r; const float as = acs[hh * 128 + s], ds = dts[hh * 128 + s];
#pragma unroll
            for (int reg = 0; reg < 16; ++reg) { const int t = 32 * tt + rowmap(reg, h);
                const float v = (s <= t) ? cb[j][reg] * __expf(acs[hh * 128 + t] - as) * ds : 0.f;
                Ms[t * 136 + s] = (bf16_t)f2bf(v); } }
        __builtin_amdgcn_sched_barrier(0);
        {
            const int cgp = tid_l & 7, cidx = hd * 64 + cgp * 8;
            float w[4][8], bias[8]; ldconvw(P.in[14], P.in[15], 4096, cidx, w, bias);
#pragma unroll 2
            for (int i = 0; i < 2; ++i) { const int q = tid_l + NTHREADS * i, s = q >> 3; float o[8];
                conv8(PROJ, R0 + s, c * 128 + s, PC_XBC + cidx, nullptr, 4096, w, bias, o);
#pragma unroll
                for (int e = 0; e < 8; ++e) XT[(cgp * 8 + e) * 136 + s] = (bf16_t)f2bf(siluf(o[e])); }
            { const int q0 = tid_l, q1 = tid_l + NTHREADS; *(LAS u32x4*)(Hs + (q0 >> 4) * 136 + (q0 & 15) * 8) = hpre0; *(LAS u32x4*)(Hs + (q1 >> 4) * 136 + (q1 & 15) * 8) = hpre1; }
        }
        __builtin_amdgcn_sched_barrier(0);
        __syncthreads();
        __builtin_amdgcn_sched_barrier(0);
        f32x16 ad = zero16(), ao = zero16();
        mma_tile(ad, Ms + 32 * tt * 136, 136, XT + 32 * pt * 136, 136, 32 * (tt + 1), lane_l);
        mma_tile(ao, Cs + 32 * tt * 136, 136, Hs + 32 * pt * 136, 136, 128, lane_l);
        const float dsk = P.in[18][hd];
        const int p = 32 * pt + r;
#pragma unroll
        for (int reg = 0; reg < 16; ++reg) { const int t = 32 * tt + rowmap(reg, h);
            float y = ad[reg] + __expf(acs[hh * 128 + t]) * ao[reg] + dsk * bf2f(XT[p * 136 + t]);
            const float z = bf2f(zv[reg]);
            ad[reg] = y * siluf(z); }
#pragma unroll
        for (int k = 0; k < 4; ++k) yv[k] = (hh == k) ? ad : yv[k];
        __syncthreads();
    }
    int lane_m = lane; asm volatile("" : "+v"(lane_m));
    const int r = lane_m & 31, h = lane_m >> 5;
#pragma unroll
    for (int reg = 0; reg < 16; ++reg) { float s = 0.f;
#pragma unroll
        for (int hh = 0; hh < 4; ++hh) s += yv[hh][reg] * yv[hh][reg];
#pragma unroll
        for (int o = 1; o < 32; o <<= 1) s += __shfl_xor(s, o);
        if (r == 0) ssq[pt * 128 + 32 * tt + rowmap(reg, h)] = s; }
    __syncthreads();
    bf16_t* Y = (bf16_t*)(P.ws + WS_YMIX);
#pragma unroll
    for (int reg = 0; reg < 16; ++reg) { const int t = 32 * tt + rowmap(reg, h);
        const float rinv = rsqrtf((ssq[t] + ssq[128 + t]) * (1.f / 256.f) + EPSN);
#pragma unroll
        for (int hh = 0; hh < 4; ++hh) { const int ch = (4 * g + hh) * 64 + 32 * pt + r;
            Y[(size_t)(R0 + t) * 4096 + ch] = (bf16_t)f2bf(yv[hh][reg] * rinv * P.in[19][ch]); } }
    __syncthreads();
}
DEV void ssd_sample_item(const Params& P, LAS unsigned char* lds, int it, int tid, int lane, int wave) {
    const int b = it >> 3, g = it & 7; const int R0 = TP + b * 8;
    LAS float* xs = (LAS float*)lds;
    LAS float* Bv = xs + 2048;
    LAS float* Cv = Bv + 1024;
    LAS float* dtv = Cv + 1024;
    LAS float* yv = dtv + 32;
    const bf16_t* PROJ = (const bf16_t*)(P.ws + WS_PROJ);
    {
        const int cc = tid; const int cidx = cc < 256 ? g * 256 + cc : (cc < 384 ? 2048 + g * 128 + (cc - 256) : 3072 + g * 128 + (cc - 384));
        const float w0 = P.in[14][cidx], w1 = P.in[14][4096 + cidx], w2 = P.in[14][8192 + cidx], w3 = P.in[14][12288 + cidx], bias = P.in[15][cidx];
        const float* hist = P.in[2] + (size_t)b * 3 * 4096 + cidx;
        float x0 = hist[0], x1 = hist[4096], x2 = hist[8192];
        LAS float* dst = cc < 256 ? xs + cc : (cc < 384 ? Bv + (cc - 256) : Cv + (cc - 384)); const int dstride = cc < 256 ? 256 : 128;
#pragma unroll
        for (int t = 0; t < 8; ++t) { const float x3 = bf2f(PROJ[(size_t)(R0 + t) * NPROJ + PC_XBC + cidx]);
            dst[t * dstride] = siluf(bias + w0 * x0 + w1 * x1 + w2 * x2 + w3 * x3); x0 = x1; x1 = x2; x2 = x3; }
        if (tid < 32) { const int hh = tid >> 3, t = tid & 7, hd = 4 * g + hh; dtv[tid] = softplusf(((const float*)(P.ws + WS_DT))[(size_t)(R0 + t) * 32 + hd] + P.in[16][hd]); }
    }
    __syncthreads();
    const int p = tid >> 3, n0 = (tid & 7) * 16;
    for (int hh = 0; hh < 4; ++hh) {
        const int hd = 4 * g + hh; const float a = -__expf(P.in[17][hd]), dsk = P.in[18][hd];
        const size_t sidx = ((size_t)(b * 32 + hd) * 64 + p) * 128 + n0;
        float hst[16];
#pragma unroll
        for (int i = 0; i < 4; ++i) { const f32x4 v = *(const f32x4*)(P.in[3] + sidx + 4 * i); hst[4 * i] = v.x; hst[4 * i + 1] = v.y; hst[4 * i + 2] = v.z; hst[4 * i + 3] = v.w; }
#pragma unroll
        for (int t = 0; t < 8; ++t) { const float dt = dtv[hh * 8 + t], dec = __expf(dt * a), xv = xs[t * 256 + hh * 64 + p], xdt = xv * dt; float yp = 0.f;
#pragma unroll
            for (int i = 0; i < 16; ++i) { hst[i] = hst[i] * dec + xdt * Bv[t * 128 + n0 + i]; yp += Cv[t * 128 + n0 + i] * hst[i]; }
            yp += __shfl_xor(yp, 1); yp += __shfl_xor(yp, 2); yp += __shfl_xor(yp, 4);
            if ((tid & 7) == 0) yv[t * 256 + hh * 64 + p] = yp + dsk * xv; }
#pragma unroll
        for (int i = 0; i < 4; ++i) *(f32x4*)(P.out + O_SSSM + sidx + 4 * i) = (f32x4){hst[4 * i], hst[4 * i + 1], hst[4 * i + 2], hst[4 * i + 3]};
    }
    __syncthreads();
    {
        const int t = wave; float v[4]; float ss = 0.f;
#pragma unroll
        for (int i = 0; i < 4; ++i) { const int ch = lane + 64 * i; const float z = bf2f(PROJ[(size_t)(R0 + t) * NPROJ + g * 256 + ch]); v[i] = yv[t * 256 + ch] * siluf(z); ss += v[i] * v[i]; }
        const float rinv = rsqrtf(wave_sum(ss) * (1.f / 256.f) + EPSN);
#pragma unroll
        for (int i = 0; i < 4; ++i) { const int ch = g * 256 + lane + 64 * i; ((bf16_t*)(P.ws + WS_YMIX))[(size_t)(R0 + t) * 4096 + ch] = (bf16_t)f2bf(v[i] * rinv * P.in[19][ch]); }
    }
    __syncthreads();
}
DEV void phase5(const Params& P, LAS unsigned char* lds, int tid, int lane, int wave) {
    const int G = gridDim.x, bid = blockIdx.x;
    const int gt = bid * NTHREADS + tid, NGT = G * NTHREADS;
#if !defined(ONLY) || ONLY == 5
    for (int it = bid; it < 512; it += G) ssd_out_item(P, lds, it, tid, lane, wave);
#endif
#if !defined(ONLY) || ONLY == 11
    for (int it = bid; it < 256; it += G) ssd_sample_item(P, lds, it, tid, lane, wave);
#endif
}

DEV void rope_stage(const bf16_t* src, const float* ropep  , int c, float scale, LAS bf16_t* dst, float* fout, bool zero) {
    float lo[8], hi[8], o1[8], o2[8];
    if (zero) {
#pragma unroll
        for (int e = 0; e < 8; ++e) { o1[e] = 0.f; o2[e] = 0.f; }
    } else {
        ld8(src + 8 * c, lo); ld8(src + 32 + 8 * c, hi);
        float csA[8], csB[8]; ldf8(ropep + 16 * c, csA); ldf8(ropep + 16 * c + 8, csB);
#pragma unroll
        for (int e = 0; e < 8; ++e) { const float co = e < 4 ? csA[2 * e] : csB[2 * e - 8], si = e < 4 ? csA[2 * e + 1] : csB[2 * e - 7]; o1[e] = (lo[e] * co - hi[e] * si) * scale; o2[e] = (hi[e] * co + lo[e] * si) * scale; }
    }
    *(LAS u32x4*)(dst + 8 * c) = pack8(o1); *(LAS u32x4*)(dst + 32 + 8 * c) = pack8(o2);
    if (fout) {
#pragma unroll
        for (int e = 0; e < 8; ++e) { fout[8 * c + e] = o1[e]; fout[32 + 8 * c + e] = o2[e]; } }
}
DEV void attn_prompt_item(const Params& P, LAS unsigned char* lds, int it, int tid, int lane, int wave) {
    const int hp = it & 1, qb = (it >> 1) & 15, kvh = (it >> 5) & 7, b = it >> 8;
    LAS bf16_t* Ks = (LAS bf16_t*)lds;
    LAS bf16_t* VT = (LAS bf16_t*)(lds + 36864);
    LAS bf16_t* Qs = (LAS bf16_t*)(lds + 70656);
    const bf16_t* QKV = (const bf16_t*)(P.ws + WS_QKV); const float* ROPE = (const float*)(P.ws + WS_ROPE);
    const bool wr_state = (qb == 15 && hp == 0);
    for (int i = 0; i < 2; ++i) { const int q = tid + NTHREADS * i, jj = q >> 2, c = q & 3; const int pos = qb * 128 - 128 + jj; const bool zero = pos < 0;
        const int posc = zero ? 0 : pos;
        float* fo = (wr_state && jj >= 128) ? P.out + O_PK + ((size_t)(b * 128 + (jj - 128)) * 8 + kvh) * 64 : nullptr;
        rope_stage(QKV + (size_t)(b * 2048 + posc) * NQKV + 2048 + kvh * 64, ROPE + (size_t)posc * 64, c, 1.0f, Ks + jj * 72, fo, zero); }
    for (int i = 0; i < 4; ++i) { const int q = tid + NTHREADS * i, jj = q >> 3, c = q & 7; const int pos = qb * 128 - 128 + jj; float v[8];
        if (pos < 0) {
#pragma unroll
            for (int e = 0; e < 8; ++e) v[e] = 0.f;
        } else ld8(QKV + (size_t)(b * 2048 + pos) * NQKV + 2560 + kvh * 64 + 8 * c, v);
#pragma unroll
        for (int e = 0; e < 8; ++e) VT[(8 * c + e) * 264 + jj] = (bf16_t)f2bf(v[e]);
        if (wr_state && jj >= 128) { float* fo = P.out + O_PV + ((size_t)(b * 128 + (jj - 128)) * 8 + kvh) * 64 + 8 * c;
#pragma unroll
            for (int e = 0; e < 8; ++e) fo[e] = v[e]; } }
    for (int i = 0; i < 2; ++i) { const int q = tid + NTHREADS * i, qr = q >> 2, c = q & 3; const int hsel = qr >> 7, qi = qr & 127, head = kvh * 4 + hp * 2 + hsel, pos = qb * 128 + qi;
        rope_stage(QKV + (size_t)(b * 2048 + pos) * NQKV + head * 64, ROPE + (size_t)pos * 64, c, 0.125f, Qs + qr * 72, nullptr, false); }
    __syncthreads();
    const int r = lane & 31, h = lane >> 5;
    const int hsel = wave >> 2, q0 = 32 * (wave & 3), head = kvh * 4 + hp * 2 + hsel;
    f32x16 st[5];
#pragma unroll
    for (int kt = 0; kt < 5; ++kt) { st[kt] = zero16(); mma_tile(st[kt], Ks + (q0 + 32 * kt) * 72, 72, Qs + (hsel * 128 + q0) * 72, 72, 64, lane); }
    const float sink = P.in[30][head];
    float m = sink;
#pragma unroll
    for (int kt = 0; kt < 5; ++kt)
#pragma unroll
        for (int reg = 0; reg < 16; ++reg) { const int dk = 32 * kt + rowmap(reg, h); const bool valid = (dk > r) && (dk <= r + 128);
            st[kt][reg] = valid ? st[kt][reg] : -1e30f; m = fmaxf(m, st[kt][reg]); }
    m = fmaxf(m, __shfl_xor(m, 32));
    float l = 0.f;
#pragma unroll
    for (int kt = 0; kt < 5; ++kt)
#pragma unroll
        for (int reg = 0; reg < 16; ++reg) { const float p = __expf(st[kt][reg] - m); st[kt][reg] = p; l += p; }
    l += __shfl_xor(l, 32);
    l += __expf(sink - m);
    const float linv = 1.f / l;
    bf16_t* O = (bf16_t*)(P.ws + WS_ATTO) + (size_t)(b * 2048 + qb * 128 + q0 + r) * 2048 + head * 64;
#pragma unroll
    for (int dt = 0; dt < 2; ++dt) {
        f32x16 ao = zero16();
#pragma unroll
        for (int kt = 0; kt < 5; ++kt)
#pragma unroll
            for (int s = 0; s < 2; ++s) {
                u32x4 pb; pb.x = pk2(st[kt][8 * s], st[kt][8 * s + 1]); pb.y = pk2(st[kt][8 * s + 2], st[kt][8 * s + 3]); pb.z = pk2(st[kt][8 * s + 4], st[kt][8 * s + 5]); pb.w = pk2(st[kt][8 * s + 6], st[kt][8 * s + 7]);
                const LAS bf16_t* vp = VT + (32 * dt + r) * 264 + q0 + 32 * kt + 16 * s + 4 * h;
                const u32x2 v0 = *(const LAS u32x2*)vp, v1 = *(const LAS u32x2*)(vp + 8);
                u32x4 va; va.x = v0.x; va.y = v0.y; va.z = v1.x; va.w = v1.y;
                ao = __builtin_amdgcn_mfma_f32_32x32x16_bf16(__builtin_bit_cast(bf16x8, va), __builtin_bit_cast(bf16x8, pb), ao, 0, 0, 0);
            }
#pragma unroll
        for (int gq = 0; gq < 4; ++gq) { u32x2 w; w.x = pk2(ao[4 * gq] * linv, ao[4 * gq + 1] * linv); w.y = pk2(ao[4 * gq + 2] * linv, ao[4 * gq + 3] * linv);
            *(u32x2*)(O + 32 * dt + 8 * gq + 4 * h) = w; }
    }
    __syncthreads();
}
DEV void attn_sample_item(const Params& P, LAS unsigned char* lds, int it, int tid, int lane, int wave) {
    const int b = it >> 3, kvh = it & 7;
    LAS float* Kf = (LAS float*)lds;
    LAS float* Vf = Kf + 136 * 65;
    LAS float* Qf = Vf + 136 * 64;
    LAS float* Sc = Qf + 32 * 65;
    const bf16_t* QKV = (const bf16_t*)(P.ws + WS_QKV); const float* ROPE = (const float*)(P.ws + WS_ROPE);
    for (int q = tid; q < 136 * 32; q += NTHREADS) { const int jj = q >> 5, d = q & 31; float k1, k2, v1, v2;
        if (jj < 128) { const size_t o = ((size_t)(b * 128 + jj) * 8 + kvh) * 64; k1 = P.in[6][o + d]; k2 = P.in[6][o + 32 + d]; v1 = P.in[7][o + d]; v2 = P.in[7][o + 32 + d]; }
        else { const int t = jj - 128; const bf16_t* row = QKV + (size_t)(TP + b * 8 + t) * NQKV; const float a = bf2f(row[2048 + kvh * 64 + d]), c2 = bf2f(row[2048 + kvh * 64 + 32 + d]);
            const float co = ROPE[((size_t)(2048 + t) * 32 + d) * 2], si = ROPE[((size_t)(2048 + t) * 32 + d) * 2 + 1];
            k1 = a * co - c2 * si; k2 = c2 * co + a * si; v1 = bf2f(row[2560 + kvh * 64 + d]); v2 = bf2f(row[2560 + kvh * 64 + 32 + d]); }
        Kf[jj * 65 + d] = k1; Kf[jj * 65 + 32 + d] = k2; Vf[jj * 64 + d] = v1; Vf[jj * 64 + 32 + d] = v2;
        if (jj >= 8) { const size_t o = ((size_t)(b * 128 + (jj - 8)) * 8 + kvh) * 64; P.out[O_SK + o + d] = k1; P.out[O_SK + o + 32 + d] = k2; P.out[O_SV + o + d] = v1; P.out[O_SV + o + 32 + d] = v2; } }
    for (int q = tid; q < 32 * 32; q += NTHREADS) { const int qr = q >> 5, d = q & 31, hq = qr >> 3, t = qr & 7, head = kvh * 4 + hq; const bf16_t* row = QKV + (size_t)(TP + b * 8 + t) * NQKV + head * 64;
        const float a = bf2f(row[d]), c2 = bf2f(row[32 + d]); const float co = ROPE[((size_t)(2048 + t) * 32 + d) * 2], si = ROPE[((size_t)(2048 + t) * 32 + d) * 2 + 1];
        Qf[qr * 65 + d] = (a * co - c2 * si) * 0.125f; Qf[qr * 65 + 32 + d] = (c2 * co + a * si) * 0.125f; }
    __syncthreads();
    const int qr = tid >> 4, kl = tid & 15, t = qr & 7, head = kvh * 4 + (qr >> 3);
    const float sink = P.in[30][head];
    float m = sink;
    for (int i = 0; i < 9; ++i) { const int jj = kl + 16 * i; if (jj < 136) { float s = 0.f;
#pragma unroll 16
            for (int d = 0; d < 64; ++d) s += Qf[qr * 65 + d] * Kf[jj * 65 + d];
            const bool valid = jj < 128 ? (jj >= t + 1) : ((jj - 128) <= t);
            s = valid ? s : -1e30f; Sc[qr * 136 + jj] = s; m = fmaxf(m, s); } }
    m = fmaxf(m, __shfl_xor(m, 1)); m = fmaxf(m, __shfl_xor(m, 2)); m = fmaxf(m, __shfl_xor(m, 4)); m = fmaxf(m, __shfl_xor(m, 8));
    float l = 0.f;
    for (int i = 0; i < 9; ++i) { const int jj = kl + 16 * i; if (jj < 136) { const float p = __expf(Sc[qr * 136 + jj] - m); Sc[qr * 136 + jj] = p; l += p; } }
    l += __shfl_xor(l, 1); l += __shfl_xor(l, 2); l += __shfl_xor(l, 4); l += __shfl_xor(l, 8);
    l += __expf(sink - m);
    __syncthreads();
    f32x4 o = (f32x4){0.f, 0.f, 0.f, 0.f};
    for (int jj = 0; jj < 136; ++jj) { const float p = Sc[qr * 136 + jj]; const f32x4 v = *(const LAS f32x4*)(Vf + jj * 64 + 4 * kl); o = o + v * p; }
    const float linv = 1.f / l;
    u32x2 w; w.x = pk2(o.x * linv, o.y * linv); w.y = pk2(o.z * linv, o.w * linv);
    *(u32x2*)((bf16_t*)(P.ws + WS_ATTO) + (size_t)(TP + b * 8 + t) * 2048 + head * 64 + 4 * kl) = w;
    __syncthreads();
}

DEV void gemm_to_mix(const Params& P, LAS unsigned char* lds, const bf16_t* A, const bf16_t* Bt, int K) {
    const int G = gridDim.x, bid = blockIdx.x;
    { pg8::Gemm g{A, Bt, K, K, K}; pg8::StaticOrder S; S.init(TP, DM, G, bid); pg8::EpiBf16<3> E{(bf16_t*)(P.ws + WS_MIX), DM, nullptr, nullptr, -1}; pg8::gemm_phase(lds, g, S, E); }
    { pg8::Gemm g{A + (size_t)TP * K, Bt, 256, K, K}; pg8::SplitKOrder S{8, K / 256, 256, G, bid}; pg8::EpiF32 E{(float*)(P.ws + WS_PART), DM, 256}; pg8::gemm_phase(lds, g, S, E); }
}

__global__ void __launch_bounds__(NTHREADS, 2) hybrid_fwd(Params P) {
    extern __shared__ __attribute__((aligned(16))) unsigned char lds_raw[];
    LAS unsigned char* lds = (LAS unsigned char*)lds_raw;
    cg::grid_group grid = cg::this_grid();
    const int tid0 = threadIdx.x;
    const int G = gridDim.x, bid = blockIdx.x;
    unsigned char* ws = P.ws;
    if (tid0 < 16) ((LAS unsigned*)(lds + 147456))[tid0] = 0u;
    __syncthreads();
    const XcdBarrier bar = xcd_barrier_post((unsigned*)(ws + WS_BAR), (volatile LAS unsigned*)(lds + 147456));
    if (G == 0x7ffffff) grid.sync();
#define GSYNC() xcd_barrier(bar)

#define LAUNDER() int tid = tid0; asm volatile("" : "+v"(tid)); const int lane = tid & 63, wave = __builtin_amdgcn_readfirstlane(tid >> 6)
#ifndef ONLY
#define PH(k) true
#else
#define PH(k) ((k) == ONLY)
#endif
    REP(16) { for (int i_ = 0; i_ < ((DBL) == 16 ? 10 : 0); ++i_) GSYNC(); }
    if (PH(0)) REP(0) { LAUNDER(); phase0(P, lds, tid, lane, wave); }
    GSYNC();
    if (PH(1)) REP(1) { LAUNDER(); norm_phase(P, lds, true, false, 0, 0, 0,   0, 0,   0,   1, 0, lane, wave); }
    GSYNC();
    if (PH(2)) REP(2) {
        pg8::Gemm g{(const bf16_t*)(ws + WS_H), (const bf16_t*)(ws + WS_WIN), DM, DM, DM}; pg8::StaticOrder S; S.init(TT, NPROJ, G, bid);
        pg8::EpiBf16<0> E{(bf16_t*)(ws + WS_PROJ), NPROJ, nullptr, (float*)(ws + WS_DT), 40}; pg8::gemm_phase(lds, g, S, E);
        const int nbusy = (33 * 41) % G;
        if (TAILS && bid >= nbusy) { LAUNDER(); const int widx = (bid - nbusy) * 8 + wave, nw = (G - nbusy) * 8;
            if (G <= 192) transpose_range(P, lds, 5152, 7200, widx, 1, nw, lane, wave);
            transpose_range(P, lds, 9760, 13856, widx, 1, nw, lane, wave); }
    }
    GSYNC();
    if (PH(3)) REP(3) { LAUNDER(); phase3(P, lds, tid, lane, wave); }
    GSYNC();
    if (PH(4)) REP(4) { LAUNDER(); phase4(P, lds, tid, lane, wave); }
    GSYNC();
    if (PH(5) || PH(11)) REP(5) { LAUNDER(); phase5(P, lds, tid, lane, wave); }
    GSYNC();
    if (PH(6)) REP(6) gemm_to_mix(P, lds, (const bf16_t*)(ws + WS_YMIX), (const bf16_t*)(ws + WS_WOH), 4096);
    GSYNC();
    for (int layer = 0; layer < 2; ++layer) {
        if (PH(1)) { LAUNDER(); if (layer == 0) norm_phase(P, lds, false, false, 0, 1, 2, 0, 2, 3, 4, 16, lane, wave, 1.f, true); else norm_phase(P, lds, false, false, 1, 1, 2, 1, 2, 3, 4, 8, lane, wave, 1.f, false); }
        if (DBL == 30) { GSYNC(); LAUNDER(); norm_phase(P, lds, false, false, layer, 1, 2, layer, 2, 3, 4, layer == 0 ? 16 : 8, lane, wave, 0.f, false); }
        GSYNC();
        if (PH(7)) REP(7) {
            pg8::Gemm g{(const bf16_t*)(ws + WS_H), (const bf16_t*)(ws + WS_WUP) + (size_t)layer * DFF * DM, DM, DM, DM}; pg8::StaticOrder S; S.init(TT, DFF, G, bid);
            pg8::EpiBf16<1> E{(bf16_t*)(ws + WS_UP), DFF, nullptr, nullptr, -1}; pg8::gemm_phase(lds, g, S, E);
            const int nbusy = (33 * 32) % G;
            if (TAILS && bid >= nbusy) { LAUNDER(); const int widx = (bid - nbusy) * 8 + wave, nw = (G - nbusy) * 8;
                if (layer == 0) { transpose_range(P, lds, 17952, 22048, widx, 1, nw, lane, wave); transpose_range(P, lds, 7200, 9760, widx, 1, nw, lane, wave); }
                else transpose_range(P, lds, 22048, 26144, widx, 1, nw, lane, wave); }
        }
        GSYNC();
        if (PH(6)) REP(12) gemm_to_mix(P, lds, (const bf16_t*)(ws + WS_UP), (const bf16_t*)(ws + WS_WDN) + (size_t)layer * DM * DFF, DFF);
        GSYNC();
        if (layer == 0) {
            if (PH(1)) { LAUNDER(); norm_phase(P, lds, false, false, 0, 3, 5, 1, 0, 0, 1, 32, lane, wave); }
            if (DBL == 30) { GSYNC(); LAUNDER(); norm_phase(P, lds, false, false, 0, 3, 5, 1, 0, 0, 1, 32, lane, wave, 0.f); }
            GSYNC();
            if (PH(8)) REP(8) {
                pg8::Gemm g{(const bf16_t*)(ws + WS_H), (const bf16_t*)(ws + WS_WQKV), DM, DM, DM}; pg8::StaticOrder S; S.init(TT, NQKV, G, bid);
                pg8::EpiBf16<2> E{(bf16_t*)(ws + WS_QKV), NQKV, P.in[29], nullptr, -1}; pg8::gemm_phase(lds, g, S, E);
                const int nbusy = (33 * 12) % G;
                if (TAILS && bid >= nbusy) { LAUNDER(); const int widx = (bid - nbusy) * 8 + wave, nw = (G - nbusy) * 8;
                    transpose_range(P, lds, 13856, 17952, widx, 1, nw, lane, wave); }
            }
            GSYNC();
            if (PH(9)) REP(9) { LAUNDER(); for (int it = bid; it < 1024; it += G) attn_prompt_item(P, lds, it, tid, lane, wave); }
            if (PH(10)) REP(10) { LAUNDER(); for (int it = bid; it < 256; it += G) attn_sample_item(P, lds, it, tid, lane, wave); }
            GSYNC();
            if (PH(6)) REP(13) gemm_to_mix(P, lds, (const bf16_t*)(ws + WS_ATTO), (const bf16_t*)(ws + WS_WOA), DM);
            GSYNC();
        } else {
            if (PH(1)) { LAUNDER(); norm_phase(P, lds, false, true, 1, 3, 5, 0, 0, 0, 0, 32, lane, wave); }
        }
    }
}

extern "C" void kernel_launch(void* const* d_in, const int* in_sizes, int n_in, void* d_out, int out_size, void* d_ws, size_t ws_size, hipStream_t stream) {
    static int inited = 0;
    if (!inited) { (void)hipFuncSetAttribute((const void*)hybrid_fwd, hipFuncAttributeMaxDynamicSharedMemorySize, LDS_BYTES); inited = 1; }
    (void)hipMemsetAsync((char*)d_ws + WS_BAR, 0, 16384, stream);
    Params p{};
    for (int i = 0; i < 34; ++i) p.in[i] = (const float*)d_in[i];
    p.out = (float*)d_out; p.ws = (unsigned char*)d_ws;
    void* args[] = {&p};
    (void)hipLaunchCooperativeKernel((const void*)hybrid_fwd, dim3(256), dim3(NTHREADS), args, LDS_BYTES, stream);
}
```

```cpp
#include <hip/hip_runtime.h>
#include <hip/hip_cooperative_groups.h>
namespace cg = cooperative_groups;

#define LAS __attribute__((address_space(3)))
#define DEV __device__ __forceinline__
typedef unsigned short bf16_t;
typedef short bf16x8 __attribute__((ext_vector_type(8)));
typedef short bf16x4 __attribute__((ext_vector_type(4)));
typedef float f32x2 __attribute__((ext_vector_type(2)));
typedef float f32x4 __attribute__((ext_vector_type(4)));
typedef float f32x16 __attribute__((ext_vector_type(16)));
typedef unsigned u32x2 __attribute__((ext_vector_type(2)));
typedef unsigned u32x4 __attribute__((ext_vector_type(4)));

constexpr int TP = 8192, TS = 256, TT = TP + TS, DM = 2048, NPROJ = 10496, DFF = 8192, NQKV = 3072;
constexpr int PC_XBC = 2048, PC_GATE = 6144, PC_XR = 8192;
constexpr float EPSN = 1e-6f;
constexpr size_t MiB = 1u << 20;
constexpr size_t WS_CDEC = 0, WS_ROPE = 1 * MiB, WS_MOD = 2 * MiB, WS_WIN = 6 * MiB, WS_WOH = 47 * MiB, WS_WQKV = 63 * MiB, WS_WOA = 75 * MiB, WS_WUP = 83 * MiB,
                 WS_WDN = 147 * MiB, WS_WLRU = 211 * MiB, WS_DT = 213 * MiB, WS_H = 215 * MiB, WS_A = 248 * MiB, WS_B = 418 * MiB, WS_YMIX = 550 * MiB, WS_MIX = 616 * MiB;
constexpr size_t WS_X16 = 682 * MiB;
constexpr size_t WS_PART = WS_B, WS_AU_U = WS_B + 66 * MiB, WS_QKV = WS_B, WS_ATTO = WS_B + 50 * MiB, WS_CS = WS_MIX, WS_HIN = WS_H, WS_PROJ = WS_A, WS_UP = WS_A;
constexpr size_t O_YP = 0, O_YS = O_YP + (size_t)4 * 2048 * 2048, O_PSC = O_YS + 32 * 8 * 2048, O_PSSM = O_PSC + 4 * 3 * 4096, O_PLC = O_PSSM + (size_t)4 * 32 * 64 * 128,
                 O_PL = O_PLC + 4 * 3 * 2048, O_PK = O_PL + 4 * 2048, O_PV = O_PK + 4 * 128 * 8 * 64, O_SSC = O_PV + 4 * 128 * 8 * 64, O_SSSM = O_SSC + 32 * 3 * 4096,
                 O_SLC = O_SSSM + (size_t)32 * 32 * 64 * 128, O_SL = O_SLC + 32 * 3 * 2048, O_SK = O_SL + 32 * 2048, O_SV = O_SK + (size_t)32 * 128 * 8 * 64;
constexpr int LDS_BYTES = 147456 + 64;
constexpr size_t WS_BAR = 65536;
constexpr int NTHREADS = 512;

#ifndef DBL
#define DBL -1
#endif
#ifndef TAILS
#define TAILS 1
#endif
#define REP(k) for (int rep_ = 0; rep_ < ((DBL) == (k) ? 2 : 1); ++rep_, __syncthreads())
struct Params { const float* in[34]; float* out; unsigned char* ws; };

DEV unsigned f2bf(float f) { unsigned u = __float_as_uint(f); return (u + 0x7fffu + ((u >> 16) & 1u)) >> 16; }
DEV unsigned pk2(float lo, float hi) { return f2bf(lo) | (f2bf(hi) << 16); }
DEV float bf2f(unsigned short b) { return __uint_as_float(((unsigned)b) << 16); }
DEV float bflo(unsigned w) { return __uint_as_float(w << 16); }
DEV float bfhi(unsigned w) { return __uint_as_float(w & 0xffff0000u); }
DEV float sigm(float x) { return 1.f / (1.f + __expf(-x)); }
DEV float siluf(float x) { return x * sigm(x); }
DEV float softplusf(float x) { return x > 20.f ? x : log1pf(__expf(x)); }
DEV float geluf(float x) { return x * sigm(1.5957691216057308f * (x + 0.044715f * x * x * x)); }
DEV float wave_sum(float v) {
#pragma unroll
    for (int o = 1; o < 64; o <<= 1) v += __shfl_xor(v, o);
    return v;
}
DEV void ld8(const bf16_t* p, float (&v)[8]) {
    const u32x4 w = *(const u32x4*)p;
    v[0] = bflo(w.x); v[1] = bfhi(w.x); v[2] = bflo(w.y); v[3] = bfhi(w.y); v[4] = bflo(w.z); v[5] = bfhi(w.z); v[6] = bflo(w.w); v[7] = bfhi(w.w);
}
DEV void ldf8(const float* p, float (&v)[8]) {
    const f32x4 a = *(const f32x4*)p, b = *(const f32x4*)(p + 4);
    v[0] = a.x; v[1] = a.y; v[2] = a.z; v[3] = a.w; v[4] = b.x; v[5] = b.y; v[6] = b.z; v[7] = b.w;
}
DEV u32x4 pack8(const float (&v)[8]) { u32x4 w; w.x = pk2(v[0], v[1]); w.y = pk2(v[2], v[3]); w.z = pk2(v[4], v[5]); w.w = pk2(v[6], v[7]); return w; }
DEV int rowmap(int reg, int h) { return (reg & 3) + 8 * (reg >> 2) + 4 * h; }
#define LDS_WAIT() asm volatile("s_waitcnt lgkmcnt(0)" ::: "memory")

DEV void conv8(const bf16_t* PROJ, int r, int tl, int pcol, const float* hist, int C, const float (&w)[4][8], const float (&bias)[8], float (&o)[8]) {
#pragma unroll
    for (int e = 0; e < 8; ++e) o[e] = bias[e];
#pragma unroll
    for (int d = 0; d < 4; ++d) {
        float v[8];
        if (tl - d >= 0) ld8(PROJ + (size_t)(r - d) * NPROJ + pcol, v);
        else if (hist) ldf8(hist + (size_t)(3 + tl - d) * C, v);
        else {
#pragma unroll
            for (int e = 0; e < 8; ++e) v[e] = 0.f;
        }
#pragma unroll
        for (int e = 0; e < 8; ++e) o[e] += w[3 - d][e] * v[e];
    }
}
DEV void ldconvw(const float* W, const float* B, int C, int c0, float (&w)[4][8], float (&bias)[8]) {
#pragma unroll
    for (int j = 0; j < 4; ++j) ldf8(W + (size_t)j * C + c0, w[j]);
    ldf8(B + c0, bias);
}
DEV void mma_tile(f32x16& acc, const LAS bf16_t* A, int lda, const LAS bf16_t* B, int ldb, int K, int lane) {
    const int r = lane & 31, h = lane >> 5;
    const LAS bf16_t* ap = A + r * lda + 8 * h; const LAS bf16_t* bp = B + r * ldb + 8 * h;
    for (int k = 0; k < K; k += 16) {
        const bf16x8 a = *(const LAS bf16x8*)(ap + k); const bf16x8 b = *(const LAS bf16x8*)(bp + k);
        acc = __builtin_amdgcn_mfma_f32_32x32x16_bf16(a, b, acc, 0, 0, 0);
    }
}
DEV f32x16 zero16() { f32x16 z;
#pragma unroll
    for (int i = 0; i < 16; ++i) z[i] = 0.f;
    return z; }

#define XB_TMO      128
#define XB_XCNT(j)  (256  + 64 * (j))
#define XB_XSUB(j)  (1280 + 64 * (j))
#define XB_XGEN(j)  (2304 + 64 * (j))
#define XB_TOP      3328
#define XB_TOPGEN   3392
#define XCD_BAR_WORDS 3456
#define XB_SPIN_CAP (1u << 18)

__device__ __forceinline__ unsigned xb_ld(unsigned* p)              { return __hip_atomic_load(p, __ATOMIC_RELAXED, __HIP_MEMORY_SCOPE_AGENT); }
__device__ __forceinline__ unsigned xb_add(unsigned* p, unsigned v) { return __hip_atomic_fetch_add(p, v, __ATOMIC_RELAXED, __HIP_MEMORY_SCOPE_AGENT); }
__device__ __forceinline__ unsigned xb_xcc_id() { return (unsigned)__builtin_amdgcn_s_getreg((3 << 11) | 20) & 0xFu; }
#define XB_SPIN(cond, bar) do { unsigned _sp = 0; while (cond) { __builtin_amdgcn_s_sleep(1); \
    if ((++_sp & 255u) == 0u) { if (xb_ld(&(bar)[XB_TMO])) break; if (_sp > XB_SPIN_CAP) { atomicAdd(&(bar)[XB_TMO], 1u); break; } } } } while (0)

struct XcdBarrier {
    unsigned* bar; unsigned x;
    volatile LAS unsigned* st;
};

__device__ __forceinline__ XcdBarrier xcd_barrier_post(unsigned* bar, volatile LAS unsigned* st) {
    XcdBarrier b; b.bar = bar; b.x = xb_xcc_id(); b.st = st;
    if (threadIdx.x == 0) (void)xb_add(&bar[XB_XCNT(b.x)], 1u);
    return b;
}
__device__ __forceinline__ void xcd_barrier_complete(unsigned* bar, unsigned x, unsigned& nloc, unsigned& nx) {
    const unsigned G = gridDim.x * gridDim.y * gridDim.z;
    unsigned sum, cnt, mine, sp = 0u;
    for (;;) {
        sum = 0u; cnt = 0u; mine = 0u;
#pragma unroll
        for (unsigned j = 0; j < 16; ++j) { const unsigned c = xb_ld(&bar[XB_XCNT(j)]); sum += c; cnt += (c > 0u) ? 1u : 0u; mine = (j == x) ? c : mine; }
        if (sum == G) break;
        __builtin_amdgcn_s_sleep(1);
        if ((++sp & 255u) == 0u) { if (xb_ld(&bar[XB_TMO])) break; if (sp > XB_SPIN_CAP) { atomicAdd(&bar[XB_TMO], 1u); break; } }
    }
    nloc = mine > 0u ? mine : 1u; nx = cnt > 0u ? cnt : 1u;
}

__device__ __forceinline__ void xcd_barrier(const XcdBarrier& b) {
    asm volatile("s_waitcnt vmcnt(0)" ::: "memory");
    __syncthreads();
    if (threadIdx.x == 0) {
        unsigned* bar = b.bar;
        __builtin_amdgcn_s_waitcnt(0);
        unsigned nloc = b.st[0], nx = b.st[1];
        if (nloc == 0u) { xcd_barrier_complete(bar, b.x, nloc, nx); b.st[0] = nloc; b.st[1] = nx; }
        const unsigned old = xb_add(&bar[XB_XSUB(b.x)], 1u);
        const unsigned gen = old / nloc;
        if (old + 1u == (gen + 1u) * nloc) {
            __builtin_amdgcn_fence(__ATOMIC_RELEASE, "agent");
            asm volatile("s_waitcnt vmcnt(0)" ::: "memory");
            const unsigned og = xb_add(&bar[XB_TOP], 1u);
            const unsigned tg = og / nx;
            if (og + 1u == (tg + 1u) * nx) xb_add(&bar[XB_TOPGEN], 1u);
            else XB_SPIN(xb_ld(&bar[XB_TOPGEN]) == tg, bar);
            __builtin_amdgcn_fence(__ATOMIC_ACQUIRE, "agent");
            xb_add(&bar[XB_XGEN(b.x)], 1u);
            asm volatile("s_waitcnt vmcnt(0)" ::: "memory");
        } else {
            XB_SPIN(xb_ld(&bar[XB_XGEN(b.x)]) == gen, bar);
            __builtin_amdgcn_fence(__ATOMIC_ACQUIRE, "agent");
            asm volatile("s_waitcnt vmcnt(0)" ::: "memory");
        }
    }
    __syncthreads();
}

namespace pg8 {
constexpr int BM = 256, BK = 64, HALF = 128, HTB = HALF * BK * 2, NXCD = 8, WGM = 8;
__host__ __device__ __forceinline__ int lds_byte(int r, int c) { const int st = (r >> 4) * 2 + (c >> 5), rr = r & 15, cc = c & 31, ob = rr * 64 + cc * 2; return st * 1024 + (ob ^ (((ob >> 9) & 1) << 5)); }
__host__ __device__ __forceinline__ void stage_rc(int b, int& R, int& C) { const int st = b / 1024, sb = b % 1024, swz = sb ^ (((sb >> 9) & 1) << 5); R = (st >> 1) * 16 + swz / 64; C = (st & 1) * 32 + (swz % 64) / 2; }
__host__ __device__ __forceinline__ int perm32(int rho) { const int n = rho >> 4, i = rho & 15; return 8 * (i >> 2) + 4 * n + (i & 3); }
struct Unit { int pm, pn, k0; };
struct Gemm { const bf16_t* A; const bf16_t* Bt; int K, lda, ldb; };
struct StaticOrder {
    int nM, nN, nwg, G, c;
    __device__ void init(int M, int N, int G_, int c_) { nM = M / BM; nN = N / BM; nwg = nM * nN; G = G_; c = c_; }
    __device__ bool next(int i, Unit& u) const {
        const long L = (long)i * G + c; if (L >= nwg) return false;
        int wgid = (int)L; { const int q = nwg / NXCD, r = nwg % NXCD, xcd = wgid % NXCD, off = wgid / NXCD; wgid = (xcd < r ? xcd * (q + 1) : r * (q + 1) + (xcd - r) * q) + off; }
        const int nig = WGM * nN, gid = wgid / nig, fm = gid * WGM, gsz = (nM - fm) < WGM ? (nM - fm) : WGM;
        u.pm = fm + ((wgid % nig) % gsz); u.pn = (wgid % nig) / gsz; u.k0 = 0; return true;
    }
};
struct SplitKOrder {
    int nN, nsplit, Kc, G, c;
    __device__ bool next(int i, Unit& u) const { const long L = (long)i * G + c; if (L >= (long)nN * nsplit) return false; u.pm = 0; u.pn = (int)(L % nN); u.k0 = (int)(L / nN) * Kc; return true; }
};
DEV unsigned cvt_pk_bf16(float lo, float hi) { unsigned r; asm volatile("v_cvt_pk_bf16_f32 %0, %1, %2" : "=v"(r) : "v"(lo), "v"(hi)); return r; }

struct EpiF32 {
    static constexpr bool PERM = false;
    float* C; int ldc; int kc;
    DEV void operator()(const f32x4 (&acc)[2][2][4][2], const Unit& u, int wr, int wc, int fr, int fq) const {
        float* Cb = C + (kc > 0 ? (size_t)(u.k0 / kc) * 256 * ldc : (size_t)0);
        const unsigned base = (unsigned)((u.pm * BM + wr * 64 + fr) * ldc + u.pn * BM + wc * 32 + 4 * fq);
#pragma unroll
        for (int ai = 0; ai < 2; ++ai)
#pragma unroll
            for (int m = 0; m < 4; ++m) { const unsigned o = base + (unsigned)((ai * HALF + m * 16) * ldc);
#pragma unroll
                for (int bj = 0; bj < 2; ++bj)
#pragma unroll
                    for (int n = 0; n < 2; ++n) *(f32x4*)(Cb + o + bj * HALF + n * 16) = acc[ai][bj][m][n];
                asm volatile("" ::: "memory"); }
    }
};
template <int MODE  > struct EpiBf16 {
    static constexpr bool PERM = true;
    bf16_t* O; int ldc; const float* bias; float* DT; int dt_pn;
    DEV void operator()(const f32x4 (&acc)[2][2][4][2], const Unit& u, int wr, int wc, int fr, int fq) const {
        const int row0 = u.pm * BM + wr * 64 + fr; const int col0 = u.pn * BM + wc * 32 + 8 * fq;
        if (MODE == 0 && u.pn == dt_pn) {
            if (wc == 0) {
#pragma unroll
                for (int ai = 0; ai < 2; ++ai)
#pragma unroll
                    for (int m = 0; m < 4; ++m) { float* rowp = DT + (size_t)(row0 + ai * HALF + m * 16) * 32 + 8 * fq;
                        *(f32x4*)(rowp) = acc[ai][0][m][0]; *(f32x4*)(rowp + 4) = acc[ai][0][m][1]; }
            }
            return;
        }
        f32x4 bv[2][2];
#pragma unroll
        for (int bj = 0; bj < 2; ++bj)
#pragma unroll
            for (int n = 0; n < 2; ++n) bv[bj][n] = (MODE == 2) ? *(const f32x4*)(bias + col0 + bj * HALF + 4 * n) : (f32x4){0.f, 0.f, 0.f, 0.f};
#pragma unroll
        for (int ai = 0; ai < 2; ++ai)
#pragma unroll
            for (int m = 0; m < 4; ++m) { bf16_t* rowp = O + (size_t)(row0 + ai * HALF + m * 16) * ldc + col0;
#pragma unroll
                for (int bj = 0; bj < 2; ++bj) { f32x4 v0 = acc[ai][bj][m][0] + bv[bj][0], v1 = acc[ai][bj][m][1] + bv[bj][1];
                    if (MODE == 1) {
#pragma unroll
                        for (int j = 0; j < 4; ++j) { const float a = fmaxf(v0[j], 0.f), b = fmaxf(v1[j], 0.f); v0[j] = a * a; v1[j] = b * b; } }
                    u32x4 w; w.x = cvt_pk_bf16(v0[0], v0[1]); w.y = cvt_pk_bf16(v0[2], v0[3]); w.z = cvt_pk_bf16(v1[0], v1[1]); w.w = cvt_pk_bf16(v1[2], v1[3]);
                    *(u32x4*)(rowp + bj * HALF) = w; } }
    }
};

template <class Epi, class Sched>
DEV void gemm_phase(LAS unsigned char* lds, const Gemm g, const Sched& S, const Epi& E) {
    int tid_l = threadIdx.x; asm volatile("" : "+v"(tid_l));
    const int tid = tid_l, wid = __builtin_amdgcn_readfirstlane(tid >> 6), lane = tid & 63, wr = wid >> 2, wc = wid & 3, fr = lane & 15, fq = lane >> 4;
    const int nt = g.K / BK;
    unsigned voffA[2], voffB[2];
#pragma unroll
    for (int i = 0; i < 2; ++i) { int R, C; stage_rc(tid * 16 + i * 8192, R, C); const int Rb = Epi::PERM ? ((R & ~31) + perm32(R & 31)) : R;
        voffA[i] = (unsigned)(R * g.lda + C) * 2u; voffB[i] = (unsigned)(Rb * g.ldb + C) * 2u; }
    const size_t kstep = (size_t)(BK * 2);
    const size_t hsA = (size_t)HALF * g.lda * 2, hsB = (size_t)HALF * g.ldb * 2;
    const size_t tsA = 2 * hsA, tsB = 2 * hsB;
    const unsigned ldsw = (unsigned)wid * 1024u;
    const int aoff = lds_byte(wr * 64 + fr, fq * 8), boff = lds_byte(wc * 32 + fr, fq * 8);
#define PG8_SA(b, h) (((b) * 2 + (h)) * HTB)
#define PG8_SB(b, h) ((4 + (b) * 2 + (h)) * HTB)
#define PG8_STAGE(bufoff, gbase, voff) do { _Pragma("unroll") for (int _i = 0; _i < 2; ++_i) \
        __builtin_amdgcn_global_load_lds((const unsigned*)((const char*)(gbase) + (voff)[_i]), (LAS unsigned*)(lds + (bufoff) + ldsw + _i * 8192), 16, 0, 0); } while (0)
#define PG8_LDA(dst, b, h) do { _Pragma("unroll") for (int m = 0; m < 4; ++m) _Pragma("unroll") for (int k = 0; k < 2; ++k) dst[m][k] = *(const LAS bf16x8*)(lds + PG8_SA(b, h) + aoff + m * 2048 + k * 1024); } while (0)
#define PG8_LDB(dst, b, h) do { _Pragma("unroll") for (int n = 0; n < 2; ++n) _Pragma("unroll") for (int k = 0; k < 2; ++k) dst[n][k] = *(const LAS bf16x8*)(lds + PG8_SB(b, h) + boff + n * 2048 + k * 1024); } while (0)
#define PG8_MMA(ai, bj, At, Bt) do { __builtin_amdgcn_s_setprio(1); _Pragma("unroll") for (int m = 0; m < 4; ++m) _Pragma("unroll") for (int n = 0; n < 2; ++n) _Pragma("unroll") for (int k = 0; k < 2; ++k) \
        acc[ai][bj][m][n] = __builtin_amdgcn_mfma_f32_16x16x32_bf16(Bt[n][k], At[m][k], acc[ai][bj][m][n], 0, 0, 0); __builtin_amdgcn_s_setprio(0); } while (0)
#define PG8_WAIT_V(n) asm volatile("s_waitcnt vmcnt(" #n ")" ::: "memory")
#define PG8_WAIT_L(n) asm volatile("s_waitcnt lgkmcnt(" #n ")" ::: "memory")
#define PG8_BAR __builtin_amdgcn_s_barrier()
#define PG8_SCHED __builtin_amdgcn_sched_barrier(0)
    Unit cur, nxt; int ui = 0;
    if (!S.next(0, cur)) return;
    f32x4 acc[2][2][4][2];
#pragma unroll
    for (int a = 0; a < 2; ++a)
#pragma unroll
        for (int b = 0; b < 2; ++b)
#pragma unroll
            for (int m = 0; m < 4; ++m)
#pragma unroll
                for (int n = 0; n < 2; ++n) acc[a][b][m][n] = (f32x4){0.f, 0.f, 0.f, 0.f};
    bf16x8 At[4][2], B0[2][2], B1[2][2];
    const char* cA = (const char*)g.A + (size_t)cur.pm * tsA + (size_t)cur.k0 * 2; const char* cB = (const char*)g.Bt + (size_t)cur.pn * tsB + (size_t)cur.k0 * 2;
    PG8_STAGE(PG8_SB(0, 0), cB, voffB); PG8_STAGE(PG8_SA(0, 0), cA, voffA); PG8_STAGE(PG8_SB(0, 1), cB + hsB, voffB); PG8_STAGE(PG8_SA(0, 1), cA + hsA, voffA);
    if (wr == 1) PG8_BAR;
    PG8_WAIT_V(4); PG8_BAR;
    PG8_STAGE(PG8_SB(1, 0), cB + kstep, voffB); PG8_STAGE(PG8_SA(1, 0), cA + kstep, voffA); PG8_STAGE(PG8_SB(1, 1), cB + hsB + kstep, voffB);
    PG8_WAIT_V(6); PG8_BAR;
    for (;;) {
        const bool has_next = S.next(ui + 1, nxt);
        const char* nA = has_next ? (const char*)g.A + (size_t)nxt.pm * tsA + (size_t)nxt.k0 * 2 : cA; const char* nB = has_next ? (const char*)g.Bt + (size_t)nxt.pn * tsB + (size_t)nxt.k0 * 2 : cB;
        for (int t = 0; t < nt; t += 2) {
            const bool last = (t == nt - 2);
            const char* a1 = cA + (size_t)(t + 1) * kstep;
            const char* a2 = last ? nA : cA + (size_t)(t + 2) * kstep; const char* b2 = last ? nB : cB + (size_t)(t + 2) * kstep;
            const char* a3 = a2 + kstep; const char* b3 = b2 + kstep;
            PG8_LDB(B0, 0, 0); PG8_SCHED; PG8_LDA(At, 0, 0); PG8_STAGE(PG8_SA(1, 1), a1 + hsA, voffA);
            PG8_WAIT_L(8); PG8_BAR; PG8_WAIT_L(0); PG8_MMA(0, 0, At, B0); PG8_BAR; PG8_SCHED;
            PG8_LDB(B1, 0, 1); PG8_STAGE(PG8_SB(0, 0), b2, voffB);
            PG8_BAR; PG8_WAIT_L(0); PG8_MMA(0, 1, At, B1); PG8_BAR;
            PG8_LDA(At, 0, 1); PG8_STAGE(PG8_SA(0, 0), a2, voffA);
            PG8_BAR; PG8_WAIT_L(0); PG8_MMA(1, 0, At, B0); PG8_BAR; PG8_SCHED;
            PG8_STAGE(PG8_SB(0, 1), b2 + hsB, voffB);
            PG8_WAIT_V(6); PG8_BAR; PG8_MMA(1, 1, At, B1); PG8_BAR;
            PG8_LDB(B0, 1, 0); PG8_SCHED; PG8_LDA(At, 1, 0); PG8_STAGE(PG8_SA(0, 1), a2 + hsA, voffA);
            PG8_WAIT_L(8); PG8_BAR; PG8_WAIT_L(0); PG8_MMA(0, 0, At, B0); PG8_BAR; PG8_SCHED;
            PG8_LDB(B1, 1, 1); PG8_STAGE(PG8_SB(1, 0), b3, voffB);
            PG8_BAR; PG8_WAIT_L(0); PG8_MMA(0, 1, At, B1); PG8_BAR;
            PG8_LDA(At, 1, 1); PG8_STAGE(PG8_SA(1, 0), a3, voffA);
            PG8_BAR; PG8_WAIT_L(0); PG8_MMA(1, 0, At, B0); PG8_BAR; PG8_SCHED;
            PG8_STAGE(PG8_SB(1, 1), b3 + hsB, voffB);
            PG8_WAIT_V(6); PG8_BAR; PG8_MMA(1, 1, At, B1); PG8_BAR;
        }
        E(acc, cur, wr, wc, fr, fq);
        if (!has_next) break;
#pragma unroll
        for (int a = 0; a < 2; ++a)
#pragma unroll
            for (int b = 0; b < 2; ++b)
#pragma unroll
                for (int m = 0; m < 4; ++m)
#pragma unroll
                    for (int n = 0; n < 2; ++n) acc[a][b][m][n] = (f32x4){0.f, 0.f, 0.f, 0.f};
        cur = nxt; cA = nA; cB = nB; ++ui;
    }
    PG8_WAIT_V(0);
    if (wr == 0) PG8_BAR;
    PG8_BAR;
#undef PG8_SA
#undef PG8_SB
#undef PG8_STAGE
#undef PG8_LDA
#undef PG8_LDB
#undef PG8_MMA
#undef PG8_WAIT_V
#undef PG8_WAIT_L
#undef PG8_BAR
#undef PG8_SCHED
}
}

DEV void mod_item(const Params& P, LAS unsigned char* lds, int item, int tid, int lane, int wave) {
    const int colg = item * 128, layer = colg / 12288, n0 = colg % 12288;
    LAS float* cs = (LAS float*)(lds + wave * 9216);
    LAS float* red = (LAS float*)(lds + 73728);
    float acc[36][2];
#pragma unroll
    for (int s = 0; s < 36; ++s) { acc[s][0] = 0.f; acc[s][1] = 0.f; }
#define MOD_LOADW(dst, kq) do { const float* wr_ = Wu + (size_t)(kq) * 12288; _Pragma("unroll") for (int j_ = 0; j_ < 16; ++j_) dst[j_] = *(const f32x2*)(wr_ + (size_t)j_ * 12288 + voff); } while (0)
#define MOD_COMP(wv, koff) do { _Pragma("unroll") for (int j4_ = 0; j4_ < 4; ++j4_) { _Pragma("unroll") for (int sg = 0; sg < 4; ++sg) { \
        _Pragma("unroll") for (int s = 9 * sg; s < 9 * sg + 9; ++s) { const f32x4 c = *(const LAS f32x4*)(cs + s * 64 + (koff) + 4 * j4_); \
            acc[s][0] += c.x * wv[4 * j4_].x + c.y * wv[4 * j4_ + 1].x + c.z * wv[4 * j4_ + 2].x + c.w * wv[4 * j4_ + 3].x; \
            acc[s][1] += c.x * wv[4 * j4_].y + c.y * wv[4 * j4_ + 1].y + c.z * wv[4 * j4_ + 2].y + c.w * wv[4 * j4_ + 3].y; } \
        _Pragma("unroll") for (int s = 9 * sg; s < 9 * sg + 9; ++s) asm volatile("" : "+v"(acc[s][0]), "+v"(acc[s][1]) :: "memory"); } } } while (0)
    const float* Wu = P.in[10] + (size_t)layer * 2048 * 12288 + n0; const unsigned voff = 2u * (unsigned)lane;
    f32x2 wa[16], wb[16];
    MOD_LOADW(wa, wave * 256);
#pragma nounroll
    for (int sub = 0; sub < 4; ++sub) {
        const int kb = wave * 256 + sub * 64;
#pragma unroll 4
        for (int i = 0; i < 36; ++i) { const float v = (i < 4) ? P.in[8][i * 2048 + kb + lane] : P.in[9][(i - 4) * 2048 + kb + lane]; cs[i * 64 + lane] = siluf(v); }
        LDS_WAIT();
#pragma nounroll
        for (int g2 = 0; g2 < 2; ++g2) {
            MOD_LOADW(wb, kb + 32 * g2 + 16); MOD_COMP(wa, 32 * g2);
            if (kb + 32 * g2 + 32 < 2048) MOD_LOADW(wa, kb + 32 * g2 + 32);
            MOD_COMP(wb, 32 * g2 + 16);
        }
        LDS_WAIT();
    }
#undef MOD_LOADW
#undef MOD_COMP
    __syncthreads();
    float* MOD = (float*)(P.ws + WS_MOD);
#pragma unroll
    for (int half = 0; half < 2; ++half) {
#pragma unroll
        for (int s = 0; s < 18; ++s) *(LAS f32x2*)(red + (wave * 18 + s) * 128 + 2 * lane) = (f32x2){acc[18 * half + s][0], acc[18 * half + s][1]};
        __syncthreads();
        for (int o = tid; o < 18 * 128; o += NTHREADS) { const int s = o >> 7, c = o & 127; float v = 0.f;
#pragma unroll
            for (int w = 0; w < 8; ++w) v += red[(w * 18 + s) * 128 + c];
            MOD[(size_t)(layer * 36 + 18 * half + s) * 12288 + n0 + c] = v + P.in[11][layer * 12288 + n0 + c]; }
        __syncthreads();
    }
}
DEV void transpose_item(const float* W, int ldw, int k0, int n0, int ncols, bf16_t* WT, int ldt, int drow0, LAS float* scr, int lane) {
    if (lane < ncols) {
        float v[64];
        const float* wp = W + (size_t)k0 * ldw + n0 + lane;
#pragma unroll
        for (int kk = 0; kk < 64; ++kk) v[kk] = __builtin_nontemporal_load(wp + (size_t)kk * ldw);
#pragma unroll
        for (int kk = 0; kk < 64; ++kk) scr[kk * 65 + lane] = v[kk];
    }
    LDS_WAIT();
    const int c = lane & 7;
#pragma unroll
    for (int j = 0; j < 8; ++j) { const int n = (lane >> 3) + 8 * j;
        if (n < ncols) { const LAS float* s = scr + (8 * c) * 65 + n;
            u32x4 o; o.x = pk2(s[0], s[65]); o.y = pk2(s[2 * 65], s[3 * 65]); o.z = pk2(s[4 * 65], s[5 * 65]); o.w = pk2(s[6 * 65], s[7 * 65]);
            *(u32x4*)(WT + (size_t)(drow0 + n) * ldt + k0 + 8 * c) = o; } }
    LDS_WAIT();
}
DEV void transpose_range(const Params& P, LAS unsigned char* lds, int lo, int hi, int slot0, int myslots, int nslots, int lane, int wave) {
    unsigned char* ws = P.ws; bf16_t* WIN = (bf16_t*)(ws + WS_WIN);
    LAS float* scr = (LAS float*)(lds + wave * 16640);
    for (int sl = 0; sl < myslots; ++sl)
    for (int it = lo + slot0 + sl; it < hi; it += nslots) {
        int r = it;
        if (r < 3072) { const int kb = r / 96, nb = r % 96; transpose_item(P.in[13], 10272, kb * 64, nb * 64, 64, WIN, 2048, nb * 64, scr, lane); continue; } r -= 3072;
        if (r < 2048) { const int kb = r / 64, nb = r % 64; transpose_item(P.in[13], 10272, kb * 64, 6176 + nb * 64, 64, WIN, 2048, 6144 + nb * 64, scr, lane); continue; } r -= 2048;
        if (r < 32) { transpose_item(P.in[13], 10272, r * 64, 6144, 32, WIN, 2048, 10240, scr, lane); continue; } r -= 32;
        if (r < 2048) { const int kb = r / 32, nb = r % 32; transpose_item(P.in[27], 2048, kb * 64, nb * 64, 64, (bf16_t*)(ws + WS_WOH), 4096, nb * 64, scr, lane); continue; } r -= 2048;
        if (r < 1536) { const int kb = r / 48, nb = r % 48; transpose_item(P.in[28], 3072, kb * 64, nb * 64, 64, (bf16_t*)(ws + WS_WQKV), 2048, nb * 64, scr, lane); continue; } r -= 1536;
        if (r < 1024) { const int kb = r / 32, nb = r % 32; transpose_item(P.in[31], 2048, kb * 64, nb * 64, 64, (bf16_t*)(ws + WS_WOA), 2048, nb * 64, scr, lane); continue; } r -= 1024;
        if (r < 8192) { const int l = r / 4096; r %= 4096; const int kb = r / 128, nb = r % 128;
            transpose_item(P.in[32] + (size_t)l * 2048 * 8192, 8192, kb * 64, nb * 64, 64, (bf16_t*)(ws + WS_WUP) + (size_t)l * 8192 * 2048, 2048, nb * 64, scr, lane); continue; } r -= 8192;
        if (r < 8192) { const int l = r / 4096; r %= 4096; const int kb = r / 32, nb = r % 32;
            transpose_item(P.in[33] + (size_t)l * 8192 * 2048, 2048, kb * 64, nb * 64, 64, (bf16_t*)(ws + WS_WDN) + (size_t)l * 2048 * 8192, 8192, nb * 64, scr, lane); continue; } r -= 8192;
        { const int mat = r / 128; r %= 128; const int blk = r / 16; r %= 16; const int kb = r / 4, nb = r % 4;
            transpose_item((mat ? P.in[24] : P.in[22]) + (size_t)blk * 65536, 256, kb * 64, nb * 64, 64, (bf16_t*)(ws + WS_WLRU) + (size_t)mat * 8 * 65536 + (size_t)blk * 65536, 256, nb * 64, scr, lane); }
    }
}
DEV void phase0(const Params& P, LAS unsigned char* lds, int tid, int lane, int wave) {
    const int G = gridDim.x, bid = blockIdx.x;
    unsigned char* ws = P.ws;
    REP(20) for (int it = bid; it < 192; it += G) mod_item(P, lds, it, tid, lane, wave);
    __syncthreads();
    bf16_t* WIN = (bf16_t*)(ws + WS_WIN);
    REP(21) {
    const int nmod = G > 192 ? 192 : G, nslots = (G - nmod) * 8 * 9 + nmod * 8;
    const int myslots = bid >= nmod ? 9 : 1, slot0 = bid >= nmod ? 9 * ((bid - nmod) * 8 + wave) : (G - nmod) * 72 + (bid * 8 + wave);
#if TAILS
    transpose_range(P, lds, 0, 5152, slot0, myslots, nslots, lane, wave);
    transpose_range(P, lds, 26144, 26400, bid * 8 + wave, 1, G * 8, lane, wave);
    if (G > 192 && bid >= nmod) transpose_range(P, lds, 5152, 7200, (bid - nmod) * 8 + wave, 1, (G - nmod) * 8, lane, wave);
#else
    { const int ns2 = (G - nmod) * 8 * 3 + nmod * 8 * 2, my2 = bid >= nmod ? 3 : 2, s02 = bid >= nmod ? 3 * ((bid - nmod) * 8 + wave) : (G - nmod) * 24 + 2 * (bid * 8 + wave);
      transpose_range(P, lds, 0, 26400, s02, my2, ns2, lane, wave); }
#endif
    }
    const int gt = bid * NTHREADS + tid, NGT = G * NTHREADS;
    for (int q = gt; q < 57344; q += NGT) *((u32x4*)(WIN + (size_t)10272 * 2048) + q) = (u32x4){0u, 0u, 0u, 0u};
    float* ROPE = (float*)(ws + WS_ROPE);
    for (int q = gt; q < 2056 * 32; q += NGT) {
        const int pi = q >> 5, i = q & 31; const int pos = pi < 2048 ? pi : 16384 + (pi - 2048);
        const float invf = powf(10000.0f, -(float)i / 32.0f);
        const float ang = (float)pos * invf;
        const double a = (double)ang; const double n = rint(a * 0.15915494309189535); const float rr = (float)(a - n * 6.283185307179586);
        ROPE[2 * q] = cosf(rr); ROPE[2 * q + 1] = sinf(rr);
    }
}

DEV void norm_phase(const Params& P, LAS unsigned char* lds, bool first, bool last, int l_post, int gpost_idx, int gate_j, int l_pre, int gpre_idx, int sh_j, int sc_j, int nsplit, int lane, int wave, float gscale = 1.f, bool xin = false) {
    const int G = gridDim.x; const int gw = blockIdx.x * 8 + wave, NGW = G * 8;
    float* X = P.out; bf16_t* X16 = (bf16_t*)(P.ws + WS_X16); const bf16_t* MIXB = (const bf16_t*)(P.ws + WS_MIX); bf16_t* H = (bf16_t*)(P.ws + WS_H); const float* MOD = (const float*)(P.ws + WS_MOD);
    const float* gpo = P.in[12] + (size_t)(l_post * 4 + gpost_idx) * DM; const float* gpr = P.in[12] + (size_t)(l_pre * 4 + gpre_idx) * DM;
    const int nrows = first ? TT : TP;
#define NORM_LOADRAW(XF, XH, MH, rowi) do { const int r_ = (rowi); const float* xs_ = r_ < TP ? P.in[0] + (size_t)r_ * DM : P.in[1] + (size_t)(r_ - TP) * DM; \
        _Pragma("unroll") for (int j = 0; j < 8; ++j) { \
            if (first || xin) XF[j] = *(const f32x4*)(xs_ + 4 * lane + 256 * j); else XH[j] = *(const u32x2*)(X16 + (size_t)r_ * DM + 4 * lane + 256 * j); \
            if (!first) MH[j] = *(const u32x2*)(MIXB + (size_t)r_ * DM + 4 * lane + 256 * j); } } while (0)
#define NORM_COPYRAW(XFd, XHd, MHd, XFs, XHs, MHs) do { _Pragma("unroll") for (int j = 0; j < 8; ++j) { if (first || xin) XFd[j] = XFs[j]; else XHd[j] = XHs[j]; if (!first) MHd[j] = MHs[j]; } } while (0)
    f32x4 xa[8], ma[8];
    f32x4 xfB[8], xfC[8]; u32x2 xhB[8], xhC[8], mhB[8], mhC[8];
    int r = gw;
    if (r < nrows) NORM_LOADRAW(xfB, xhB, mhB, r);
    if (r + NGW < nrows) NORM_LOADRAW(xfC, xhC, mhC, r + NGW); else NORM_COPYRAW(xfC, xhC, mhC, xfB, xhB, mhB);
    for (; r < nrows; r += NGW) {
#pragma unroll
        for (int j = 0; j < 8; ++j) {
            if (first || xin) xa[j] = xfB[j]; else xa[j] = (f32x4){bflo(xhB[j].x), bfhi(xhB[j].x), bflo(xhB[j].y), bfhi(xhB[j].y)};
            if (first) ma[j] = xa[j]; else ma[j] = (f32x4){bflo(mhB[j].x), bfhi(mhB[j].x), bflo(mhB[j].y), bfhi(mhB[j].y)}; }
        NORM_COPYRAW(xfB, xhB, mhB, xfC, xhC, mhC);
        if (r + 2 * NGW < nrows) NORM_LOADRAW(xfC, xhC, mhC, r + 2 * NGW);
        const int seq = r < TP ? (r >> 11) : 4 + ((r - TP) >> 3);
        if (!first) {
            float ss = 0.f;
#pragma unroll
            for (int j = 0; j < 8; ++j) ss += ma[j].x * ma[j].x + ma[j].y * ma[j].y + ma[j].z * ma[j].z + ma[j].w * ma[j].w;
            const float rinv = rsqrtf(wave_sum(ss) * (1.f / DM) + EPSN);
            const float* gt = MOD + (size_t)(l_post * 36 + seq) * 12288 + gate_j * DM;
#pragma unroll
            for (int j = 0; j < 8; ++j) { const f32x4 g = *(const f32x4*)(gpo + 4 * lane + 256 * j), ga = *(const f32x4*)(gt + 4 * lane + 256 * j);
                xa[j] = xa[j] + ga * gscale * (ma[j] * rinv * g);
                if (last) *(f32x4*)(X + (size_t)r * DM + 4 * lane + 256 * j) = xa[j];
                else { u32x2 xw; xw.x = pk2(xa[j].x, xa[j].y); xw.y = pk2(xa[j].z, xa[j].w); *(u32x2*)(X16 + (size_t)r * DM + 4 * lane + 256 * j) = xw; } }
        }
        if (!last) {
            float ss = 0.f;
#pragma unroll
            for (int j = 0; j < 8; ++j) ss += xa[j].x * xa[j].x + xa[j].y * xa[j].y + xa[j].z * xa[j].z + xa[j].w * xa[j].w;
            const float rinv = rsqrtf(wave_sum(ss) * (1.f / DM) + EPSN);
            const float* mbp = MOD + (size_t)(l_pre * 36 + seq) * 12288;
#pragma unroll
            for (int j = 0; j < 8; ++j) { const f32x4 g = *(const f32x4*)(gpr + 4 * lane + 256 * j), sc = *(const f32x4*)(mbp + sc_j * DM + 4 * lane + 256 * j), sh = *(const f32x4*)(mbp + sh_j * DM + 4 * lane + 256 * j);
                const f32x4 h = xa[j] * rinv * g * (sc + 1.f) + sh;
                u32x2 w; w.x = pk2(h.x, h.y); w.y = pk2(h.z, h.w);
                *(u32x2*)(H + (size_t)r * DM + 4 * lane + 256 * j) = w; }
        }
    }
#undef NORM_LOADRAW
#undef NORM_COPYRAW
    if (first) return;
    LAS float* red = (LAS float*)lds;
    for (int rs = blockIdx.x; rs < TS; rs += G) {
        const int rr = TP + rs, seq = 4 + (rs >> 3), col = 256 * wave + 4 * lane;
        const float* pp = (const float*)(P.ws + WS_PART) + (size_t)rs * DM + col;
        f32x4 mv = (f32x4){0.f, 0.f, 0.f, 0.f};
#pragma unroll 8
        for (int ks = 0; ks < nsplit; ++ks) mv = mv + *(const f32x4*)(pp + (size_t)ks * 256 * DM);
        f32x4 xv;
        if (xin) xv = *(const f32x4*)(P.in[1] + (size_t)rs * DM + col); else { const u32x2 xw = *(const u32x2*)(X16 + (size_t)rr * DM + col); xv = (f32x4){bflo(xw.x), bfhi(xw.x), bflo(xw.y), bfhi(xw.y)}; }
        const float s1 = wave_sum(mv.x * mv.x + mv.y * mv.y + mv.z * mv.z + mv.w * mv.w);
        if (lane == 0) red[wave] = s1;
        __syncthreads();
        float tot = 0.f;
#pragma unroll
        for (int w = 0; w < 8; ++w) tot += red[w];
        const float rinv = rsqrtf(tot * (1.f / DM) + EPSN);
        const f32x4 g = *(const f32x4*)(gpo + col), ga = *(const f32x4*)(MOD + (size_t)(l_post * 36 + seq) * 12288 + gate_j * DM + col);
        xv = xv + ga * gscale * (mv * rinv * g);
        if (last) *(f32x4*)(X + (size_t)rr * DM + col) = xv; else { u32x2 xw; xw.x = pk2(xv.x, xv.y); xw.y = pk2(xv.z, xv.w); *(u32x2*)(X16 + (size_t)rr * DM + col) = xw; }
        if (!last) {
            const float s2 = wave_sum(xv.x * xv.x + xv.y * xv.y + xv.z * xv.z + xv.w * xv.w);
            if (lane == 0) red[8 + wave] = s2;
            __syncthreads();
            float tot2 = 0.f;
#pragma unroll
            for (int w = 0; w < 8; ++w) tot2 += red[8 + w];
            const float rinv2 = rsqrtf(tot2 * (1.f / DM) + EPSN);
            const float* mbp = MOD + (size_t)(l_pre * 36 + seq) * 12288;
            const f32x4 g2 = *(const f32x4*)(gpr + col), sc = *(const f32x4*)(mbp + sc_j * DM + col), sh = *(const f32x4*)(mbp + sh_j * DM + col);
            const f32x4 h = xv * rinv2 * g2 * (sc + 1.f) + sh;
            u32x2 w; w.x = pk2(h.x, h.y); w.y = pk2(h.z, h.w);
            *(u32x2*)(H + (size_t)rr * DM + col) = w;
        }
        __syncthreads();
    }
}

DEV void lru_gate_item(const Params& P, LAS unsigned char* lds, int r0, int nrows  , int kb, int tid, int lane, int wave) {
    LAS bf16_t* XC = (LAS bf16_t*)lds;
    const bf16_t* PROJ = (const bf16_t*)(P.ws + WS_PROJ);
    {
        const int cgp = tid & 31, ch0 = kb * 256 + cgp * 8;
        float w[4][8], bias[8]; ldconvw(P.in[20], P.in[21], 2048, ch0, w, bias);
#pragma unroll 4
        for (int i = 0; i < nrows / 16; ++i) { const int q = tid + NTHREADS * i, row = q >> 5, r = r0 + row; int tl; const float* hist = nullptr;
            if (r < TP) tl = r & 2047; else { const int rs = r - TP; tl = rs & 7; hist = P.in[4] + (size_t)(rs >> 3) * 3 * 2048 + ch0; }
            float o[8]; conv8(PROJ, r, tl, PC_XR + ch0, hist, 2048, w, bias, o);
            *(LAS u32x4*)(XC + row * 264 + cgp * 8) = pack8(o); }
    }
    __syncthreads();
    const int r = lane & 31, h = lane >> 5;
    const int ch = kb * 256 + 32 * wave + r;
    const float ba_ = P.in[23][ch], bx_ = P.in[25][ch], sp = softplusf(-P.in[26][ch]);
    float* Aa = (float*)(P.ws + WS_B); float* Uu = (float*)(P.ws + WS_AU_U);
    const bf16_t* Wa = (const bf16_t*)(P.ws + WS_WLRU) + (size_t)(kb * 256 + 32 * wave + r) * 256 + 8 * h; const bf16_t* Wx = Wa + 8 * 65536;
#pragma nounroll
    for (int mh = 0; mh < nrows / 64; ++mh) {
        f32x16 aa[2], ax[2];
#pragma unroll
        for (int m = 0; m < 2; ++m) { aa[m] = zero16(); ax[m] = zero16(); }
        bf16x8 bA[4], bX[4], nA[4], nX[4];
#pragma unroll
        for (int j = 0; j < 4; ++j) { bA[j] = *(const bf16x8*)(Wa + 16 * j); bX[j] = *(const bf16x8*)(Wx + 16 * j); }
#pragma unroll
        for (int kb4 = 0; kb4 < 4; ++kb4) {
            if (kb4 < 3) {
#pragma unroll
                for (int j = 0; j < 4; ++j) { nA[j] = *(const bf16x8*)(Wa + 64 * (kb4 + 1) + 16 * j); nX[j] = *(const bf16x8*)(Wx + 64 * (kb4 + 1) + 16 * j); } }
#pragma unroll
            for (int j = 0; j < 4; ++j)
#pragma unroll
                for (int m = 0; m < 2; ++m) { const bf16x8 a = *(const LAS bf16x8*)(XC + (64 * mh + 32 * m + r) * 264 + 64 * kb4 + 16 * j + 8 * h);
                    aa[m] = __builtin_amdgcn_mfma_f32_32x32x16_bf16(a, bA[j], aa[m], 0, 0, 0); ax[m] = __builtin_amdgcn_mfma_f32_32x32x16_bf16(a, bX[j], ax[m], 0, 0, 0); }
            if (kb4 < 3) {
#pragma unroll
                for (int j = 0; j < 4; ++j) { bA[j] = nA[j]; bX[j] = nX[j]; } }
        }
#pragma unroll
        for (int m = 0; m < 2; ++m)
#pragma unroll
            for (int reg = 0; reg < 16; ++reg) { const int t = 64 * mh + 32 * m + rowmap(reg, h);
                const float xb = bf2f(XC[t * 264 + 32 * wave + r]);
                const float gr = sigm(aa[m][reg] + ba_), gi = sigm(ax[m][reg] + bx_);
                const float la = -8.0f * gr * sp; const float a = __expf(la); const float mult = sqrtf(fmaxf(-expm1f(2.0f * la), 0.f));
                Aa[(size_t)(r0 + t) * 2048 + ch] = a; Uu[(size_t)(r0 + t) * 2048 + ch] = mult * gi * xb; }
    }
    __syncthreads();
}
DEV void ssd_dt_acs(const Params& P, LAS float* acs, LAS float* dts, LAS float* tmp, int R0, int g, int tid) {
    const int hh = tid >> 7, s = tid & 127, hd = 4 * g + hh;
    const float* DT = (const float*)(P.ws + WS_DT);
    const float dtv = softplusf(DT[(size_t)(R0 + s) * 32 + hd] + P.in[16][hd]);
    const float a = -__expf(P.in[17][hd]);
    tmp[tid] = dtv * a; dts[tid] = dtv;
    __syncthreads();
    float c = 0.f; for (int i = 0; i <= s; ++i) c += tmp[hh * 128 + i];
    acs[tid] = c;
    __syncthreads();
}
DEV void ssd_state_item(const Params& P, LAS unsigned char* lds, int it, int tid, int lane, int wave) {
    const int g = it & 7, c = (it >> 3) & 15, b = it >> 7; const int R0 = b * 2048 + c * 128;
    LAS bf16_t* BT = (LAS bf16_t*)lds;
    LAS bf16_t* XWT = (LAS bf16_t*)(lds + 34816);
    LAS float* acs = (LAS float*)(lds + 52224); LAS float* dts = acs + 512; LAS float* tmp = dts + 512;
    const bf16_t* PROJ = (const bf16_t*)(P.ws + WS_PROJ);
    ssd_dt_acs(P, acs, dts, tmp, R0, g, tid);
    {
        const int cgb = tid & 15, cidx = 2048 + g * 128 + cgb * 8;
        float w[4][8], bias[8]; ldconvw(P.in[14], P.in[15], 4096, cidx, w, bias);
#pragma unroll 4
        for (int i = 0; i < 4; ++i) { const int q = tid + NTHREADS * i, s = q >> 4; float o[8];
            conv8(PROJ, R0 + s, c * 128 + s, PC_XBC + cidx, nullptr, 4096, w, bias, o);
#pragma unroll
            for (int e = 0; e < 8; ++e) BT[(cgb * 8 + e) * 136 + s] = (bf16_t)f2bf(siluf(o[e])); }
    }
    float* CS = (float*)(P.ws + WS_CS); float* CDEC = (float*)(P.ws + WS_CDEC);
    for (int hh = 0; hh < 4; ++hh) {
        const int hd = 4 * g + hh;
        {
            const int cgp = tid & 7, cidx = hd * 64 + cgp * 8;
            float w[4][8], bias[8]; ldconvw(P.in[14], P.in[15], 4096, cidx, w, bias);
            const float alast = acs[hh * 128 + 127];
#pragma unroll 2
            for (int i = 0; i < 2; ++i) { const int q = tid + NTHREADS * i, s = q >> 3; float o[8];
                conv8(PROJ, R0 + s, c * 128 + s, PC_XBC + cidx, nullptr, 4096, w, bias, o);
                const float sc = dts[hh * 128 + s] * __expf(alast - acs[hh * 128 + s]);
#pragma unroll
                for (int e = 0; e < 8; ++e) XWT[(cgp * 8 + e) * 136 + s] = (bf16_t)f2bf(siluf(o[e]) * sc); }
        }
        __syncthreads();
        const int pt = wave >> 2, nt = wave & 3;
        f32x16 acc = zero16();
        mma_tile(acc, XWT + 32 * pt * 136, 136, BT + 32 * nt * 136, 136, 128, lane);
        float* dst = CS + ((size_t)((b * 16 + c) * 32 + hd)) * 8192;
#pragma unroll
        for (int reg = 0; reg < 16; ++reg) dst[(32 * pt + rowmap(reg, lane >> 5)) * 128 + 32 * nt + (lane & 31)] = acc[reg];
        if (tid == 0) CDEC[(b * 16 + c) * 32 + hd] = __expf(acs[hh * 128 + 127]);
        __syncthreads();
    }
}
DEV void phase3(const Params& P, LAS unsigned char* lds, int tid, int lane, int wave) {
    const int G = gridDim.x, bid = blockIdx.x;
    REP(14) { for (int it = bid; it < 512; it += G) lru_gate_item(P, lds, (it >> 3) * 128, 128, it & 7, tid, lane, wave);
              for (int it = bid; it < 32; it += G) lru_gate_item(P, lds, TP + (it >> 3) * 64, 64, it & 7, tid, lane, wave); }
    REP(15) for (int it = bid; it < 512; it += G) ssd_state_item(P, lds, it, tid, lane, wave);
    const bf16_t* PROJ = (const bf16_t*)(P.ws + WS_PROJ);
    const int gt = bid * NTHREADS + tid, NGT = G * NTHREADS;
    for (int q = gt; q < 49152 + 24576 + 393216 + 196608; q += NGT) {
        int r = q;
        if (r < 49152) { const int b = r / 12288, j = (r / 4096) % 3, cc = r % 4096; P.out[O_PSC + r] = bf2f(PROJ[(size_t)(b * 2048 + 2045 + j) * NPROJ + PC_XBC + cc]); continue; } r -= 49152;
        if (r < 24576) { const int b = r / 6144, j = (r / 2048) % 3, cc = r % 2048; P.out[O_PLC + r] = bf2f(PROJ[(size_t)(b * 2048 + 2045 + j) * NPROJ + PC_XR + cc]); continue; } r -= 24576;
        if (r < 393216) { const int b = r / 12288, j = (r / 4096) % 3, cc = r % 4096; P.out[O_SSC + r] = bf2f(PROJ[(size_t)(TP + b * 8 + 5 + j) * NPROJ + PC_XBC + cc]); continue; } r -= 393216;
        { const int b = r / 6144, j = (r / 2048) % 3, cc = r % 2048; P.out[O_SLC + r] = bf2f(PROJ[(size_t)(TP + b * 8 + 5 + j) * NPROJ + PC_XR + cc]); }
    }
}

DEV void lru_scan_item(const Params& P, LAS unsigned char* lds, int it, int tid) {
    const int b = it >> 6, cgp = it & 63, cl = tid & 31, ch = cgp * 32 + cl, seg = tid >> 5;
    const size_t rbase = (size_t)b * 2048 + seg * 128;
    const float* Aa = (const float*)(P.ws + WS_B) + rbase * 2048 + ch; const float* Uu = (const float*)(P.ws + WS_AU_U) + rbase * 2048 + ch;
    LAS float* sA = (LAS float*)lds; LAS float* sH = sA + 512;
    float p1 = 1.f, h1 = 0.f, p2 = 1.f, h2 = 0.f;
#pragma unroll 16
    for (int t = 0; t < 64; ++t) { const float a1 = Aa[(size_t)t * 2048], u1 = Uu[(size_t)t * 2048], a2 = Aa[(size_t)(64 + t) * 2048], u2 = Uu[(size_t)(64 + t) * 2048];
        h1 = a1 * h1 + u1; p1 *= a1; h2 = a2 * h2 + u2; p2 *= a2; }
    sA[seg * 32 + cl] = p1 * p2; sH[seg * 32 + cl] = p2 * h1 + h2;
    __syncthreads();
    float hin = 0.f;
    for (int s = 0; s < seg; ++s) hin = sA[s * 32 + cl] * hin + sH[s * 32 + cl];
    const bf16_t* GATE = (const bf16_t*)(P.ws + WS_PROJ) + rbase * NPROJ + PC_GATE + ch;
    bf16_t* Y = (bf16_t*)(P.ws + WS_YMIX) + rbase * 4096 + 2048 + ch;
    float g1 = hin, g2 = p1 * hin + h1;
#pragma unroll 16
    for (int t = 0; t < 64; ++t) { const float a1 = Aa[(size_t)t * 2048], u1 = Uu[(size_t)t * 2048], a2 = Aa[(size_t)(64 + t) * 2048], u2 = Uu[(size_t)(64 + t) * 2048];
        const float z1 = bf2f(GATE[(size_t)t * NPROJ]), z2 = bf2f(GATE[(size_t)(64 + t) * NPROJ]);
        g1 = a1 * g1 + u1; g2 = a2 * g2 + u2;
        Y[(size_t)t * 4096] = (bf16_t)f2bf(g1 * geluf(z1)); Y[(size_t)(64 + t) * 4096] = (bf16_t)f2bf(g2 * geluf(z2)); }
    const float h = g2;
    if (seg == 15) P.out[O_PL + b * 2048 + ch] = h;
    __syncthreads();
}
DEV void phase4(const Params& P, LAS unsigned char* lds, int tid, int lane, int wave) {
    const int G = gridDim.x, bid = blockIdx.x;
    REP(22) for (int it = bid; it < 256; it += G) lru_scan_item(P, lds, it, tid);
    const int gt = bid * NTHREADS + tid, NGT = G * NTHREADS;
    for (int q = gt; q < 65536; q += NGT) { const int b = q >> 11, ch = q & 2047; float h = P.in[5][q];
        const size_t r0 = (size_t)TP + b * 8;
#pragma unroll
        for (int t = 0; t < 8; ++t) { const float a = ((const float*)(P.ws + WS_B))[(r0 + t) * 2048 + ch], u = ((const float*)(P.ws + WS_AU_U))[(r0 + t) * 2048 + ch]; h = a * h + u;
            ((bf16_t*)(P.ws + WS_YMIX))[(r0 + t) * 4096 + 2048 + ch] = (bf16_t)f2bf(h * geluf(bf2f(((const bf16_t*)(P.ws + WS_PROJ))[(r0 + t) * NPROJ + PC_GATE + ch]))); }
        P.out[O_SL + q] = h; }
    const f32x4* CS4 = (const f32x4*)(P.ws + WS_CS); const float* CDEC = (const float*)(P.ws + WS_CDEC); u32x2* HIN = (u32x2*)(P.ws + WS_HIN);
    REP(23) for (int q = gt; q < 262144; q += NGT) { const int b = q >> 16, rem = q & 65535, hd = rem >> 11, e4 = rem & 2047;
        f32x4 h = (f32x4){0.f, 0.f, 0.f, 0.f};
        f32x4 csv[16]; float decv[16];
#pragma unroll
        for (int c = 0; c < 16; ++c) { const int idx = (b * 16 + c) * 32 + hd; decv[c] = CDEC[idx]; csv[c] = CS4[(size_t)idx * 2048 + e4]; }
#pragma unroll
        for (int c = 0; c < 16; ++c) { const int idx = (b * 16 + c) * 32 + hd;
            u32x2 w; w.x = pk2(h.x, h.y); w.y = pk2(h.z, h.w); HIN[(size_t)idx * 2048 + e4] = w;
            h = h * decv[c] + csv[c]; }
        *(f32x4*)(P.out + O_PSSM + (size_t)(b * 32 + hd) * 8192 + e4 * 4) = h; }
}

DEV void ssd_out_item(const Params& P, LAS unsigned char* lds, int it, int tid, int lane, int wave) {
    const int g = it & 7, c = (it >> 3) & 15, b = it >> 7; const int R0 = b * 2048 + c * 128;
    LAS bf16_t* Cs = (LAS bf16_t*)lds; LAS bf16_t* Bs = (LAS bf16_t*)(lds + 34816); LAS bf16_t* Ms = (LAS bf16_t*)(lds + 69632);
    LAS bf16_t* XT = (LAS bf16_t*)(lds + 104448); LAS bf16_t* Hs = (LAS bf16_t*)(lds + 121856);
    LAS float* acs = (LAS float*)(lds + 139264); LAS float* dts = acs + 512; LAS float* ssq = dts + 512; LAS float* tmp = (LAS float*)Ms;
    const bf16_t* PROJ = (const bf16_t*)(P.ws + WS_PROJ);
    ssd_dt_acs(P, acs, dts, tmp, R0, g, tid);
    {
        const int cgb = tid & 15;
#pragma unroll
        for (int mat = 0; mat < 2; ++mat) { const int cidx = 2048 + mat * 1024 + g * 128 + cgb * 8;
            float w[4][8], bias[8]; ldconvw(P.in[14], P.in[15], 4096, cidx, w, bias);
            LAS bf16_t* dstm = mat ? Cs : Bs;
#pragma unroll 4
            for (int i = 0; i < 4; ++i) { const int q = tid + NTHREADS * i, s = q >> 4; float o[8];
                conv8(PROJ, R0 + s, c * 128 + s, PC_XBC + cidx, nullptr, 4096, w, bias, o);
#pragma unroll
                for (int e = 0; e < 8; ++e) o[e] = siluf(o[e]);
                *(LAS u32x4*)(dstm + s * 136 + cgb * 8) = pack8(o); } }
    }
    __syncthreads();
    const int tt = wave >> 1;
    f32x16 cb[2];
#pragma unroll
    for (int j = 0; j < 2; ++j) { const int st = 2 * (wave & 1) + j; cb[j] = zero16();
        if (st <= tt) mma_tile(cb[j], Cs + 32 * tt * 136, 136, Bs + 32 * st * 136, 136, 128, lane); }
    const int pt = wave & 1;
    f32x16 yv[4];
#pragma unroll
    for (int k = 0; k < 4; ++k) yv[k] = zero16();
    for (int hh = 0; hh < 4; ++hh) {
        const int hd = 4 * g + hh;
        int lane_l = lane, tid_l = tid; asm volatile("" : "+v"(lane_l), "+v"(tid_l));
        const int r = lane_l & 31, h = lane_l >> 5;
        const u32x4* hsrc = (const u32x4*)((const bf16_t*)(P.ws + WS_HIN) + ((size_t)((b * 16 + c) * 32 + hd)) * 8192);
        const u32x4 hpre0 = hsrc[tid_l], hpre1 = hsrc[tid_l + NTHREADS];
        unsigned short zv[16];
        { const bf16_t* zp = PROJ + (size_t)(R0 + 32 * tt + 4 * h) * NPROJ + hd * 64 + 32 * pt + r;
#pragma unroll
          for (int reg = 0; reg < 16; ++reg) zv[reg] = zp[(size_t)((reg & 3) + 8 * (reg >> 2)) * NPROJ]; }
        __builtin_amdgcn_sched_barrier(0);
#pragma unroll
        for (int j = 0; j < 2; ++j) { const int st = 2 * (wave & 1) + j; const int s = 32 * st + r; const float as = acs[hh * 128 + s], ds = dts[hh * 128 + s];
#pragma unroll
            for (int reg = 0; reg < 16; ++reg) { const int t = 32 * tt + rowmap(reg, h);
                const float v = (s <= t) ? cb[j][reg] * __expf(acs[hh * 128 + t] - as) * ds : 0.f;
                Ms[t * 136 + s] = (bf16_t)f2bf(v); } }
        __builtin_amdgcn_sched_barrier(0);
        {
            const int cgp = tid_l & 7, cidx = hd * 64 + cgp * 8;
            float w[4][8], bias[8]; ldconvw(P.in[14], P.in[15], 4096, cidx, w, bias);
#pragma unroll 2
            for (int i = 0; i < 2; ++i) { const int q = tid_l + NTHREADS * i, s = q >> 3; float o[8];
                conv8(PROJ, R0 + s, c * 128 + s, PC_XBC + cidx, nullptr, 4096, w, bias, o);
#pragma unroll
                for (int e = 0; e < 8; ++e) XT[(cgp * 8 + e) * 136 + s] = (bf16_t)f2bf(siluf(o[e])); }
            { const int q0 = tid_l, q1 = tid_l + NTHREADS; *(LAS u32x4*)(Hs + (q0 >> 4) * 136 + (q0 & 15) * 8) = hpre0; *(LAS u32x4*)(Hs + (q1 >> 4) * 136 + (q1 & 15) * 8) = hpre1; }
        }
        __builtin_amdgcn_sched_barrier(0);
        __syncthreads();
        __builtin_amdgcn_sched_barrier(0);
        f32x16 ad = zero16(), ao = zero16();
        mma_tile(ad, Ms + 32 * tt * 136, 136, XT + 32 * pt * 136, 136, 32 * (tt + 1), lane_l);
        mma_tile(ao, Cs + 32 * tt * 136, 136, Hs + 32 * pt * 136, 136, 128, lane_l);
        const float dsk = P.in[18][hd];
        const int p = 32 * pt + r;
#pragma unroll
        for (int reg = 0; reg < 16; ++reg) { const int t = 32 * tt + rowmap(reg, h);
            float y = ad[reg] + __expf(acs[hh * 128 + t]) * ao[reg] + dsk * bf2f(XT[p * 136 + t]);
            const float z = bf2f(zv[reg]);
            ad[reg] = y * siluf(z); }
#pragma unroll
        for (int k = 0; k < 4; ++k) yv[k] = (hh == k) ? ad : yv[k];
        __syncthreads();
    }
    int lane_m = lane; asm volatile("" : "+v"(lane_m));
    const int r = lane_m & 31, h = lane_m >> 5;
#pragma unroll
    for (int reg = 0; reg < 16; ++reg) { float s = 0.f;
#pragma unroll
        for (int hh = 0; hh < 4; ++hh) s += yv[hh][reg] * yv[hh][reg];
#pragma unroll
        for (int o = 1; o < 32; o <<= 1) s += __shfl_xor(s, o);
        if (r == 0) ssq[pt * 128 + 32 * tt + rowmap(reg, h)] = s; }
    __syncthreads();
    bf16_t* Y = (bf16_t*)(P.ws + WS_YMIX);
#pragma unroll
    for (int reg = 0; reg < 16; ++reg) { const int t = 32 * tt + rowmap(reg, h);
        const float rinv = rsqrtf((ssq[t] + ssq[128 + t]) * (1.f / 256.f) + EPSN);
#pragma unroll
        for (int hh = 0; hh < 4; ++hh) { const int ch = (4 * g + hh) * 64 + 32 * pt + r;
            Y[(size_t)(R0 + t) * 4096 + ch] = (bf16_t)f2bf(yv[hh][reg] * rinv * P.in[19][ch]); } }
    __syncthreads();
}
DEV void ssd_sample_item(const Params& P, LAS unsigned char* lds, int it, int tid, int lane, int wave) {
    const int b = it >> 3, g = it & 7; const int R0 = TP + b * 8;
    LAS float* xs = (LAS float*)lds;
    LAS float* Bv = xs + 2048;
    LAS float* Cv = Bv + 1024;
    LAS float* dtv = Cv + 1024;
    LAS float* yv = dtv + 32;
    const bf16_t* PROJ = (const bf16_t*)(P.ws + WS_PROJ);
    {
        const int cc = tid; const int cidx = cc < 256 ? g * 256 + cc : (cc < 384 ? 2048 + g * 128 + (cc - 256) : 3072 + g * 128 + (cc - 384));
        const float w0 = P.in[14][cidx], w1 = P.in[14][4096 + cidx], w2 = P.in[14][8192 + cidx], w3 = P.in[14][12288 + cidx], bias = P.in[15][cidx];
        const float* hist = P.in[2] + (size_t)b * 3 * 4096 + cidx;
        float x0 = hist[0], x1 = hist[4096], x2 = hist[8192];
        LAS float* dst = cc < 256 ? xs + cc : (cc < 384 ? Bv + (cc - 256) : Cv + (cc - 384)); const int dstride = cc < 256 ? 256 : 128;
#pragma unroll
        for (int t = 0; t < 8; ++t) { const float x3 = bf2f(PROJ[(size_t)(R0 + t) * NPROJ + PC_XBC + cidx]);
            dst[t * dstride] = siluf(bias + w0 * x0 + w1 * x1 + w2 * x2 + w3 * x3); x0 = x1; x1 = x2; x2 = x3; }
        if (tid < 32) { const int hh = tid >> 3, t = tid & 7, hd = 4 * g + hh; dtv[tid] = softplusf(((const float*)(P.ws + WS_DT))[(size_t)(R0 + t) * 32 + hd] + P.in[16][hd]); }
    }
    __syncthreads();
    const int p = tid >> 3, n0 = (tid & 7) * 16;
    for (int hh = 0; hh < 4; ++hh) {
        const int hd = 4 * g + hh; const float a = -__expf(P.in[17][hd]), dsk = P.in[18][hd];
        const size_t sidx = ((size_t)(b * 32 + hd) * 64 + p) * 128 + n0;
        float hst[16];
#pragma unroll
        for (int i = 0; i < 4; ++i) { const f32x4 v = *(const f32x4*)(P.in[3] + sidx + 4 * i); hst[4 * i] = v.x; hst[4 * i + 1] = v.y; hst[4 * i + 2] = v.z; hst[4 * i + 3] = v.w; }
#pragma unroll
        for (int t = 0; t < 8; ++t) { const float dt = dtv[hh * 8 + t], dec = __expf(dt * a), xv = xs[t * 256 + hh * 64 + p], xdt = xv * dt; float yp = 0.f;
#pragma unroll
            for (int i = 0; i < 16; ++i) { hst[i] = hst[i] * dec + xdt * Bv[t * 128 + n0 + i]; yp += Cv[t * 128 + n0 + i] * hst[i]; }
            yp += __shfl_xor(yp, 1); yp += __shfl_xor(yp, 2); yp += __shfl_xor(yp, 4);
            if ((tid & 7) == 0) yv[t * 256 + hh * 64 + p] = yp + dsk * xv; }
#pragma unroll
        for (int i = 0; i < 4; ++i) *(f32x4*)(P.out + O_SSSM + sidx + 4 * i) = (f32x4){hst[4 * i], hst[4 * i + 1], hst[4 * i + 2], hst[4 * i + 3]};
    }
    __syncthreads();
    {
        const int t = wave; float v[4]; float ss = 0.f;
#pragma unroll
        for (int i = 0; i < 4; ++i) { const int ch = lane + 64 * i; const float z = bf2f(PROJ[(size_t)(R0 + t) * NPROJ + g * 256 + ch]); v[i] = yv[t * 256 + ch] * siluf(z); ss += v[i] * v[i]; }
        const float rinv = rsqrtf(wave_sum(ss) * (1.f / 256.f) + EPSN);
#pragma unroll
        for (int i = 0; i < 4; ++i) { const int ch = g * 256 + lane + 64 * i; ((bf16_t*)(P.ws + WS_YMIX))[(size_t)(R0 + t) * 4096 + ch] = (bf16_t)f2bf(v[i] * rinv * P.in[19][ch]); }
    }
    __syncthreads();
}
DEV void phase5(const Params& P, LAS unsigned char* lds, int tid, int lane, int wave) {
    const int G = gridDim.x, bid = blockIdx.x;
    const int gt = bid * NTHREADS + tid, NGT = G * NTHREADS;
#if !defined(ONLY) || ONLY == 5
    for (int it = bid; it < 512; it += G) ssd_out_item(P, lds, it, tid, lane, wave);
#endif
#if !defined(ONLY) || ONLY == 11
    for (int it = bid; it < 256; it += G) ssd_sample_item(P, lds, it, tid, lane, wave);
#endif
}

DEV void rope_stage(const bf16_t* src, const float* ropep  , int c, float scale, LAS bf16_t* dst, float* fout, bool zero) {
    float lo[8], hi[8], o1[8], o2[8];
    if (zero) {
#pragma unroll
        for (int e = 0; e < 8; ++e) { o1[e] = 0.f; o2[e] = 0.f; }
    } else {
        ld8(src + 8 * c, lo); ld8(src + 32 + 8 * c, hi);
        float csA[8], csB[8]; ldf8(ropep + 16 * c, csA); ldf8(ropep + 16 * c + 8, csB);
#pragma unroll
        for (int e = 0; e < 8; ++e) { const float co = e < 4 ? csA[2 * e] : csB[2 * e - 8], si = e < 4 ? csA[2 * e + 1] : csB[2 * e - 7]; o1[e] = (lo[e] * co - hi[e] * si) * scale; o2[e] = (hi[e] * co + lo[e] * si) * scale; }
    }
    *(LAS u32x4*)(dst + 8 * c) = pack8(o1); *(LAS u32x4*)(dst + 32 + 8 * c) = pack8(o2);
    if (fout) {
#pragma unroll
        for (int e = 0; e < 8; ++e) { fout[8 * c + e] = o1[e]; fout[32 + 8 * c + e] = o2[e]; } }
}
DEV void attn_prompt_item(const Params& P, LAS unsigned char* lds, int it, int tid, int lane, int wave) {
    const int hp = it & 1, qb = (it >> 1) & 15, kvh = (it >> 5) & 7, b = it >> 8;
    LAS bf16_t* Ks = (LAS bf16_t*)lds;
    LAS bf16_t* VT = (LAS bf16_t*)(lds + 36864);
    LAS bf16_t* Qs = (LAS bf16_t*)(lds + 70656);
    const bf16_t* QKV = (const bf16_t*)(P.ws + WS_QKV); const float* ROPE = (const float*)(P.ws + WS_ROPE);
    const bool wr_state = (qb == 15 && hp == 0);
    for (int i = 0; i < 2; ++i) { const int q = tid + NTHREADS * i, jj = q >> 2, c = q & 3; const int pos = qb * 128 - 128 + jj; const bool zero = pos < 0;
        const int posc = zero ? 0 : pos;
        float* fo = (wr_state && jj >= 128) ? P.out + O_PK + ((size_t)(b * 128 + (jj - 128)) * 8 + kvh) * 64 : nullptr;
        rope_stage(QKV + (size_t)(b * 2048 + posc) * NQKV + 2048 + kvh * 64, ROPE + (size_t)posc * 64, c, 1.0f, Ks + jj * 72, fo, zero); }
    for (int i = 0; i < 4; ++i) { const int q = tid + NTHREADS * i, jj = q >> 3, c = q & 7; const int pos = qb * 128 - 128 + jj; float v[8];
        if (pos < 0) {
#pragma unroll
            for (int e = 0; e < 8; ++e) v[e] = 0.f;
        } else ld8(QKV + (size_t)(b * 2048 + pos) * NQKV + 2560 + kvh * 64 + 8 * c, v);
#pragma unroll
        for (int e = 0; e < 8; ++e) VT[(8 * c + e) * 264 + jj] = (bf16_t)f2bf(v[e]);
        if (wr_state && jj >= 128) { float* fo = P.out + O_PV + ((size_t)(b * 128 + (jj - 128)) * 8 + kvh) * 64 + 8 * c;
#pragma unroll
            for (int e = 0; e < 8; ++e) fo[e] = v[e]; } }
    for (int i = 0; i < 2; ++i) { const int q = tid + NTHREADS * i, qr = q >> 2, c = q & 3; const int hsel = qr >> 7, qi = qr & 127, head = kvh * 4 + hp * 2 + hsel, pos = qb * 128 + qi;
        rope_stage(QKV + (size_t)(b * 2048 + pos) * NQKV + head * 64, ROPE + (size_t)pos * 64, c, 0.125f, Qs + qr * 72, nullptr, false); }
    __syncthreads();
    const int r = lane & 31, h = lane >> 5;
    const int hsel = wave >> 2, q0 = 32 * (wave & 3), head = kvh * 4 + hp * 2 + hsel;
    f32x16 st[5];
#pragma unroll
    for (int kt = 0; kt < 5; ++kt) { st[kt] = zero16(); mma_tile(st[kt], Ks + (q0 + 32 * kt) * 72, 72, Qs + (hsel * 128 + q0) * 72, 72, 64, lane); }
    const float sink = P.in[30][head];
    float m = sink;
#pragma unroll
    for (int kt = 0; kt < 5; ++kt)
#pragma unroll
        for (int reg = 0; reg < 16; ++reg) { const int dk = 32 * kt + rowmap(reg, h); const bool valid = (dk > r) && (dk <= r + 128);
            st[kt][reg] = valid ? st[kt][reg] : -1e30f; m = fmaxf(m, st[kt][reg]); }
    m = fmaxf(m, __shfl_xor(m, 32));
    float l = 0.f;
#pragma unroll
    for (int kt = 0; kt < 5; ++kt)
#pragma unroll
        for (int reg = 0; reg < 16; ++reg) { const float p = __expf(st[kt][reg] - m); st[kt][reg] = p; l += p; }
    l += __shfl_xor(l, 32);
    l += __expf(sink - m);
    const float linv = 1.f / l;
    bf16_t* O = (bf16_t*)(P.ws + WS_ATTO) + (size_t)(b * 2048 + qb * 128 + q0 + r) * 2048 + head * 64;
#pragma unroll
    for (int dt = 0; dt < 2; ++dt) {
        f32x16 ao = zero16();
#pragma unroll
        for (int kt = 0; kt < 5; ++kt)
#pragma unroll
            for (int s = 0; s < 2; ++s) {
                u32x4 pb; pb.x = pk2(st[kt][8 * s], st[kt][8 * s + 1]); pb.y = pk2(st[kt][8 * s + 2], st[kt][8 * s + 3]); pb.z = pk2(st[kt][8 * s + 4], st[kt][8 * s + 5]); pb.w = pk2(st[kt][8 * s + 6], st[kt][8 * s + 7]);
                const LAS bf16_t* vp = VT + (32 * dt + r) * 264 + q0 + 32 * kt + 16 * s + 4 * h;
                const u32x2 v0 = *(const LAS u32x2*)vp, v1 = *(const LAS u32x2*)(vp + 8);
                u32x4 va; va.x = v0.x; va.y = v0.y; va.z = v1.x; va.w = v1.y;
                ao = __builtin_amdgcn_mfma_f32_32x32x16_bf16(__builtin_bit_cast(bf16x8, va), __builtin_bit_cast(bf16x8, pb), ao, 0, 0, 0);
            }
#pragma unroll
        for (int gq = 0; gq < 4; ++gq) { u32x2 w; w.x = pk2(ao[4 * gq] * linv, ao[4 * gq + 1] * linv); w.y = pk2(ao[4 * gq + 2] * linv, ao[4 * gq + 3] * linv);
            *(u32x2*)(O + 32 * dt + 8 * gq + 4 * h) = w; }
    }
    __syncthreads();
}
DEV void attn_sample_item(const Params& P, LAS unsigned char* lds, int it, int tid, int lane, int wave) {
    const int b = it >> 3, kvh = it & 7;
    LAS float* Kf = (LAS float*)lds;
    LAS float* Vf = Kf + 136 * 65;
    LAS float* Qf = Vf + 136 * 64;
    LAS float* Sc = Qf + 32 * 65;
    const bf16_t* QKV = (const bf16_t*)(P.ws + WS_QKV); const float* ROPE = (const float*)(P.ws + WS_ROPE);
    for (int q = tid; q < 136 * 32; q += NTHREADS) { const int jj = q >> 5, d = q & 31; float k1, k2, v1, v2;
        if (jj < 128) { const size_t o = ((size_t)(b * 128 + jj) * 8 + kvh) * 64; k1 = P.in[6][o + d]; k2 = P.in[6][o + 32 + d]; v1 = P.in[7][o + d]; v2 = P.in[7][o + 32 + d]; }
        else { const int t = jj - 128; const bf16_t* row = QKV + (size_t)(TP + b * 8 + t) * NQKV; const float a = bf2f(row[2048 + kvh * 64 + d]), c2 = bf2f(row[2048 + kvh * 64 + 32 + d]);
            const float co = ROPE[((size_t)(2048 + t) * 32 + d) * 2], si = ROPE[((size_t)(2048 + t) * 32 + d) * 2 + 1];
            k1 = a * co - c2 * si; k2 = c2 * co + a * si; v1 = bf2f(row[2560 + kvh * 64 + d]); v2 = bf2f(row[2560 + kvh * 64 + 32 + d]); }
        Kf[jj * 65 + d] = k1; Kf[jj * 65 + 32 + d] = k2; Vf[jj * 64 + d] = v1; Vf[jj * 64 + 32 + d] = v2;
        if (jj >= 8) { const size_t o = ((size_t)(b * 128 + (jj - 8)) * 8 + kvh) * 64; P.out[O_SK + o + d] = k1; P.out[O_SK + o + 32 + d] = k2; P.out[O_SV + o + d] = v1; P.out[O_SV + o + 32 + d] = v2; } }
    for (int q = tid; q < 32 * 32; q += NTHREADS) { const int qr = q >> 5, d = q & 31, hq = qr >> 3, t = qr & 7, head = kvh * 4 + hq; const bf16_t* row = QKV + (size_t)(TP + b * 8 + t) * NQKV + head * 64;
        const float a = bf2f(row[d]), c2 = bf2f(row[32 + d]); const float co = ROPE[((size_t)(2048 + t) * 32 + d) * 2], si = ROPE[((size_t)(2048 + t) * 32 + d) * 2 + 1];
        Qf[qr * 65 + d] = (a * co - c2 * si) * 0.125f; Qf[qr * 65 + 32 + d] = (c2 * co + a * si) * 0.125f; }
    __syncthreads();
    const int qr = tid >> 4, kl = tid & 15, t = qr & 7, head = kvh * 4 + (qr >> 3);
    const float sink = P.in[30][head];
    float m = sink;
    for (int i = 0; i < 9; ++i) { const int jj = kl + 16 * i; if (jj < 136) { float s = 0.f;
#pragma unroll 16
            for (int d = 0; d < 64; ++d) s += Qf[qr * 65 + d] * Kf[jj * 65 + d];
            const bool valid = jj < 128 ? (jj >= t + 1) : ((jj - 128) <= t);
            s = valid ? s : -1e30f; Sc[qr * 136 + jj] = s; m = fmaxf(m, s); } }
    m = fmaxf(m, __shfl_xor(m, 1)); m = fmaxf(m, __shfl_xor(m, 2)); m = fmaxf(m, __shfl_xor(m, 4)); m = fmaxf(m, __shfl_xor(m, 8));
    float l = 0.f;
    for (int i = 0; i < 9; ++i) { const int jj = kl + 16 * i; if (jj < 136) { const float p = __expf(Sc[qr * 136 + jj] - m); Sc[qr * 136 + jj] = p; l += p; } }
    l += __shfl_xor(l, 1); l += __shfl_xor(l, 2); l += __shfl_xor(l, 4); l += __shfl_xor(l, 8);
    l += __expf(sink - m);
    __syncthreads();
    f32x4 o = (f32x4){0.f, 0.f, 0.f, 0.f};
    for (int jj = 0; jj < 136; ++jj) { const float p = Sc[qr * 136 + jj]; const f32x4 v = *(const LAS f32x4*)(Vf + jj * 64 + 4 * kl); o = o + v * p; }
    const float linv = 1.f / l;
    u32x2 w; w.x = pk2(o.x * linv, o.y * linv); w.y = pk2(o.z * linv, o.w * linv);
    *(u32x2*)((bf16_t*)(P.ws + WS_ATTO) + (size_t)(TP + b * 8 + t) * 2048 + head * 64 + 4 * kl) = w;
    __syncthreads();
}

DEV void gemm_to_mix(const Params& P, LAS unsigned char* lds, const bf16_t* A, const bf16_t* Bt, int K) {
    const int G = gridDim.x, bid = blockIdx.x;
    { pg8::Gemm g{A, Bt, K, K, K}; pg8::StaticOrder S; S.init(TP, DM, G, bid); pg8::EpiBf16<3> E{(bf16_t*)(P.ws + WS_MIX), DM, nullptr, nullptr, -1}; pg8::gemm_phase(lds, g, S, E); }
    { pg8::Gemm g{A + (size_t)TP * K, Bt, 256, K, K}; pg8::SplitKOrder S{8, K / 256, 256, G, bid}; pg8::EpiF32 E{(float*)(P.ws + WS_PART), DM, 256}; pg8::gemm_phase(lds, g, S, E); }
}

__global__ void __launch_bounds__(NTHREADS, 2) hybrid_fwd(Params P) {
    extern __shared__ __attribute__((aligned(16))) unsigned char lds_raw[];
    LAS unsigned char* lds = (LAS unsigned char*)lds_raw;
    cg::grid_group grid = cg::this_grid();
    const int tid0 = threadIdx.x;
    const int G = gridDim.x, bid = blockIdx.x;
    unsigned char* ws = P.ws;
    if (tid0 < 16) ((LAS unsigned*)(lds + 147456))[tid0] = 0u;
    __syncthreads();
    const XcdBarrier bar = xcd_barrier_post((unsigned*)(ws + WS_BAR), (volatile LAS unsigned*)(lds + 147456));
    if (G == 0x7ffffff) grid.sync();
#define GSYNC() xcd_barrier(bar)

#define LAUNDER() int tid = tid0; asm volatile("" : "+v"(tid)); const int lane = tid & 63, wave = __builtin_amdgcn_readfirstlane(tid >> 6)
#ifndef ONLY
#define PH(k) true
#else
#define PH(k) ((k) == ONLY)
#endif
    REP(16) { for (int i_ = 0; i_ < ((DBL) == 16 ? 10 : 0); ++i_) GSYNC(); }
    if (PH(0)) REP(0) { LAUNDER(); phase0(P, lds, tid, lane, wave); }
    GSYNC();
    if (PH(1)) REP(1) { LAUNDER(); norm_phase(P, lds, true, false, 0, 0, 0,   0, 0,   0,   1, 0, lane, wave); }
    GSYNC();
    if (PH(2)) REP(2) {
        pg8::Gemm g{(const bf16_t*)(ws + WS_H), (const bf16_t*)(ws + WS_WIN), DM, DM, DM}; pg8::StaticOrder S; S.init(TT, NPROJ, G, bid);
        pg8::EpiBf16<0> E{(bf16_t*)(ws + WS_PROJ), NPROJ, nullptr, (float*)(ws + WS_DT), 40}; pg8::gemm_phase(lds, g, S, E);
        const int nbusy = (33 * 41) % G;
        if (TAILS && bid >= nbusy) { LAUNDER(); const int widx = (bid - nbusy) * 8 + wave, nw = (G - nbusy) * 8;
            if (G <= 192) transpose_range(P, lds, 5152, 7200, widx, 1, nw, lane, wave);
            transpose_range(P, lds, 9760, 13856, widx, 1, nw, lane, wave); }
    }
    GSYNC();
    if (PH(3)) REP(3) { LAUNDER(); phase3(P, lds, tid, lane, wave); }
    GSYNC();
    if (PH(4)) REP(4) { LAUNDER(); phase4(P, lds, tid, lane, wave); }
    GSYNC();
    if (PH(5) || PH(11)) REP(5) { LAUNDER(); phase5(P, lds, tid, lane, wave); }
    GSYNC();
    if (PH(6)) REP(6) gemm_to_mix(P, lds, (const bf16_t*)(ws + WS_YMIX), (const bf16_t*)(ws + WS_WOH), 4096);
    GSYNC();
    for (int layer = 0; layer < 2; ++layer) {
        if (PH(1)) { LAUNDER(); if (layer == 0) norm_phase(P, lds, false, false, 0, 1, 2, 0, 2, 3, 4, 16, lane, wave, 1.f, true); else norm_phase(P, lds, false, false, 1, 1, 2, 1, 2, 3, 4, 8, lane, wave, 1.f, false); }
        if (DBL == 30) { GSYNC(); LAUNDER(); norm_phase(P, lds, false, false, layer, 1, 2, layer, 2, 3, 4, layer == 0 ? 16 : 8, lane, wave, 0.f, false); }
        GSYNC();
        if (PH(7)) REP(7) {
            pg8::Gemm g{(const bf16_t*)(ws + WS_H), (const bf16_t*)(ws + WS_WUP) + (size_t)layer * DFF * DM, DM, DM, DM}; pg8::StaticOrder S; S.init(TT, DFF, G, bid);
            pg8::EpiBf16<1> E{(bf16_t*)(ws + WS_UP), DFF, nullptr, nullptr, -1}; pg8::gemm_phase(lds, g, S, E);
            const int nbusy = (33 * 32) % G;
            if (TAILS && bid >= nbusy) { LAUNDER(); const int widx = (bid - nbusy) * 8 + wave, nw = (G - nbusy) * 8;
                if (layer == 0) { transpose_range(P, lds, 17952, 22048, widx, 1, nw, lane, wave); transpose_range(P, lds, 7200, 9760, widx, 1, nw, lane, wave); }
                else transpose_range(P, lds, 22048, 26144, widx, 1, nw, lane, wave); }
        }
        GSYNC();
        if (PH(6)) REP(12) gemm_to_mix(P, lds, (const bf16_t*)(ws + WS_UP), (const bf16_t*)(ws + WS_WDN) + (size_t)layer * DM * DFF, DFF);
        GSYNC();
        if (layer == 0) {
            if (PH(1)) { LAUNDER(); norm_phase(P, lds, false, false, 0, 3, 5, 1, 0, 0, 1, 32, lane, wave); }
            if (DBL == 30) { GSYNC(); LAUNDER(); norm_phase(P, lds, false, false, 0, 3, 5, 1, 0, 0, 1, 32, lane, wave, 0.f); }
            GSYNC();
            if (PH(8)) REP(8) {
                pg8::Gemm g{(const bf16_t*)(ws + WS_H), (const bf16_t*)(ws + WS_WQKV), DM, DM, DM}; pg8::StaticOrder S; S.init(TT, NQKV, G, bid);
                pg8::EpiBf16<2> E{(bf16_t*)(ws + WS_QKV), NQKV, P.in[29], nullptr, -1}; pg8::gemm_phase(lds, g, S, E);
                const int nbusy = (33 * 12) % G;
                if (TAILS && bid >= nbusy) { LAUNDER(); const int widx = (bid - nbusy) * 8 + wave, nw = (G - nbusy) * 8;
                    transpose_range(P, lds, 13856, 17952, widx, 1, nw, lane, wave); }
            }
            GSYNC();
            if (PH(9)) REP(9) { LAUNDER(); for (int it = bid; it < 1024; it += G) attn_prompt_item(P, lds, it, tid, lane, wave); }
            if (PH(10)) REP(10) { LAUNDER(); for (int it = bid; it < 256; it += G) attn_sample_item(P, lds, it, tid, lane, wave); }
            GSYNC();
            if (PH(6)) REP(13) gemm_to_mix(P, lds, (const bf16_t*)(ws + WS_ATTO), (const bf16_t*)(ws + WS_WOA), DM);
            GSYNC();
        } else {
            if (PH(1)) { LAUNDER(); norm_phase(P, lds, false, true, 1, 3, 5, 0, 0, 0, 0, 32, lane, wave); }
        }
    }
}

extern "C" void kernel_launch(void* const* d_in, const int* in_sizes, int n_in, void* d_out, int out_size, void* d_ws, size_t ws_size, hipStream_t stream) {
    static int inited = 0;
    if (!inited) { (void)hipFuncSetAttribute((const void*)hybrid_fwd, hipFuncAttributeMaxDynamicSharedMemorySize, LDS_BYTES); inited = 1; }
    (void)hipMemsetAsync((char*)d_ws + WS_BAR, 0, 16384, stream);
    Params p{};
    for (int i = 0; i < 34; ++i) p.in[i] = (const float*)d_in[i];
    p.out = (float*)d_out; p.ws = (unsigned char*)d_ws;
    void* args[] = {&p};
    (void)hipLaunchCooperativeKernel((const void*)hybrid_fwd, dim3(256), dim3(NTHREADS), args, LDS_BYTES, stream);
}
```

```cpp
#include <hip/hip_runtime.h>
#include <hip/hip_cooperative_groups.h>
namespace cg = cooperative_groups;

#define LAS __attribute__((address_space(3)))
#define DEV __device__ __forceinline__
typedef unsigned short bf16_t;
typedef short bf16x8 __attribute__((ext_vector_type(8)));
typedef short bf16x4 __attribute__((ext_vector_type(4)));
typedef float f32x2 __attribute__((ext_vector_type(2)));
typedef float f32x4 __attribute__((ext_vector_type(4)));
typedef float f32x16 __attribute__((ext_vector_type(16)));
typedef unsigned u32x2 __attribute__((ext_vector_type(2)));
typedef unsigned u32x4 __attribute__((ext_vector_type(4)));

constexpr int TP = 8192, TS = 256, TT = TP + TS, DM = 2048, NPROJ = 10496, DFF = 8192, NQKV = 3072;
constexpr int PC_XBC = 2048, PC_GATE = 6144, PC_XR = 8192;
constexpr float EPSN = 1e-6f;
constexpr size_t MiB = 1u << 20;
constexpr size_t WS_CDEC = 0, WS_ROPE = 1 * MiB, WS_MOD = 2 * MiB, WS_WIN = 6 * MiB, WS_WOH = 47 * MiB, WS_WQKV = 63 * MiB, WS_WOA = 75 * MiB, WS_WUP = 83 * MiB,
                 WS_WDN = 147 * MiB, WS_WLRU = 211 * MiB, WS_DT = 213 * MiB, WS_H = 215 * MiB, WS_A = 248 * MiB, WS_B = 418 * MiB, WS_YMIX = 550 * MiB, WS_MIX = 616 * MiB;
constexpr size_t WS_X16 = 682 * MiB;
constexpr size_t WS_PART = WS_B, WS_AU_U = WS_B + 66 * MiB, WS_QKV = WS_B, WS_ATTO = WS_B + 50 * MiB, WS_CS = WS_MIX, WS_HIN = WS_H, WS_PROJ = WS_A, WS_UP = WS_A;
constexpr size_t O_YP = 0, O_YS = O_YP + (size_t)4 * 2048 * 2048, O_PSC = O_YS + 32 * 8 * 2048, O_PSSM = O_PSC + 4 * 3 * 4096, O_PLC = O_PSSM + (size_t)4 * 32 * 64 * 128,
                 O_PL = O_PLC + 4 * 3 * 2048, O_PK = O_PL + 4 * 2048, O_PV = O_PK + 4 * 128 * 8 * 64, O_SSC = O_PV + 4 * 128 * 8 * 64, O_SSSM = O_SSC + 32 * 3 * 4096,
                 O_SLC = O_SSSM + (size_t)32 * 32 * 64 * 128, O_SL = O_SLC + 32 * 3 * 2048, O_SK = O_SL + 32 * 2048, O_SV = O_SK + (size_t)32 * 128 * 8 * 64;
constexpr int LDS_BYTES = 147456 + 64;
constexpr size_t WS_BAR = 65536;
constexpr int NTHREADS = 512;

#ifndef DBL
#define DBL -1
#endif
#ifndef TAILS
#define TAILS 1
#endif
#define REP(k) for (int rep_ = 0; rep_ < ((DBL) == (k) ? 2 : 1); ++rep_, __syncthreads())
struct Params { const float* in[34]; float* out; unsigned char* ws; };

DEV unsigned f2bf(float f) { unsigned u = __float_as_uint(f); return (u + 0x7fffu + ((u >> 16) & 1u)) >> 16; }
DEV unsigned pk2(float lo, float hi) { return f2bf(lo) | (f2bf(hi) << 16); }
DEV float bf2f(unsigned short b) { return __uint_as_float(((unsigned)b) << 16); }
DEV float bflo(unsigned w) { return __uint_as_float(w << 16); }
DEV float bfhi(unsigned w) { return __uint_as_float(w & 0xffff0000u); }
DEV float sigm(float x) { return 1.f / (1.f + __expf(-x)); }
DEV float siluf(float x) { return x * sigm(x); }
DEV float softplusf(float x) { return x > 20.f ? x : log1pf(__expf(x)); }
DEV float geluf(float x) { return x * sigm(1.5957691216057308f * (x + 0.044715f * x * x * x)); }
DEV float wave_sum(float v) {
#pragma unroll
    for (int o = 1; o < 64; o <<= 1) v += __shfl_xor(v, o);
    return v;
}
DEV void ld8(const bf16_t* p, float (&v)[8]) {
    const u32x4 w = *(const u32x4*)p;
    v[0] = bflo(w.x); v[1] = bfhi(w.x); v[2] = bflo(w.y); v[3] = bfhi(w.y); v[4] = bflo(w.z); v[5] = bfhi(w.z); v[6] = bflo(w.w); v[7] = bfhi(w.w);
}
DEV void ldf8(const float* p, float (&v)[8]) {
    const f32x4 a = *(const f32x4*)p, b = *(const f32x4*)(p + 4);
    v[0] = a.x; v[1] = a.y; v[2] = a.z; v[3] = a.w; v[4] = b.x; v[5] = b.y; v[6] = b.z; v[7] = b.w;
}
DEV u32x4 pack8(const float (&v)[8]) { u32x4 w; w.x = pk2(v[0], v[1]); w.y = pk2(v[2], v[3]); w.z = pk2(v[4], v[5]); w.w = pk2(v[6], v[7]); return w; }
DEV int rowmap(int reg, int h) { return (reg & 3) + 8 * (reg >> 2) + 4 * h; }
#define LDS_WAIT() asm volatile("s_waitcnt lgkmcnt(0)" ::: "memory")

DEV void conv8(const bf16_t* PROJ, int r, int tl, int pcol, const float* hist, int C, const float (&w)[4][8], const float (&bias)[8], float (&o)[8]) {
#pragma unroll
    for (int e = 0; e < 8; ++e) o[e] = bias[e];
#pragma unroll
    for (int d = 0; d < 4; ++d) {
        float v[8];
        if (tl - d >= 0) ld8(PROJ + (size_t)(r - d) * NPROJ + pcol, v);
        else if (hist) ldf8(hist + (size_t)(3 + tl - d) * C, v);
        else {
#pragma unroll
            for (int e = 0; e < 8; ++e) v[e] = 0.f;
        }
#pragma unroll
        for (int e = 0; e < 8; ++e) o[e] += w[3 - d][e] * v[e];
    }
}
DEV void ldconvw(const float* W, const float* B, int C, int c0, float (&w)[4][8], float (&bias)[8]) {
#pragma unroll
    for (int j = 0; j < 4; ++j) ldf8(W + (size_t)j * C + c0, w[j]);
    ldf8(B + c0, bias);
}
DEV void mma_tile(f32x16& acc, const LAS bf16_t* A, int lda, const LAS bf16_t* B, int ldb, int K, int lane) {
    const int r = lane & 31, h = lane >> 5;
    const LAS bf16_t* ap = A + r * lda + 8 * h; const LAS bf16_t* bp = B + r * ldb + 8 * h;
    for (int k = 0; k < K; k += 16) {
        const bf16x8 a = *(const LAS bf16x8*)(ap + k); const bf16x8 b = *(const LAS bf16x8*)(bp + k);
        acc = __builtin_amdgcn_mfma_f32_32x32x16_bf16(a, b, acc, 0, 0, 0);
    }
}
DEV f32x16 zero16() { f32x16 z;
#pragma unroll
    for (int i = 0; i < 16; ++i) z[i] = 0.f;
    return z; }

#define XB_TMO      128
#define XB_XCNT(j)  (256  + 64 * (j))
#define XB_XSUB(j)  (1280 + 64 * (j))
#define XB_XGEN(j)  (2304 + 64 * (j))
#define XB_TOP      3328
#define XB_TOPGEN   3392
#define XCD_BAR_WORDS 3456
#define XB_SPIN_CAP (1u << 18)

__device__ __forceinline__ unsigned xb_ld(unsigned* p)              { return __hip_atomic_load(p, __ATOMIC_RELAXED, __HIP_MEMORY_SCOPE_AGENT); }
__device__ __forceinline__ unsigned xb_add(unsigned* p, unsigned v) { return __hip_atomic_fetch_add(p, v, __ATOMIC_RELAXED, __HIP_MEMORY_SCOPE_AGENT); }
__device__ __forceinline__ unsigned xb_xcc_id() { return (unsigned)__builtin_amdgcn_s_getreg((3 << 11) | 20) & 0xFu; }
#define XB_SPIN(cond, bar) do { unsigned _sp = 0; while (cond) { __builtin_amdgcn_s_sleep(1); \
    if ((++_sp & 255u) == 0u) { if (xb_ld(&(bar)[XB_TMO])) break; if (_sp > XB_SPIN_CAP) { atomicAdd(&(bar)[XB_TMO], 1u); break; } } } } while (0)

struct XcdBarrier {
    unsigned* bar; unsigned x;
    volatile LAS unsigned* st;
};

__device__ __forceinline__ XcdBarrier xcd_barrier_post(unsigned* bar, volatile LAS unsigned* st) {
    XcdBarrier b; b.bar = bar; b.x = xb_xcc_id(); b.st = st;
    if (threadIdx.x == 0) (void)xb_add(&bar[XB_XCNT(b.x)], 1u);
    return b;
}
__device__ __forceinline__ void xcd_barrier_complete(unsigned* bar, unsigned x, unsigned& nloc, unsigned& nx) {
    const unsigned G = gridDim.x * gridDim.y * gridDim.z;
    unsigned sum, cnt, mine, sp = 0u;
    for (;;) {
        sum = 0u; cnt = 0u; mine = 0u;
#pragma unroll
        for (unsigned j = 0; j < 16; ++j) { const unsigned c = xb_ld(&bar[XB_XCNT(j)]); sum += c; cnt += (c > 0u) ? 1u : 0u; mine = (j == x) ? c : mine; }
        if (sum == G) break;
        __builtin_amdgcn_s_sleep(1);
        if ((++sp & 255u) == 0u) { if (xb_ld(&bar[XB_TMO])) break; if (sp > XB_SPIN_CAP) { atomicAdd(&bar[XB_TMO], 1u); break; } }
    }
    nloc = mine > 0u ? mine : 1u; nx = cnt > 0u ? cnt : 1u;
}

__device__ __forceinline__ void xcd_barrier(const XcdBarrier& b) {
    asm volatile("s_waitcnt vmcnt(0)" ::: "memory");
    __syncthreads();
    if (threadIdx.x == 0) {
        unsigned* bar = b.bar;
        __builtin_amdgcn_s_waitcnt(0);
        unsigned nloc = b.st[0], nx = b.st[1];
        if (nloc == 0u) { xcd_barrier_complete(bar, b.x, nloc, nx); b.st[0] = nloc; b.st[1] = nx; }
        const unsigned old = xb_add(&bar[XB_XSUB(b.x)], 1u);
        const unsigned gen = old / nloc;
        if (old + 1u == (gen + 1u) * nloc) {
            __builtin_amdgcn_fence(__ATOMIC_RELEASE, "agent");
            asm volatile("s_waitcnt vmcnt(0)" ::: "memory");
            const unsigned og = xb_add(&bar[XB_TOP], 1u);
            const unsigned tg = og / nx;
            if (og + 1u == (tg + 1u) * nx) xb_add(&bar[XB_TOPGEN], 1u);
            else XB_SPIN(xb_ld(&bar[XB_TOPGEN]) == tg, bar);
            __builtin_amdgcn_fence(__ATOMIC_ACQUIRE, "agent");
            xb_add(&bar[XB_XGEN(b.x)], 1u);
            asm volatile("s_waitcnt vmcnt(0)" ::: "memory");
        } else {
            XB_SPIN(xb_ld(&bar[XB_XGEN(b.x)]) == gen, bar);
            __builtin_amdgcn_fence(__ATOMIC_ACQUIRE, "agent");
            asm volatile("s_waitcnt vmcnt(0)" ::: "memory");
        }
    }
    __syncthreads();
}

namespace pg8 {
constexpr int BM = 256, BK = 64, HALF = 128, HTB = HALF * BK * 2, NXCD = 8, WGM = 8;
__host__ __device__ __forceinline__ int lds_byte(int r, int c) { const int st = (r >> 4) * 2 + (c >> 5), rr = r & 15, cc = c & 31, ob = rr * 64 + cc * 2; return st * 1024 + (ob ^ (((ob >> 9) & 1) << 5)); }
__host__ __device__ __forceinline__ void stage_rc(int b, int& R, int& C) { const int st = b / 1024, sb = b % 1024, swz = sb ^ (((sb >> 9) & 1) << 5); R = (st >> 1) * 16 + swz / 64; C = (st & 1) * 32 + (swz % 64) / 2; }
__host__ __device__ __forceinline__ int perm32(int rho) { const int n = rho >> 4, i = rho & 15; return 8 * (i >> 2) + 4 * n + (i & 3); }
struct Unit { int pm, pn, k0; };
struct Gemm { const bf16_t* A; const bf16_t* Bt; int K, lda, ldb; };
struct StaticOrder {
    int nM, nN, nwg, G, c;
    __device__ void init(int M, int N, int G_, int c_) { nM = M / BM; nN = N / BM; nwg = nM * nN; G = G_; c = c_; }
    __device__ bool next(int i, Unit& u) const {
        const long L = (long)i * G + c; if (L >= nwg) return false;
        int wgid = (int)L; { const int q = nwg / NXCD, r = nwg % NXCD, xcd = wgid % NXCD, off = wgid / NXCD; wgid = (xcd < r ? xcd * (q + 1) : r * (q + 1) + (xcd - r) * q) + off; }
        const int nig = WGM * nN, gid = wgid / nig, fm = gid * WGM, gsz = (nM - fm) < WGM ? (nM - fm) : WGM;
        u.pm = fm + ((wgid % nig) % gsz); u.pn = (wgid % nig) / gsz; u.k0 = 0; return true;
    }
};
struct SplitKOrder {
    int nN, nsplit, Kc, G, c;
    __device__ bool next(int i, Unit& u) const { const long L = (long)i * G + c; if (L >= (long)nN * nsplit) return false; u.pm = 0; u.pn = (int)(L % nN); u.k0 = (int)(L / nN) * Kc; return true; }
};
DEV unsigned cvt_pk_bf16(float lo, float hi) { unsigned r; asm volatile("v_cvt_pk_bf16_f32 %0, %1, %2" : "=v"(r) : "v"(lo), "v"(hi)); return r; }

struct EpiF32 {
    static constexpr bool PERM = false;
    float* C; int ldc; int kc;
    DEV void operator()(const f32x4 (&acc)[2][2][4][2], const Unit& u, int wr, int wc, int fr, int fq) const {
        float* Cb = C + (kc > 0 ? (size_t)(u.k0 / kc) * 256 * ldc : (size_t)0);
        const unsigned base = (unsigned)((u.pm * BM + wr * 64 + fr) * ldc + u.pn * BM + wc * 32 + 4 * fq);
#pragma unroll
        for (int ai = 0; ai < 2; ++ai)
#pragma unroll
            for (int m = 0; m < 4; ++m) { const unsigned o = base + (unsigned)((ai * HALF + m * 16) * ldc);
#pragma unroll
                for (int bj = 0; bj < 2; ++bj)
#pragma unroll
                    for (int n = 0; n < 2; ++n) *(f32x4*)(Cb + o + bj * HALF + n * 16) = acc[ai][bj][m][n];
                asm volatile("" ::: "memory"); }
    }
};
template <int MODE  > struct EpiBf16 {
    static constexpr bool PERM = true;
    bf16_t* O; int ldc; const float* bias; float* DT; int dt_pn;
    DEV void operator()(const f32x4 (&acc)[2][2][4][2], const Unit& u, int wr, int wc, int fr, int fq) const {
        const int row0 = u.pm * BM + wr * 64 + fr; const int col0 = u.pn * BM + wc * 32 + 8 * fq;
        if (MODE == 0 && u.pn == dt_pn) {
            if (wc == 0) {
#pragma unroll
                for (int ai = 0; ai < 2; ++ai)
#pragma unroll
                    for (int m = 0; m < 4; ++m) { float* rowp = DT + (size_t)(row0 + ai * HALF + m * 16) * 32 + 8 * fq;
                        *(f32x4*)(rowp) = acc[ai][0][m][0]; *(f32x4*)(rowp + 4) = acc[ai][0][m][1]; }
            }
            return;
        }
        f32x4 bv[2][2];
#pragma unroll
        for (int bj = 0; bj < 2; ++bj)
#pragma unroll
            for (int n = 0; n < 2; ++n) bv[bj][n] = (MODE == 2) ? *(const f32x4*)(bias + col0 + bj * HALF + 4 * n) : (f32x4){0.f, 0.f, 0.f, 0.f};
#pragma unroll
        for (int ai = 0; ai < 2; ++ai)
#pragma unroll
            for (int m = 0; m < 4; ++m) { bf16_t* rowp = O + (size_t)(row0 + ai * HALF + m * 16) * ldc + col0;
#pragma unroll
                for (int bj = 0; bj < 2; ++bj) { f32x4 v0 = acc[ai][bj][m][0] + bv[bj][0], v1 = acc[ai][bj][m][1] + bv[bj][1];
                    if (MODE == 1) {
#pragma unroll
                        for (int j = 0; j < 4; ++j) { const float a = fmaxf(v0[j], 0.f), b = fmaxf(v1[j], 0.f); v0[j] = a * a; v1[j] = b * b; } }
                    u32x4 w; w.x = cvt_pk_bf16(v0[0], v0[1]); w.y = cvt_pk_bf16(v0[2], v0[3]); w.z = cvt_pk_bf16(v1[0], v1[1]); w.w = cvt_pk_bf16(v1[2], v1[3]);
                    *(u32x4*)(rowp + bj * HALF) = w; } }
    }
};

template <class Epi, class Sched>
DEV void gemm_phase(LAS unsigned char* lds, const Gemm g, const Sched& S, const Epi& E) {
    int tid_l = threadIdx.x; asm volatile("" : "+v"(tid_l));
    const int tid = tid_l, wid = __builtin_amdgcn_readfirstlane(tid >> 6), lane = tid & 63, wr = wid >> 2, wc = wid & 3, fr = lane & 15, fq = lane >> 4;
    const int nt = g.K / BK;
    unsigned voffA[2], voffB[2];
#pragma unroll
    for (int i = 0; i < 2; ++i) { int R, C; stage_rc(tid * 16 + i * 8192, R, C); const int Rb = Epi::PERM ? ((R & ~31) + perm32(R & 31)) : R;
        voffA[i] = (unsigned)(R * g.lda + C) * 2u; voffB[i] = (unsigned)(Rb * g.ldb + C) * 2u; }
    const size_t kstep = (size_t)(BK * 2);
    const size_t hsA = (size_t)HALF * g.lda * 2, hsB = (size_t)HALF * g.ldb * 2;
    const size_t tsA = 2 * hsA, tsB = 2 * hsB;
    const unsigned ldsw = (unsigned)wid * 1024u;
    const int aoff = lds_byte(wr * 64 + fr, fq * 8), boff = lds_byte(wc * 32 + fr, fq * 8);
#define PG8_SA(b, h) (((b) * 2 + (h)) * HTB)
#define PG8_SB(b, h) ((4 + (b) * 2 + (h)) * HTB)
#define PG8_STAGE(bufoff, gbase, voff) do { _Pragma("unroll") for (int _i = 0; _i < 2; ++_i) \
        __builtin_amdgcn_global_load_lds((const unsigned*)((const char*)(gbase) + (voff)[_i]), (LAS unsigned*)(lds + (bufoff) + ldsw + _i * 8192), 16, 0, 0); } while (0)
#define PG8_LDA(dst, b, h) do { _Pragma("unroll") for (int m = 0; m < 4; ++m) _Pragma("unroll") for (int k = 0; k < 2; ++k) dst[m][k] = *(const LAS bf16x8*)(lds + PG8_SA(b, h) + aoff + m * 2048 + k * 1024); } while (0)
#define PG8_LDB(dst, b, h) do { _Pragma("unroll") for (int n = 0; n < 2; ++n) _Pragma("unroll") for (int k = 0; k < 2; ++k) dst[n][k] = *(const LAS bf16x8*)(lds + PG8_SB(b, h) + boff + n * 2048 + k * 1024); } while (0)
#define PG8_MMA(ai, bj, At, Bt) do { __builtin_amdgcn_s_setprio(1); _Pragma("unroll") for (int m = 0; m < 4; ++m) _Pragma("unroll") for (int n = 0; n < 2; ++n) _Pragma("unroll") for (int k = 0; k < 2; ++k) \
        acc[ai][bj][m][n] = __builtin_amdgcn_mfma_f32_16x16x32_bf16(Bt[n][k], At[m][k], acc[ai][bj][m][n], 0, 0, 0); __builtin_amdgcn_s_setprio(0); } while (0)
#define PG8_WAIT_V(n) asm volatile("s_waitcnt vmcnt(" #n ")" ::: "memory")
#define PG8_WAIT_L(n) asm volatile("s_waitcnt lgkmcnt(" #n ")" ::: "memory")
#define PG8_BAR __builtin_amdgcn_s_barrier()
#define PG8_SCHED __builtin_amdgcn_sched_barrier(0)
    Unit cur, nxt; int ui = 0;
    if (!S.next(0, cur)) return;
    f32x4 acc[2][2][4][2];
#pragma unroll
    for (int a = 0; a < 2; ++a)
#pragma unroll
        for (int b = 0; b < 2; ++b)
#pragma unroll
            for (int m = 0; m < 4; ++m)
#pragma unroll
                for (int n = 0; n < 2; ++n) acc[a][b][m][n] = (f32x4){0.f, 0.f, 0.f, 0.f};
    bf16x8 At[4][2], B0[2][2], B1[2][2];
    const char* cA = (const char*)g.A + (size_t)cur.pm * tsA + (size_t)cur.k0 * 2; const char* cB = (const char*)g.Bt + (size_t)cur.pn * tsB + (size_t)cur.k0 * 2;
    PG8_STAGE(PG8_SB(0, 0), cB, voffB); PG8_STAGE(PG8_SA(0, 0), cA, voffA); PG8_STAGE(PG8_SB(0, 1), cB + hsB, voffB); PG8_STAGE(PG8_SA(0, 1), cA + hsA, voffA);
    if (wr == 1) PG8_BAR;
    PG8_WAIT_V(4); PG8_BAR;
    PG8_STAGE(PG8_SB(1, 0), cB + kstep, voffB); PG8_STAGE(PG8_SA(1, 0), cA + kstep, voffA); PG8_STAGE(PG8_SB(1, 1), cB + hsB + kstep, voffB);
    PG8_WAIT_V(6); PG8_BAR;
    for (;;) {
        const bool has_next = S.next(ui + 1, nxt);
        const char* nA = has_next ? (const char*)g.A + (size_t)nxt.pm * tsA + (size_t)nxt.k0 * 2 : cA; const char* nB = has_next ? (const char*)g.Bt + (size_t)nxt.pn * tsB + (size_t)nxt.k0 * 2 : cB;
        for (int t = 0; t < nt; t += 2) {
            const bool last = (t == nt - 2);
            const char* a1 = cA + (size_t)(t + 1) * kstep;
            const char* a2 = last ? nA : cA + (size_t)(t + 2) * kstep; const char* b2 = last ? nB : cB + (size_t)(t + 2) * kstep;
            const char* a3 = a2 + kstep; const char* b3 = b2 + kstep;
            PG8_LDB(B0, 0, 0); PG8_SCHED; PG8_LDA(At, 0, 0); PG8_STAGE(PG8_SA(1, 1), a1 + hsA, voffA);
            PG8_WAIT_L(8); PG8_BAR; PG8_WAIT_L(0); PG8_MMA(0, 0, At, B0); PG8_BAR; PG8_SCHED;
            PG8_LDB(B1, 0, 1); PG8_STAGE(PG8_SB(0, 0), b2, voffB);
            PG8_BAR; PG8_WAIT_L(0); PG8_MMA(0, 1, At, B1); PG8_BAR;
            PG8_LDA(At, 0, 1); PG8_STAGE(PG8_SA(0, 0), a2, voffA);
            PG8_BAR; PG8_WAIT_L(0); PG8_MMA(1, 0, At, B0); PG8_BAR; PG8_SCHED;
            PG8_STAGE(PG8_SB(0, 1), b2 + hsB, voffB);
            PG8_WAIT_V(6); PG8_BAR; PG8_MMA(1, 1, At, B1); PG8_BAR;
            PG8_LDB(B0, 1, 0); PG8_SCHED; PG8_LDA(At, 1, 0); PG8_STAGE(PG8_SA(0, 1), a2 + hsA, voffA);
            PG8_WAIT_L(8); PG8_BAR; PG8_WAIT_L(0); PG8_MMA(0, 0, At, B0); PG8_BAR; PG8_SCHED;
            PG8_LDB(B1, 1, 1); PG8_STAGE(PG8_SB(1, 0), b3, voffB);
            PG8_BAR; PG8_WAIT_L(0); PG8_MMA(0, 1, At, B1); PG8_BAR;
            PG8_LDA(At, 1, 1); PG8_STAGE(PG8_SA(1, 0), a3, voffA);
            PG8_BAR; PG8_WAIT_L(0); PG8_MMA(1, 0, At, B0); PG8_BAR; PG8_SCHED;
            PG8_STAGE(PG8_SB(1, 1), b3 + hsB, voffB);
            PG8_WAIT_V(6); PG8_BAR; PG8_MMA(1, 1, At, B1); PG8_BAR;
        }
        E(acc, cur, wr, wc, fr, fq);
        if (!has_next) break;
#pragma unroll
        for (int a = 0; a < 2; ++a)
#pragma unroll
            for (int b = 0; b < 2; ++b)
#pragma unroll
                for (int m = 0; m < 4; ++m)
#pragma unroll
                    for (int n = 0; n < 2; ++n) acc[a][b][m][n] = (f32x4){0.f, 0.f, 0.f, 0.f};
        cur = nxt; cA = nA; cB = nB; ++ui;
    }
    PG8_WAIT_V(0);
    if (wr == 0) PG8_BAR;
    PG8_BAR;
#undef PG8_SA
#undef PG8_SB
#undef PG8_STAGE
#undef PG8_LDA
#undef PG8_LDB
#undef PG8_MMA
#undef PG8_WAIT_V
#undef PG8_WAIT_L
#undef PG8_BAR
#undef PG8_SCHED
}
}

DEV void mod_item(const Params& P, LAS unsigned char* lds, int item, int tid, int lane, int wave) {
    const int colg = item * 128, layer = colg / 12288, n0 = colg % 12288;
    LAS float* cs = (LAS float*)(lds + wave * 9216);
    LAS float* red = (LAS float*)(lds + 73728);
    float acc[36][2];
#pragma unroll
    for (int s = 0; s < 36; ++s) { acc[s][0] = 0.f; acc[s][1] = 0.f; }
#define MOD_LOADW(dst, kq) do { const float* wr_ = Wu + (size_t)(kq) * 12288; _Pragma("unroll") for (int j_ = 0; j_ < 16; ++j_) dst[j_] = *(const f32x2*)(wr_ + (size_t)j_ * 12288 + voff); } while (0)
#define MOD_COMP(wv, koff) do { _Pragma("unroll") for (int j4_ = 0; j4_ < 4; ++j4_) { _Pragma("unroll") for (int sg = 0; sg < 4; ++sg) { \
        _Pragma("unroll") for (int s = 9 * sg; s < 9 * sg + 9; ++s) { const f32x4 c = *(const LAS f32x4*)(cs + s * 64 + (koff) + 4 * j4_); \
            acc[s][0] += c.x * wv[4 * j4_].x + c.y * wv[4 * j4_ + 1].x + c.z * wv[4 * j4_ + 2].x + c.w * wv[4 * j4_ + 3].x; \
            acc[s][1] += c.x * wv[4 * j4_].y + c.y * wv[4 * j4_ + 1].y + c.z * wv[4 * j4_ + 2].y + c.w * wv[4 * j4_ + 3].y; } \
        _Pragma("unroll") for (int s = 9 * sg; s < 9 * sg + 9; ++s) asm volatile("" : "+v"(acc[s][0]), "+v"(acc[s][1]) :: "memory"); } } } while (0)
    const float* Wu = P.in[10] + (size_t)layer * 2048 * 12288 + n0; const unsigned voff = 2u * (unsigned)lane;
    f32x2 wa[16], wb[16];
    MOD_LOADW(wa, wave * 256);
#pragma nounroll
    for (int sub = 0; sub < 4; ++sub) {
        const int kb = wave * 256 + sub * 64;
#pragma unroll 4
        for (int i = 0; i < 36; ++i) { const float v = (i < 4) ? P.in[8][i * 2048 + kb + lane] : P.in[9][(i - 4) * 2048 + kb + lane]; cs[i * 64 + lane] = siluf(v); }
        LDS_WAIT();
#pragma nounroll
        for (int g2 = 0; g2 < 2; ++g2) {
            MOD_LOADW(wb, kb + 32 * g2 + 16); MOD_COMP(wa, 32 * g2);
            if (kb + 32 * g2 + 32 < 2048) MOD_LOADW(wa, kb + 32 * g2 + 32);
            MOD_COMP(wb, 32 * g2 + 16);
        }
        LDS_WAIT();
    }
#undef MOD_LOADW
#undef MOD_COMP
    __syncthreads();
    float* MOD = (float*)(P.ws + WS_MOD);
#pragma unroll
    for (int half = 0; half < 2; ++half) {
#pragma unroll
        for (int s = 0; s < 18; ++s) *(LAS f32x2*)(red + (wave * 18 + s) * 128 + 2 * lane) = (f32x2){acc[18 * half + s][0], acc[18 * half + s][1]};
        __syncthreads();
        for (int o = tid; o < 18 * 128; o += NTHREADS) { const int s = o >> 7, c = o & 127; float v = 0.f;
#pragma unroll
            for (int w = 0; w < 8; ++w) v += red[(w * 18 + s) * 128 + c];
            MOD[(size_t)(layer * 36 + 18 * half + s) * 12288 + n0 + c] = v + P.in[11][layer * 12288 + n0 + c]; }
        __syncthreads();
    }
}
DEV void transpose_item(const float* W, int ldw, int k0, int n0, int ncols, bf16_t* WT, int ldt, int drow0, LAS float* scr, int lane) {
    if (lane < ncols) {
        float v[64];
        const float* wp = W + (size_t)k0 * ldw + n0 + lane;
#pragma unroll
        for (int kk = 0; kk < 64; ++kk) v[kk] = __builtin_nontemporal_load(wp + (size_t)kk * ldw);
#pragma unroll
        for (int kk = 0; kk < 64; ++kk) scr[kk * 65 + lane] = v[kk];
    }
    LDS_WAIT();
    const int c = lane & 7;
#pragma unroll
    for (int j = 0; j < 8; ++j) { const int n = (lane >> 3) + 8 * j;
        if (n < ncols) { const LAS float* s = scr + (8 * c) * 65 + n;
            u32x4 o; o.x = pk2(s[0], s[65]); o.y = pk2(s[2 * 65], s[3 * 65]); o.z = pk2(s[4 * 65], s[5 * 65]); o.w = pk2(s[6 * 65], s[7 * 65]);
            *(u32x4*)(WT + (size_t)(drow0 + n) * ldt + k0 + 8 * c) = o; } }
    LDS_WAIT();
}
DEV void transpose_range(const Params& P, LAS unsigned char* lds, int lo, int hi, int slot0, int myslots, int nslots, int lane, int wave) {
    unsigned char* ws = P.ws; bf16_t* WIN = (bf16_t*)(ws + WS_WIN);
    LAS float* scr = (LAS float*)(lds + wave * 16640);
    for (int sl = 0; sl < myslots; ++sl)
    for (int it = lo + slot0 + sl; it < hi; it += nslots) {
        int r = it;
        if (r < 3072) { const int kb = r / 96, nb = r % 96; transpose_item(P.in[13], 10272, kb * 64, nb * 64, 64, WIN, 2048, nb * 64, scr, lane); continue; } r -= 3072;
        if (r < 2048) { const int kb = r / 64, nb = r % 64; transpose_item(P.in[13], 10272, kb * 64, 6176 + nb * 64, 64, WIN, 2048, 6144 + nb * 64, scr, lane); continue; } r -= 2048;
        if (r < 32) { transpose_item(P.in[13], 10272, r * 64, 6144, 32, WIN, 2048, 10240, scr, lane); continue; } r -= 32;
        if (r < 2048) { const int kb = r / 32, nb = r % 32; transpose_item(P.in[27], 2048, kb * 64, nb * 64, 64, (bf16_t*)(ws + WS_WOH), 4096, nb * 64, scr, lane); continue; } r -= 2048;
        if (r < 1536) { const int kb = r / 48, nb = r % 48; transpose_item(P.in[28], 3072, kb * 64, nb * 64, 64, (bf16_t*)(ws + WS_WQKV), 2048, nb * 64, scr, lane); continue; } r -= 1536;
        if (r < 1024) { const int kb = r / 32, nb = r % 32; transpose_item(P.in[31], 2048, kb * 64, nb * 64, 64, (bf16_t*)(ws + WS_WOA), 2048, nb * 64, scr, lane); continue; } r -= 1024;
        if (r < 8192) { const int l = r / 4096; r %= 4096; const int kb = r / 128, nb = r % 128;
            transpose_item(P.in[32] + (size_t)l * 2048 * 8192, 8192, kb * 64, nb * 64, 64, (bf16_t*)(ws + WS_WUP) + (size_t)l * 8192 * 2048, 2048, nb * 64, scr, lane); continue; } r -= 8192;
        if (r < 8192) { const int l = r / 4096; r %= 4096; const int kb = r / 32, nb = r % 32;
            transpose_item(P.in[33] + (size_t)l * 8192 * 2048, 2048, kb * 64, nb * 64, 64, (bf16_t*)(ws + WS_WDN) + (size_t)l * 2048 * 8192, 8192, nb * 64, scr, lane); continue; } r -= 8192;
        { const int mat = r / 128; r %= 128; const int blk = r / 16; r %= 16; const int kb = r / 4, nb = r % 4;
            transpose_item((mat ? P.in[24] : P.in[22]) + (size_t)blk * 65536, 256, kb * 64, nb * 64, 64, (bf16_t*)(ws + WS_WLRU) + (size_t)mat * 8 * 65536 + (size_t)blk * 65536, 256, nb * 64, scr, lane); }
    }
}
DEV void phase0(const Params& P, LAS unsigned char* lds, int tid, int lane, int wave) {
    const int G = gridDim.x, bid = blockIdx.x;
    unsigned char* ws = P.ws;
    REP(20) for (int it = bid; it < 192; it += G) mod_item(P, lds, it, tid, lane, wave);
    __syncthreads();
    bf16_t* WIN = (bf16_t*)(ws + WS_WIN);
    REP(21) {
    const int nmod = G > 192 ? 192 : G, nslots = (G - nmod) * 8 * 9 + nmod * 8;
    const int myslots = bid >= nmod ? 9 : 1, slot0 = bid >= nmod ? 9 * ((bid - nmod) * 8 + wave) : (G - nmod) * 72 + (bid * 8 + wave);
#if TAILS
    transpose_range(P, lds, 0, 5152, slot0, myslots, nslots, lane, wave);
    transpose_range(P, lds, 26144, 26400, bid * 8 + wave, 1, G * 8, lane, wave);
    if (G > 192 && bid >= nmod) transpose_range(P, lds, 5152, 7200, (bid - nmod) * 8 + wave, 1, (G - nmod) * 8, lane, wave);
#else
    { const int ns2 = (G - nmod) * 8 * 3 + nmod * 8 * 2, my2 = bid >= nmod ? 3 : 2, s02 = bid >= nmod ? 3 * ((bid - nmod) * 8 + wave) : (G - nmod) * 24 + 2 * (bid * 8 + wave);
      transpose_range(P, lds, 0, 26400, s02, my2, ns2, lane, wave); }
#endif
    }
    const int gt = bid * NTHREADS + tid, NGT = G * NTHREADS;
    for (int q = gt; q < 57344; q += NGT) *((u32x4*)(WIN + (size_t)10272 * 2048) + q) = (u32x4){0u, 0u, 0u, 0u};
    float* ROPE = (float*)(ws + WS_ROPE);
    for (int q = gt; q < 2056 * 32; q += NGT) {
        const int pi = q >> 5, i = q & 31; const int pos = pi < 2048 ? pi : 16384 + (pi - 2048);
        const float invf = powf(10000.0f, -(float)i / 32.0f);
        const float ang = (float)pos * invf;
        const double a = (double)ang; const double n = rint(a * 0.15915494309189535); const float rr = (float)(a - n * 6.283185307179586);
        ROPE[2 * q] = cosf(rr); ROPE[2 * q + 1] = sinf(rr);
    }
}

DEV void norm_phase(const Params& P, LAS unsigned char* lds, bool first, bool last, int l_post, int gpost_idx, int gate_j, int l_pre, int gpre_idx, int sh_j, int sc_j, int nsplit, int lane, int wave, float gscale = 1.f, bool xin = false) {
    const int G = gridDim.x; const int gw = blockIdx.x * 8 + wave, NGW = G * 8;
    float* X = P.out; bf16_t* X16 = (bf16_t*)(P.ws + WS_X16); const bf16_t* MIXB = (const bf16_t*)(P.ws + WS_MIX); bf16_t* H = (bf16_t*)(P.ws + WS_H); const float* MOD = (const float*)(P.ws + WS_MOD);
    const float* gpo = P.in[12] + (size_t)(l_post * 4 + gpost_idx) * DM; const float* gpr = P.in[12] + (size_t)(l_pre * 4 + gpre_idx) * DM;
    const int nrows = first ? TT : TP;
#define NORM_LOADRAW(XF, XH, MH, rowi) do { const int r_ = (rowi); const float* xs_ = r_ < TP ? P.in[0] + (size_t)r_ * DM : P.in[1] + (size_t)(r_ - TP) * DM; \
        _Pragma("unroll") for (int j = 0; j < 8; ++j) { \
            if (first || xin) XF[j] = *(const f32x4*)(xs_ + 4 * lane + 256 * j); else XH[j] = *(const u32x2*)(X16 + (size_t)r_ * DM + 4 * lane + 256 * j); \
            if (!first) MH[j] = *(const u32x2*)(MIXB + (size_t)r_ * DM + 4 * lane + 256 * j); } } while (0)
#define NORM_COPYRAW(XFd, XHd, MHd, XFs, XHs, MHs) do { _Pragma("unroll") for (int j = 0; j < 8; ++j) { if (first || xin) XFd[j] = XFs[j]; else XHd[j] = XHs[j]; if (!first) MHd[j] = MHs[j]; } } while (0)
    f32x4 xa[8], ma[8];
    f32x4 xfB[8], xfC[8]; u32x2 xhB[8], xhC[8], mhB[8], mhC[8];
    int r = gw;
    if (r < nrows) NORM_LOADRAW(xfB, xhB, mhB, r);
    if (r + NGW < nrows) NORM_LOADRAW(xfC, xhC, mhC, r + NGW); else NORM_COPYRAW(xfC, xhC, mhC, xfB, xhB, mhB);
    for (; r < nrows; r += NGW) {
#pragma unroll
        for (int j = 0; j < 8; ++j) {
            if (first || xin) xa[j] = xfB[j]; else xa[j] = (f32x4){bflo(xhB[j].x), bfhi(xhB[j].x), bflo(xhB[j].y), bfhi(xhB[j].y)};
            if (first) ma[j] = xa[j]; else ma[j] = (f32x4){bflo(mhB[j].x), bfhi(mhB[j].x), bflo(mhB[j].y), bfhi(mhB[j].y)}; }
        NORM_COPYRAW(xfB, xhB, mhB, xfC, xhC, mhC);
        if (r + 2 * NGW < nrows) NORM_LOADRAW(xfC, xhC, mhC, r + 2 * NGW);
        const int seq = r < TP ? (r >> 11) : 4 + ((r - TP) >> 3);
        if (!first) {
            float ss = 0.f;
#pragma unroll
            for (int j = 0; j < 8; ++j) ss += ma[j].x * ma[j].x + ma[j].y * ma[j].y + ma[j].z * ma[j].z + ma[j].w * ma[j].w;
            const float rinv = rsqrtf(wave_sum(ss) * (1.f / DM) + EPSN);
            const float* gt = MOD + (size_t)(l_post * 36 + seq) * 12288 + gate_j * DM;
#pragma unroll
            for (int j = 0; j < 8; ++j) { const f32x4 g = *(const f32x4*)(gpo + 4 * lane + 256 * j), ga = *(const f32x4*)(gt + 4 * lane + 256 * j);
                xa[j] = xa[j] + ga * gscale * (ma[j] * rinv * g);
                if (last) *(f32x4*)(X + (size_t)r * DM + 4 * lane + 256 * j) = xa[j];
                else { u32x2 xw; xw.x = pk2(xa[j].x, xa[j].y); xw.y = pk2(xa[j].z, xa[j].w); *(u32x2*)(X16 + (size_t)r * DM + 4 * lane + 256 * j) = xw; } }
        }
        if (!last) {
            float ss = 0.f;
#pragma unroll
            for (int j = 0; j < 8; ++j) ss += xa[j].x * xa[j].x + xa[j].y * xa[j].y + xa[j].z * xa[j].z + xa[j].w * xa[j].w;
            const float rinv = rsqrtf(wave_sum(ss) * (1.f / DM) + EPSN);
            const float* mbp = MOD + (size_t)(l_pre * 36 + seq) * 12288;
#pragma unroll
            for (int j = 0; j < 8; ++j) { const f32x4 g = *(const f32x4*)(gpr + 4 * lane + 256 * j), sc = *(const f32x4*)(mbp + sc_j * DM + 4 * lane + 256 * j), sh = *(const f32x4*)(mbp + sh_j * DM + 4 * lane + 256 * j);
                const f32x4 h = xa[j] * rinv * g * (sc + 1.f) + sh;
                u32x2 w; w.x = pk2(h.x, h.y); w.y = pk2(h.z, h.w);
                *(u32x2*)(H + (size_t)r * DM + 4 * lane + 256 * j) = w; }
        }
    }
#undef NORM_LOADRAW
#undef NORM_COPYRAW
    if (first) return;
    LAS float* red = (LAS float*)lds;
    for (int rs = blockIdx.x; rs < TS; rs += G) {
        const int rr = TP + rs, seq = 4 + (rs >> 3), col = 256 * wave + 4 * lane;
        const float* pp = (const float*)(P.ws + WS_PART) + (size_t)rs * DM + col;
        f32x4 mv = (f32x4){0.f, 0.f, 0.f, 0.f};
#pragma unroll 8
        for (int ks = 0; ks < nsplit; ++ks) mv = mv + *(const f32x4*)(pp + (size_t)ks * 256 * DM);
        f32x4 xv;
        if (xin) xv = *(const f32x4*)(P.in[1] + (size_t)rs * DM + col); else { const u32x2 xw = *(const u32x2*)(X16 + (size_t)rr * DM + col); xv = (f32x4){bflo(xw.x), bfhi(xw.x), bflo(xw.y), bfhi(xw.y)}; }
        const float s1 = wave_sum(mv.x * mv.x + mv.y * mv.y + mv.z * mv.z + mv.w * mv.w);
        if (lane == 0) red[wave] = s1;
        __syncthreads();
        float tot = 0.f;
#pragma unroll
        for (int w = 0; w < 8; ++w) tot += red[w];
        const float rinv = rsqrtf(tot * (1.f / DM) + EPSN);
        const f32x4 g = *(const f32x4*)(gpo + col), ga = *(const f32x4*)(MOD + (size_t)(l_post * 36 + seq) * 12288 + gate_j * DM + col);
        xv = xv + ga * gscale * (mv * rinv * g);
        if (last) *(f32x4*)(X + (size_t)rr * DM + col) = xv; else { u32x2 xw; xw.x = pk2(xv.x, xv.y); xw.y = pk2(xv.z, xv.w); *(u32x2*)(X16 + (size_t)rr * DM + col) = xw; }
        if (!last) {
            const float s2 = wave_sum(xv.x * xv.x + xv.y * xv.y + xv.z * xv.z + xv.w * xv.w);
            if (lane == 0) red[8 + wave] = s2;
            __syncthreads();
            float tot2 = 0.f;
#pragma unroll
            for (int w = 0; w < 8; ++w) tot2 += red[8 + w];
            const float rinv2 = rsqrtf(tot2 * (1.f / DM) + EPSN);
            const float* mbp = MOD + (size_t)(l_pre * 36 + seq) * 12288;
            const f32x4 g2 = *(const f32x4*)(gpr + col), sc = *(const f32x4*)(mbp + sc_j * DM + col), sh = *(const f32x4*)(mbp + sh_j * DM + col);
            const f32x4 h = xv * rinv2 * g2 * (sc + 1.f) + sh;
            u32x2 w; w.x = pk2(h.x, h.y); w.y = pk2(h.z, h.w);
            *(u32x2*)(H + (size_t)rr * DM + col) = w;
        }
        __syncthreads();
    }
}

DEV void lru_gate_item(const Params& P, LAS unsigned char* lds, int r0, int nrows  , int kb, int tid, int lane, int wave) {
    LAS bf16_t* XC = (LAS bf16_t*)lds;
    const bf16_t* PROJ = (const bf16_t*)(P.ws + WS_PROJ);
    {
        const int cgp = tid & 31, ch0 = kb * 256 + cgp * 8;
        float w[4][8], bias[8]; ldconvw(P.in[20], P.in[21], 2048, ch0, w, bias);
#pragma unroll 4
        for (int i = 0; i < nrows / 16; ++i) { const int q = tid + NTHREADS * i, row = q >> 5, r = r0 + row; int tl; const float* hist = nullptr;
            if (r < TP) tl = r & 2047; else { const int rs = r - TP; tl = rs & 7; hist = P.in[4] + (size_t)(rs >> 3) * 3 * 2048 + ch0; }
            float o[8]; conv8(PROJ, r, tl, PC_XR + ch0, hist, 2048, w, bias, o);
            *(LAS u32x4*)(XC + row * 264 + cgp * 8) = pack8(o); }
    }
    __syncthreads();
    const int r = lane & 31, h = lane >> 5;
    const int ch = kb * 256 + 32 * wave + r;
    const float ba_ = P.in[23][ch], bx_ = P.in[25][ch], sp = softplusf(-P.in[26][ch]);
    float* Aa = (float*)(P.ws + WS_B); float* Uu = (float*)(P.ws + WS_AU_U);
    const bf16_t* Wa = (const bf16_t*)(P.ws + WS_WLRU) + (size_t)(kb * 256 + 32 * wave + r) * 256 + 8 * h; const bf16_t* Wx = Wa + 8 * 65536;
#pragma nounroll
    for (int mh = 0; mh < nrows / 64; ++mh) {
        f32x16 aa[2], ax[2];
#pragma unroll
        for (int m = 0; m < 2; ++m) { aa[m] = zero16(); ax[m] = zero16(); }
        bf16x8 bA[4], bX[4], nA[4], nX[4];
#pragma unroll
        for (int j = 0; j < 4; ++j) { bA[j] = *(const bf16x8*)(Wa + 16 * j); bX[j] = *(const bf16x8*)(Wx + 16 * j); }
#pragma unroll
        for (int kb4 = 0; kb4 < 4; ++kb4) {
            if (kb4 < 3) {
#pragma unroll
                for (int j = 0; j < 4; ++j) { nA[j] = *(const bf16x8*)(Wa + 64 * (kb4 + 1) + 16 * j); nX[j] = *(const bf16x8*)(Wx + 64 * (kb4 + 1) + 16 * j); } }
#pragma unroll
            for (int j = 0; j < 4; ++j)
#pragma unroll
                for (int m = 0; m < 2; ++m) { const bf16x8 a = *(const LAS bf16x8*)(XC + (64 * mh + 32 * m + r) * 264 + 64 * kb4 + 16 * j + 8 * h);
                    aa[m] = __builtin_amdgcn_mfma_f32_32x32x16_bf16(a, bA[j], aa[m], 0, 0, 0); ax[m] = __builtin_amdgcn_mfma_f32_32x32x16_bf16(a, bX[j], ax[m], 0, 0, 0); }
            if (kb4 < 3) {
#pragma unroll
                for (int j = 0; j < 4; ++j) { bA[j] = nA[j]; bX[j] = nX[j]; } }
        }
#pragma unroll
        for (int m = 0; m < 2; ++m)
#pragma unroll
            for (int reg = 0; reg < 16; ++reg) { const int t = 64 * mh + 32 * m + rowmap(reg, h);
                const float xb = bf2f(XC[t * 264 + 32 * wave + r]);
                const float gr = sigm(aa[m][reg] + ba_), gi = sigm(ax[m][reg] + bx_);
                const float la = -8.0f * gr * sp; const float a = __expf(la); const float mult = sqrtf(fmaxf(-expm1f(2.0f * la), 0.f));
                Aa[(size_t)(r0 + t) * 2048 + ch] = a; Uu[(size_t)(r0 + t) * 2048 + ch] = mult * gi * xb; }
    }
    __syncthreads();
}
DEV void ssd_dt_acs(const Params& P, LAS float* acs, LAS float* dts, LAS float* tmp, int R0, int g, int tid) {
    const int hh = tid >> 7, s = tid & 127, hd = 4 * g + hh;
    const float* DT = (const float*)(P.ws + WS_DT);
    const float dtv = softplusf(DT[(size_t)(R0 + s) * 32 + hd] + P.in[16][hd]);
    const float a = -__expf(P.in[17][hd]);
    tmp[tid] = dtv * a; dts[tid] = dtv;
    __syncthreads();
    float c = 0.f; for (int i = 0; i <= s; ++i) c += tmp[hh * 128 + i];
    acs[tid] = c;
    __syncthreads();
}
DEV void ssd_state_item(const Params& P, LAS unsigned char* lds, int it, int tid, int lane, int wave) {
    const int g = it & 7, c = (it >> 3) & 15, b = it >> 7; const int R0 = b * 2048 + c * 128;
    LAS bf16_t* BT = (LAS bf16_t*)lds;
    LAS bf16_t* XWT = (LAS bf16_t*)(lds + 34816);
    LAS float* acs = (LAS float*)(lds + 52224); LAS float* dts = acs + 512; LAS float* tmp = dts + 512;
    const bf16_t* PROJ = (const bf16_t*)(P.ws + WS_PROJ);
    ssd_dt_acs(P, acs, dts, tmp, R0, g, tid);
    {
        const int cgb = tid & 15, cidx = 2048 + g * 128 + cgb * 8;
        float w[4][8], bias[8]; ldconvw(P.in[14], P.in[15], 4096, cidx, w, bias);
#pragma unroll 4
        for (int i = 0; i < 4; ++i) { const int q = tid + NTHREADS * i, s = q >> 4; float o[8];
            conv8(PROJ, R0 + s, c * 128 + s, PC_XBC + cidx, nullptr, 4096, w, bias, o);
#pragma unroll
            for (int e = 0; e < 8; ++e) BT[(cgb * 8 + e) * 136 + s] = (bf16_t)f2bf(siluf(o[e])); }
    }
    float* CS = (float*)(P.ws + WS_CS); float* CDEC = (float*)(P.ws + WS_CDEC);
    for (int hh = 0; hh < 4; ++hh) {
        const int hd = 4 * g + hh;
        {
            const int cgp = tid & 7, cidx = hd * 64 + cgp * 8;
            float w[4][8], bias[8]; ldconvw(P.in[14], P.in[15], 4096, cidx, w, bias);
            const float alast = acs[hh * 128 + 127];
#pragma unroll 2
            for (int i = 0; i < 2; ++i) { const int q = tid + NTHREADS * i, s = q >> 3; float o[8];
                conv8(PROJ, R0 + s, c * 128 + s, PC_XBC + cidx, nullptr, 4096, w, bias, o);
                const float sc = dts[hh * 128 + s] * __expf(alast - acs[hh * 128 + s]);
#pragma unroll
                for (int e = 0; e < 8; ++e) XWT[(cgp * 8 + e) * 136 + s] = (bf16_t)f2bf(siluf(o[e]) * sc); }
        }
        __syncthreads();
        const int pt = wave >> 2, nt = wave & 3;
        f32x16 acc = zero16();
        mma_tile(acc, XWT + 32 * pt * 136, 136, BT + 32 * nt * 136, 136, 128, lane);
        float* dst = CS + ((size_t)((b * 16 + c) * 32 + hd)) * 8192;
#pragma unroll
        for (int reg = 0; reg < 16; ++reg) dst[(32 * pt + rowmap(reg, lane >> 5)) * 128 + 32 * nt + (lane & 31)] = acc[reg];
        if (tid == 0) CDEC[(b * 16 + c) * 32 + hd] = __expf(acs[hh * 128 + 127]);
        __syncthreads();
    }
}
DEV void phase3(const Params& P, LAS unsigned char* lds, int tid, int lane, int wave) {
    const int G = gridDim.x, bid = blockIdx.x;
    REP(14) { for (int it = bid; it < 512; it += G) lru_gate_item(P, lds, (it >> 3) * 128, 128, it & 7, tid, lane, wave);
              for (int it = bid; it < 32; it += G) lru_gate_item(P, lds, TP + (it >> 3) * 64, 64, it & 7, tid, lane, wave); }
    REP(15) for (int it = bid; it < 512; it += G) ssd_state_item(P, lds, it, tid, lane, wave);
    const bf16_t* PROJ = (const bf16_t*)(P.ws + WS_PROJ);
    const int gt = bid * NTHREADS + tid, NGT = G * NTHREADS;
    for (int q = gt; q < 49152 + 24576 + 393216 + 196608; q += NGT) {
        int r = q;
        if (r < 49152) { const int b = r / 12288, j = (r / 4096) % 3, cc = r % 4096; P.out[O_PSC + r] = bf2f(PROJ[(size_t)(b * 2048 + 2045 + j) * NPROJ + PC_XBC + cc]); continue; } r -= 49152;
        if (r < 24576) { const int b = r / 6144, j = (r / 2048) % 3, cc = r % 2048; P.out[O_PLC + r] = bf2f(PROJ[(size_t)(b * 2048 + 2045 + j) * NPROJ + PC_XR + cc]); continue; } r -= 24576;
        if (r < 393216) { const int b = r / 12288, j = (r / 4096) % 3, cc = r % 4096; P.out[O_SSC + r] = bf2f(PROJ[(size_t)(TP + b * 8 + 5 + j) * NPROJ + PC_XBC + cc]); continue; } r -= 393216;
        { const int b = r / 6144, j = (r / 2048) % 3, cc = r % 2048; P.out[O_SLC + r] = bf2f(PROJ[(size_t)(TP + b * 8 + 5 + j) * NPROJ + PC_XR + cc]); }
    }
}

DEV void lru_scan_item(const Params& P, LAS unsigned char* lds, int it, int tid) {
    const int b = it >> 6, cgp = it & 63, cl = tid & 31, ch = cgp * 32 + cl, seg = tid >> 5;
    const size_t rbase = (size_t)b * 2048 + seg * 128;
    const float* Aa = (const float*)(P.ws + WS_B) + rbase * 2048 + ch; const float* Uu = (const float*)(P.ws + WS_AU_U) + rbase * 2048 + ch;
    LAS float* sA = (LAS float*)lds; LAS float* sH = sA + 512;
    float p1 = 1.f, h1 = 0.f, p2 = 1.f, h2 = 0.f;
#pragma unroll 16
    for (int t = 0; t < 64; ++t) { const float a1 = Aa[(size_t)t * 2048], u1 = Uu[(size_t)t * 2048], a2 = Aa[(size_t)(64 + t) * 2048], u2 = Uu[(size_t)(64 + t) * 2048];
        h1 = a1 * h1 + u1; p1 *= a1; h2 = a2 * h2 + u2; p2 *= a2; }
    sA[seg * 32 + cl] = p1 * p2; sH[seg * 32 + cl] = p2 * h1 + h2;
    __syncthreads();
    float hin = 0.f;
    for (int s = 0; s < seg; ++s) hin = sA[s * 32 + cl] * hin + sH[s * 32 + cl];
    const bf16_t* GATE = (const bf16_t*)(P.ws + WS_PROJ) + rbase * NPROJ + PC_GATE + ch;
    bf16_t* Y = (bf16_t*)(P.ws + WS_YMIX) + rbase * 4096 + 2048 + ch;
    float g1 = hin, g2 = p1 * hin + h1;
#pragma unroll 16
    for (int t = 0; t < 64; ++t) { const float a1 = Aa[(size_t)t * 2048], u1 = Uu[(size_t)t * 2048], a2 = Aa[(size_t)(64 + t) * 2048], u2 = Uu[(size_t)(64 + t) * 2048];
        const float z1 = bf2f(GATE[(size_t)t * NPROJ]), z2 = bf2f(GATE[(size_t)(64 + t) * NPROJ]);
        g1 = a1 * g1 + u1; g2 = a2 * g2 + u2;
        Y[(size_t)t * 4096] = (bf16_t)f2bf(g1 * geluf(z1)); Y[(size_t)(64 + t) * 4096] = (bf16_t)f2bf(g2 * geluf(z2)); }
    const float h = g2;
    if (seg == 15) P.out[O_PL + b * 2048 + ch] = h;
    __syncthreads();
}
DEV void phase4(const Params& P, LAS unsigned char* lds, int tid, int lane, int wave) {
    const int G = gridDim.x, bid = blockIdx.x;
    REP(22) for (int it = bid; it < 256; it += G) lru_scan_item(P, lds, it, tid);
    const int gt = bid * NTHREADS + tid, NGT = G * NTHREADS;
    for (int q = gt; q < 65536; q += NGT) { const int b = q >> 11, ch = q & 2047; float h = P.in[5][q];
        const size_t r0 = (size_t)TP + b * 8;
#pragma unroll
        for (int t = 0; t < 8; ++t) { const float a = ((const float*)(P.ws + WS_B))[(r0 + t) * 2048 + ch], u = ((const float*)(P.ws + WS_AU_U))[(r0 + t) * 2048 + ch]; h = a * h + u;
            ((bf16_t*)(P.ws + WS_YMIX))[(r0 + t) * 4096 + 2048 + ch] = (bf16_t)f2bf(h * geluf(bf2f(((const bf16_t*)(P.ws + WS_PROJ))[(r0 + t) * NPROJ + PC_GATE + ch]))); }
        P.out[O_SL + q] = h; }
    const f32x4* CS4 = (const f32x4*)(P.ws + WS_CS); const float* CDEC = (const float*)(P.ws + WS_CDEC); u32x2* HIN = (u32x2*)(P.ws + WS_HIN);
    REP(23) for (int q = gt; q < 262144; q += NGT) { const int b = q >> 16, rem = q & 65535, hd = rem >> 11, e4 = rem & 2047;
        f32x4 h = (f32x4){0.f, 0.f, 0.f, 0.f};
        f32x4 csv[16]; float decv[16];
#pragma unroll
        for (int c = 0; c < 16; ++c) { const int idx = (b * 16 + c) * 32 + hd; decv[c] = CDEC[idx]; csv[c] = CS4[(size_t)idx * 2048 + e4]; }
#pragma unroll
        for (int c = 0; c < 16; ++c) { const int idx = (b * 16 + c) * 32 + hd;
            u32x2 w; w.x = pk2(h.x, h.y); w.y = pk2(h.z, h.w); HIN[(size_t)idx * 2048 + e4] = w;
            h = h * decv[c] + csv[c]; }
        *(f32x4*)(P.out + O_PSSM + (size_t)(b * 32 + hd) * 8192 + e4 * 4) = h; }
}

DEV void ssd_out_item(const Params& P, LAS unsigned char* lds, int it, int tid, int lane, int wave) {
    const int g = it & 7, c = (it >> 3) & 15, b = it >> 7; const int R0 = b * 2048 + c * 128;
    LAS bf16_t* Cs = (LAS bf16_t*)lds; LAS bf16_t* Bs = (LAS bf16_t*)(lds + 34816); LAS bf16_t* Ms = (LAS bf16_t*)(lds + 69632);
    LAS bf16_t* XT = (LAS bf16_t*)(lds + 104448); LAS bf16_t* Hs = (LAS bf16_t*)(lds + 121856);
    LAS float* acs = (LAS float*)(lds + 139264); LAS float* dts = acs + 512; LAS float* ssq = dts + 512; LAS float* tmp = (LAS float*)Ms;
    const bf16_t* PROJ = (const bf16_t*)(P.ws + WS_PROJ);
    ssd_dt_acs(P, acs, dts, tmp, R0, g, tid);
    {
        const int cgb = tid & 15;
#pragma unroll
        for (int mat = 0; mat < 2; ++mat) { const int cidx = 2048 + mat * 1024 + g * 128 + cgb * 8;
            float w[4][8], bias[8]; ldconvw(P.in[14], P.in[15], 4096, cidx, w, bias);
            LAS bf16_t* dstm = mat ? Cs : Bs;
#pragma unroll 4
            for (int i = 0; i < 4; ++i) { const int q = tid + NTHREADS * i, s = q >> 4; float o[8];
                conv8(PROJ, R0 + s, c * 128 + s, PC_XBC + cidx, nullptr, 4096, w, bias, o);
#pragma unroll
                for (int e = 0; e < 8; ++e) o[e] = siluf(o[e]);
                *(LAS u32x4*)(dstm + s * 136 + cgb * 8) = pack8(o); } }
    }
    __syncthreads();
    const int tt = wave >> 1;
    f32x16 cb[2];
#pragma unroll
    for (int j = 0; j < 2; ++j) { const int st = 2 * (wave & 1) + j; cb[j] = zero16();
        if (st <= tt) mma_tile(cb[j], Cs + 32 * tt * 136, 136, Bs + 32 * st * 136, 136, 128, lane); }
    const int pt = wave & 1;
    f32x16 yv[4];
#pragma unroll
    for (int k = 0; k < 4; ++k) yv[k] = zero16();
    for (int hh = 0; hh < 4; ++hh) {
        const int hd = 4 * g + hh;
        int lane_l = lane, tid_l = tid; asm volatile("" : "+v"(lane_l), "+v"(tid_l));
        const int r = lane_l & 31, h = lane_l >> 5;
        const u32x4* hsrc = (const u32x4*)((const bf16_t*)(P.ws + WS_HIN) + ((size_t)((b * 16 + c) * 32 + hd)) * 8192);
        const u32x4 hpre0 = hsrc[tid_l], hpre1 = hsrc[tid_l + NTHREADS];
        unsigned short zv[16];
        { const bf16_t* zp = PROJ + (size_t)(R0 + 32 * tt + 4 * h) * NPROJ + hd * 64 + 32 * pt + r;
#pragma unroll
          for (int reg = 0; reg < 16; ++reg) zv[reg] = zp[(size_t)((reg & 3) + 8 * (reg >> 2)) * NPROJ]; }
        __builtin_amdgcn_sched_barrier(0);
#pragma unroll
        for (int j = 0; j < 2; ++j) { const int st = 2 * (wave & 1) + j; const int s = 32 * st + r; const float as = acs[hh * 128 + s], ds = dts[hh * 128 + s];
#pragma unroll
            for (int reg = 0; reg < 16; ++reg) { const int t = 32 * tt + rowmap(reg, h);
                const float v = (s <= t) ? cb[j][reg] * __expf(acs[hh * 128 + t] - as) * ds : 0.f;
                Ms[t * 136 + s] = (bf16_t)f2bf(v); } }
        __builtin_amdgcn_sched_barrier(0);
        {
            const int cgp = tid_l & 7, cidx = hd * 64 + cgp * 8;
            float w[4][8], bias[8]; ldconvw(P.in[14], P.in[15], 4096, cidx, w, bias);
#pragma unroll 2
            for (int i = 0; i < 2; ++i) { const int q = tid_l + NTHREADS * i, s = q >> 3; float o[8];
                conv8(PROJ, R0 + s, c * 128 + s, PC_XBC + cidx, nullptr, 4096, w, bias, o);
#pragma unroll
                for (int e = 0; e < 8; ++e) XT[(cgp * 8 + e) * 136 + s] = (bf16_t)f2bf(siluf(o[e])); }
            { const int q0 = tid_l, q1 = tid_l + NTHREADS; *(LAS u32x4*)(Hs + (q0 >> 4) * 136 + (q0 & 15) * 8) = hpre0; *(LAS u32x4*)(Hs + (q1 >> 4) * 136 + (q1 & 15) * 8) = hpre1; }
        }
        __builtin_amdgcn_sched_barrier(0);
        __syncthreads();
        __builtin_amdgcn_sched_barrier(0);
        f32x16 ad = zero16(), ao = zero16();
        mma_tile(ad, Ms + 32 * tt * 136, 136, XT + 32 * pt * 136, 136, 32 * (tt + 1), lane_l);
        mma_tile(ao, Cs + 32 * tt * 136, 136, Hs + 32 * pt * 136, 136, 128, lane_l);
        const float dsk = P.in[18][hd];
        const int p = 32 * pt + r;
#pragma unroll
        for (int reg = 0; reg < 16; ++reg) { const int t = 32 * tt + rowmap(reg, h);
            float y = ad[reg] + __expf(acs[hh * 128 + t]) * ao[reg] + dsk * bf2f(XT[p * 136 + t]);
            const float z = bf2f(zv[reg]);
            ad[reg] = y * siluf(z); }
#pragma unroll
        for (int k = 0; k < 4; ++k) yv[k] = (hh == k) ? ad : yv[k];
        __syncthreads();
    }
    int lane_m = lane; asm volatile("" : "+v"(lane_m));
    const int r = lane_m & 31, h = lane_m >> 5;
#pragma unroll
    for (int reg = 0; reg < 16; ++reg) { float s = 0.f;
#pragma unroll
        for (int hh = 0; hh < 4; ++hh) s += yv[hh][reg] * yv[hh][reg];
#pragma unroll
        for (int o = 1; o < 32; o <<= 1) s += __shfl_xor(s, o);
        if (r == 0) ssq[pt * 128 + 32 * tt + rowmap(reg, h)] = s; }
    __syncthreads();
    bf16_t* Y = (bf16_t*)(P.ws + WS_YMIX);
#pragma unroll
    for (int reg = 0; reg < 16; ++reg) { const int t = 32 * tt + rowmap(reg, h);
        const float rinv = rsqrtf((ssq[t] + ssq[128 + t]) * (1.f / 256.f) + EPSN);
#pragma unroll
        for (int hh = 0; hh < 4; ++hh) { const int ch = (4 * g + hh) * 64 + 32 * pt + r;
            Y[(size_t)(R0 + t) * 4096 + ch] = (bf16_t)f2bf(yv[hh][reg] * rinv * P.in[19][ch]); } }
    __syncthreads();
}
DEV void ssd_sample_item(const Params& P, LAS unsigned char* lds, int it, int tid, int lane, int wave) {
    const int b = it >> 3, g = it & 7; const int R0 = TP + b * 8;
    LAS float* xs = (LAS float*)lds;
    LAS float* Bv = xs + 2048;
    LAS float* Cv = Bv + 1024;
    LAS float* dtv = Cv + 1024;
    LAS float* yv = dtv + 32;
    const bf16_t* PROJ = (const bf16_t*)(P.ws + WS_PROJ);
    {
        const int cc = tid; const int cidx = cc < 256 ? g * 256 + cc : (cc < 384 ? 2048 + g * 128 + (cc - 256) : 3072 + g * 128 + (cc - 384));
        const float w0 = P.in[14][cidx], w1 = P.in[14][4096 + cidx], w2 = P.in[14][8192 + cidx], w3 = P.in[14][12288 + cidx], bias = P.in[15][cidx];
        const float* hist = P.in[2] + (size_t)b * 3 * 4096 + cidx;
        float x0 = hist[0], x1 = hist[4096], x2 = hist[8192];
        LAS float* dst = cc < 256 ? xs + cc : (cc < 384 ? Bv + (cc - 256) : Cv + (cc - 384)); const int dstride = cc < 256 ? 256 : 128;
#pragma unroll
        for (int t = 0; t < 8; ++t) { const float x3 = bf2f(PROJ[(size_t)(R0 + t) * NPROJ + PC_XBC + cidx]);
            dst[t * dstride] = siluf(bias + w0 * x0 + w1 * x1 + w2 * x2 + w3 * x3); x0 = x1; x1 = x2; x2 = x3; }
        if (tid < 32) { const int hh = tid >> 3, t = tid & 7, hd = 4 * g + hh; dtv[tid] = softplusf(((const float*)(P.ws + WS_DT))[(size_t)(R0 + t) * 32 + hd] + P.in[16][hd]); }
    }
    __syncthreads();
    const int p = tid >> 3, n0 = (tid & 7) * 16;
    for (int hh = 0; hh < 4; ++hh) {
        const int hd = 4 * g + hh; const float a = -__expf(P.in[17][hd]), dsk = P.in[18][hd];
        const size_t sidx = ((size_t)(b * 32 + hd) * 64 + p) * 128 + n0;
        float hst[16];
#pragma unroll
        for (int i = 0; i < 4; ++i) { const f32x4 v = *(const f32x4*)(P.in[3] + sidx + 4 * i); hst[4 * i] = v.x; hst[4 * i + 1] = v.y; hst[4 * i + 2] = v.z; hst[4 * i + 3] = v.w; }
#pragma unroll
        for (int t = 0; t < 8; ++t) { const float dt = dtv[hh * 8 + t], dec = __expf(dt * a), xv = xs[t * 256 + hh * 64 + p], xdt = xv * dt; float yp = 0.f;
#pragma unroll
            for (int i = 0; i < 16; ++i) { hst[i] = hst[i] * dec + xdt * Bv[t * 128 + n0 + i]; yp += Cv[t * 128 + n0 + i] * hst[i]; }
            yp += __shfl_xor(yp, 1); yp += __shfl_xor(yp, 2); yp += __shfl_xor(yp, 4);
            if ((tid & 7) == 0) yv[t * 256 + hh * 64 + p] = yp + dsk * xv; }
#pragma unroll
        for (int i = 0; i < 4; ++i) *(f32x4*)(P.out + O_SSSM + sidx + 4 * i) = (f32x4){hst[4 * i], hst[4 * i + 1], hst[4 * i + 2], hst[4 * i + 3]};
    }
    __syncthreads();
    {
        const int t = wave; float v[4]; float ss = 0.f;
#pragma unroll
        for (int i = 0; i < 4; ++i) { const int ch = lane + 64 * i; const float z = bf2f(PROJ[(size_t)(R0 + t) * NPROJ + g * 256 + ch]); v[i] = yv[t * 256 + ch] * siluf(z); ss += v[i] * v[i]; }
        const float rinv = rsqrtf(wave_sum(ss) * (1.f / 256.f) + EPSN);
#pragma unroll
        for (int i = 0; i < 4; ++i) { const int ch = g * 256 + lane + 64 * i; ((bf16_t*)(P.ws + WS_YMIX))[(size_t)(R0 + t) * 4096 + ch] = (bf16_t)f2bf(v[i] * rinv * P.in[19][ch]); }
    }
    __syncthreads();
}
DEV void phase5(const Params& P, LAS unsigned char* lds, int tid, int lane, int wave) {
    const int G = gridDim.x, bid = blockIdx.x;
    const int gt = bid * NTHREADS + tid, NGT = G * NTHREADS;
#if !defined(ONLY) || ONLY == 5
    for (int it = bid; it < 512; it += G) ssd_out_item(P, lds, it, tid, lane, wave);
#endif
#if !defined(ONLY) || ONLY == 11
    for (int it = bid; it < 256; it += G) ssd_sample_item(P, lds, it, tid, lane, wave);
#endif
}

DEV void rope_stage(const bf16_t* src, const float* ropep  , int c, float scale, LAS bf16_t* dst, float* fout, bool zero) {
    float lo[8], hi[8], o1[8], o2[8];
    if (zero) {
#pragma unroll
        for (int e = 0; e < 8; ++e) { o1[e] = 0.f; o2[e] = 0.f; }
    } else {
        ld8(src + 8 * c, lo); ld8(src + 32 + 8 * c, hi);
        float csA[8], csB[8]; ldf8(ropep + 16 * c, csA); ldf8(ropep + 16 * c + 8, csB);
#pragma unroll
        for (int e = 0; e < 8; ++e) { const float co = e < 4 ? csA[2 * e] : csB[2 * e - 8], si = e < 4 ? csA[2 * e + 1] : csB[2 * e - 7]; o1[e] = (lo[e] * co - hi[e] * si) * scale; o2[e] = (hi[e] * co + lo[e] * si) * scale; }
    }
    *(LAS u32x4*)(dst + 8 * c) = pack8(o1); *(LAS u32x4*)(dst + 32 + 8 * c) = pack8(o2);
    if (fout) {
#pragma unroll
        for (int e = 0; e < 8; ++e) { fout[8 * c + e] = o1[e]; fout[32 + 8 * c + e] = o2[e]; } }
}
DEV void attn_prompt_item(const Params& P, LAS unsigned char* lds, int it, int tid, int lane, int wave) {
    const int hp = it & 1, qb = (it >> 1) & 15, kvh = (it >> 5) & 7, b = it >> 8;
    LAS bf16_t* Ks = (LAS bf16_t*)lds;
    LAS bf16_t* VT = (LAS bf16_t*)(lds + 36864);
    LAS bf16_t* Qs = (LAS bf16_t*)(lds + 70656);
    const bf16_t* QKV = (const bf16_t*)(P.ws + WS_QKV); const float* ROPE = (const float*)(P.ws + WS_ROPE);
    const bool wr_state = (qb == 15 && hp == 0);
    for (int i = 0; i < 2; ++i) { const int q = tid + NTHREADS * i, jj = q >> 2, c = q & 3; const int pos = qb * 128 - 128 + jj; const bool zero = pos < 0;
        const int posc = zero ? 0 : pos;
        float* fo = (wr_state && jj >= 128) ? P.out + O_PK + ((size_t)(b * 128 + (jj - 128)) * 8 + kvh) * 64 : nullptr;
        rope_stage(QKV + (size_t)(b * 2048 + posc) * NQKV + 2048 + kvh * 64, ROPE + (size_t)posc * 64, c, 1.0f, Ks + jj * 72, fo, zero); }
    for (int i = 0; i < 4; ++i) { const int q = tid + NTHREADS * i, jj = q >> 3, c = q & 7; const int pos = qb * 128 - 128 + jj; float v[8];
        if (pos < 0) {
#pragma unroll
            for (int e = 0; e < 8; ++e) v[e] = 0.f;
        } else ld8(QKV + (size_t)(b * 2048 + pos) * NQKV + 2560 + kvh * 64 + 8 * c, v);
#pragma unroll
        for (int e = 0; e < 8; ++e) VT[(8 * c + e) * 264 + jj] = (bf16_t)f2bf(v[e]);
        if (wr_state && jj >= 128) { float* fo = P.out + O_PV + ((size_t)(b * 128 + (jj - 128)) * 8 + kvh) * 64 + 8 * c;
#pragma unroll
            for (int e = 0; e < 8; ++e) fo[e] = v[e]; } }
    for (int i = 0; i < 2; ++i) { const int q = tid + NTHREADS * i, qr = q >> 2, c = q & 3; const int hsel = qr >> 7, qi = qr & 127, head = kvh * 4 + hp * 2 + hsel, pos = qb * 128 + qi;
        rope_stage(QKV + (size_t)(b * 2048 + pos) * NQKV + head * 64, ROPE + (size_t)pos * 64, c, 0.125f, Qs + qr * 72, nullptr, false); }
    __syncthreads();
    const int r = lane & 31, h = lane >> 5;
    const int hsel = wave >> 2, q0 = 32 * (wave & 3), head = kvh * 4 + hp * 2 + hsel;
    f32x16 st[5];
#pragma unroll
    for (int kt = 0; kt < 5; ++kt) { st[kt] = zero16(); mma_tile(st[kt], Ks + (q0 + 32 * kt) * 72, 72, Qs + (hsel * 128 + q0) * 72, 72, 64, lane); }
    const float sink = P.in[30][head];
    float m = sink;
#pragma unroll
    for (int kt = 0; kt < 5; ++kt)
#pragma unroll
        for (int reg = 0; reg < 16; ++reg) { const int dk = 32 * kt + rowmap(reg, h); const bool valid = (dk > r) && (dk <= r + 128);
            st[kt][reg] = valid ? st[kt][reg] : -1e30f; m = fmaxf(m, st[kt][reg]); }
    m = fmaxf(m, __shfl_xor(m, 32));
    float l = 0.f;
#pragma unroll
    for (int kt = 0; kt < 5; ++kt)
#pragma unroll
        for (int reg = 0; reg < 16; ++reg) { const float p = __expf(st[kt][reg] - m); st[kt][reg] = p; l += p; }
    l += __shfl_xor(l, 32);
    l += __expf(sink - m);
    const float linv = 1.f / l;
    bf16_t* O = (bf16_t*)(P.ws + WS_ATTO) + (size_t)(b * 2048 + qb * 128 + q0 + r) * 2048 + head * 64;
#pragma unroll
    for (int dt = 0; dt < 2; ++dt) {
        f32x16 ao = zero16();
#pragma unroll
        for (int kt = 0; kt < 5; ++kt)
#pragma unroll
            for (int s = 0; s < 2; ++s) {
                u32x4 pb; pb.x = pk2(st[kt][8 * s], st[kt][8 * s + 1]); pb.y = pk2(st[kt][8 * s + 2], st[kt][8 * s + 3]); pb.z = pk2(st[kt][8 * s + 4], st[kt][8 * s + 5]); pb.w = pk2(st[kt][8 * s + 6], st[kt][8 * s + 7]);
                const LAS bf16_t* vp = VT + (32 * dt + r) * 264 + q0 + 32 * kt + 16 * s + 4 * h;
                const u32x2 v0 = *(const LAS u32x2*)vp, v1 = *(const LAS u32x2*)(vp + 8);
                u32x4 va; va.x = v0.x; va.y = v0.y; va.z = v1.x; va.w = v1.y;
                ao = __builtin_amdgcn_mfma_f32_32x32x16_bf16(__builtin_bit_cast(bf16x8, va), __builtin_bit_cast(bf16x8, pb), ao, 0, 0, 0);
            }
#pragma unroll
        for (int gq = 0; gq < 4; ++gq) { u32x2 w; w.x = pk2(ao[4 * gq] * linv, ao[4 * gq + 1] * linv); w.y = pk2(ao[4 * gq + 2] * linv, ao[4 * gq + 3] * linv);
            *(u32x2*)(O + 32 * dt + 8 * gq + 4 * h) = w; }
    }
    __syncthreads();
}
DEV void attn_sample_item(const Params& P, LAS unsigned char* lds, int it, int tid, int lane, int wave) {
    const int b = it >> 3, kvh = it & 7;
    LAS float* Kf = (LAS float*)lds;
    LAS float* Vf = Kf + 136 * 65;
    LAS float* Qf = Vf + 136 * 64;
    LAS float* Sc = Qf + 32 * 65;
    const bf16_t* QKV = (const bf16_t*)(P.ws + WS_QKV); const float* ROPE = (const float*)(P.ws + WS_ROPE);
    for (int q = tid; q < 136 * 32; q += NTHREADS) { const int jj = q >> 5, d = q & 31; float k1, k2, v1, v2;
        if (jj < 128) { const size_t o = ((size_t)(b * 128 + jj) * 8 + kvh) * 64; k1 = P.in[6][o + d]; k2 = P.in[6][o + 32 + d]; v1 = P.in[7][o + d]; v2 = P.in[7][o + 32 + d]; }
        else { const int t = jj - 128; const bf16_t* row = QKV + (size_t)(TP + b * 8 + t) * NQKV; const float a = bf2f(row[2048 + kvh * 64 + d]), c2 = bf2f(row[2048 + kvh * 64 + 32 + d]);
            const float co = ROPE[((size_t)(2048 + t) * 32 + d) * 2], si = ROPE[((size_t)(2048 + t) * 32 + d) * 2 + 1];
            k1 = a * co - c2 * si; k2 = c2 * co + a * si; v1 = bf2f(row[2560 + kvh * 64 + d]); v2 = bf2f(row[2560 + kvh * 64 + 32 + d]); }
        Kf[jj * 65 + d] = k1; Kf[jj * 65 + 32 + d] = k2; Vf[jj * 64 + d] = v1; Vf[jj * 64 + 32 + d] = v2;
        if (jj >= 8) { const size_t o = ((size_t)(b * 128 + (jj - 8)) * 8 + kvh) * 64; P.out[O_SK + o + d] = k1; P.out[O_SK + o + 32 + d] = k2; P.out[O_SV + o + d] = v1; P.out[O_SV + o + 32 + d] = v2; } }
    for (int q = tid; q < 32 * 32; q += NTHREADS) { const int qr = q >> 5, d = q & 31, hq = qr >> 3, t = qr & 7, head = kvh * 4 + hq; const bf16_t* row = QKV + (size_t)(TP + b * 8 + t) * NQKV + head * 64;
        const float a = bf2f(row[d]), c2 = bf2f(row[32 + d]); const float co = ROPE[((size_t)(2048 + t) * 32 + d) * 2], si = ROPE[((size_t)(2048 + t) * 32 + d) * 2 + 1];
        Qf[qr * 65 + d] = (a * co - c2 * si) * 0.125f; Qf[qr * 65 + 32 + d] = (c2 * co + a * si) * 0.125f; }
    __syncthreads();
    const int qr = tid >> 4, kl = tid & 15, t = qr & 7, head = kvh * 4 + (qr >> 3);
    const float sink = P.in[30][head];
    float m = sink;
    for (int i = 0; i < 9; ++i) { const int jj = kl + 16 * i; if (jj < 136) { float s = 0.f;
#pragma unroll 16
            for (int d = 0; d < 64; ++d) s += Qf[qr * 65 + d] * Kf[jj * 65 + d];
            const bool valid = jj < 128 ? (jj >= t + 1) : ((jj - 128) <= t);
            s = valid ? s : -1e30f; Sc[qr * 136 + jj] = s; m = fmaxf(m, s); } }
    m = fmaxf(m, __shfl_xor(m, 1)); m = fmaxf(m, __shfl_xor(m, 2)); m = fmaxf(m, __shfl_xor(m, 4)); m = fmaxf(m, __shfl_xor(m, 8));
    float l = 0.f;
    for (int i = 0; i < 9; ++i) { const int jj = kl + 16 * i; if (jj < 136) { const float p = __expf(Sc[qr * 136 + jj] - m); Sc[qr * 136 + jj] = p; l += p; } }
    l += __shfl_xor(l, 1); l += __shfl_xor(l, 2); l += __shfl_xor(l, 4); l += __shfl_xor(l, 8);
    l += __expf(sink - m);
    __syncthreads();
    f32x4 o = (f32x4){0.f, 0.f, 0.f, 0.f};
    for (int jj = 0; jj < 136; ++jj) { const float p = Sc[qr * 136 + jj]; const f32x4 v = *(const LAS f32x4*)(Vf + jj * 64 + 4 * kl); o = o + v * p; }
    const float linv = 1.f / l;
    u32x2 w; w.x = pk2(o.x * linv, o.y * linv); w.y = pk2(o.z * linv, o.w * linv);
    *(u32x2*)((bf16_t*)(P.ws + WS_ATTO) + (size_t)(TP + b * 8 + t) * 2048 + head * 64 + 4 * kl) = w;
    __syncthreads();
}

DEV void gemm_to_mix(const Params& P, LAS unsigned char* lds, const bf16_t* A, const bf16_t* Bt, int K) {
    const int G = gridDim.x, bid = blockIdx.x;
    { pg8::Gemm g{A + (size_t)TP * K, Bt, 256, K, K}; pg8::SplitKOrder S{8, K / 256, 256, G, bid}; pg8::EpiF32 E{(float*)(P.ws + WS_PART), DM, 256}; pg8::gemm_phase(lds, g, S, E); }
    { pg8::Gemm g{A, Bt, K, K, K}; pg8::StaticOrder S; S.init(TP, DM, G, bid); pg8::EpiBf16<3> E{(bf16_t*)(P.ws + WS_MIX), DM, nullptr, nullptr, -1}; pg8::gemm_phase(lds, g, S, E); }
}

__global__ void __launch_bounds__(NTHREADS, 2) hybrid_fwd(Params P) {
    extern __shared__ __attribute__((aligned(16))) unsigned char lds_raw[];
    LAS unsigned char* lds = (LAS unsigned char*)lds_raw;
    cg::grid_group grid = cg::this_grid();
    const int tid0 = threadIdx.x;
    const int G = gridDim.x, bid = blockIdx.x;
    unsigned char* ws = P.ws;
    if (tid0 < 16) ((LAS unsigned*)(lds + 147456))[tid0] = 0u;
    __syncthreads();
    const XcdBarrier bar = xcd_barrier_post((unsigned*)(ws + WS_BAR), (volatile LAS unsigned*)(lds + 147456));
    if (G == 0x7ffffff) grid.sync();
#define GSYNC() xcd_barrier(bar)

#define LAUNDER() int tid = tid0; asm volatile("" : "+v"(tid)); const int lane = tid & 63, wave = __builtin_amdgcn_readfirstlane(tid >> 6)
#ifndef ONLY
#define PH(k) true
#else
#define PH(k) ((k) == ONLY)
#endif
    REP(16) { for (int i_ = 0; i_ < ((DBL) == 16 ? 10 : 0); ++i_) GSYNC(); }
    if (PH(0)) REP(0) { LAUNDER(); phase0(P, lds, tid, lane, wave); }
    GSYNC();
    if (PH(1)) REP(1) { LAUNDER(); norm_phase(P, lds, true, false, 0, 0, 0,   0, 0,   0,   1, 0, lane, wave); }
    GSYNC();
    if (PH(2)) REP(2) {
        pg8::Gemm g{(const bf16_t*)(ws + WS_H), (const bf16_t*)(ws + WS_WIN), DM, DM, DM}; pg8::StaticOrder S; S.init(TT, NPROJ, G, bid);
        pg8::EpiBf16<0> E{(bf16_t*)(ws + WS_PROJ), NPROJ, nullptr, (float*)(ws + WS_DT), 40}; pg8::gemm_phase(lds, g, S, E);
        const int nbusy = (33 * 41) % G;
        if (TAILS && bid >= nbusy) { LAUNDER(); const int widx = (bid - nbusy) * 8 + wave, nw = (G - nbusy) * 8;
            if (G <= 192) transpose_range(P, lds, 5152, 7200, widx, 1, nw, lane, wave);
            transpose_range(P, lds, 9760, 13856, widx, 1, nw, lane, wave); }
    }
    GSYNC();
    if (PH(3)) REP(3) { LAUNDER(); phase3(P, lds, tid, lane, wave); }
    GSYNC();
    if (PH(4)) REP(4) { LAUNDER(); phase4(P, lds, tid, lane, wave); }
    GSYNC();
    if (PH(5) || PH(11)) REP(5) { LAUNDER(); phase5(P, lds, tid, lane, wave); }
    GSYNC();
    if (PH(6)) REP(6) gemm_to_mix(P, lds, (const bf16_t*)(ws + WS_YMIX), (const bf16_t*)(ws + WS_WOH), 4096);
    GSYNC();
    for (int layer = 0; layer < 2; ++layer) {
        if (PH(1)) { LAUNDER(); if (layer == 0) norm_phase(P, lds, false, false, 0, 1, 2, 0, 2, 3, 4, 16, lane, wave, 1.f, true); else norm_phase(P, lds, false, false, 1, 1, 2, 1, 2, 3, 4, 8, lane, wave, 1.f, false); }
        if (DBL == 30) { GSYNC(); LAUNDER(); norm_phase(P, lds, false, false, layer, 1, 2, layer, 2, 3, 4, layer == 0 ? 16 : 8, lane, wave, 0.f, false); }
        GSYNC();
        if (PH(7)) REP(7) {
            pg8::Gemm g{(const bf16_t*)(ws + WS_H), (const bf16_t*)(ws + WS_WUP) + (size_t)layer * DFF * DM, DM, DM, DM}; pg8::StaticOrder S; S.init(TT, DFF, G, bid);
            pg8::EpiBf16<1> E{(bf16_t*)(ws + WS_UP), DFF, nullptr, nullptr, -1}; pg8::gemm_phase(lds, g, S, E);
            const int nbusy = (33 * 32) % G;
            if (TAILS && bid >= nbusy) { LAUNDER(); const int widx = (bid - nbusy) * 8 + wave, nw = (G - nbusy) * 8;
                if (layer == 0) { transpose_range(P, lds, 17952, 22048, widx, 1, nw, lane, wave); transpose_range(P, lds, 7200, 9760, widx, 1, nw, lane, wave); }
                else transpose_range(P, lds, 22048, 26144, widx, 1, nw, lane, wave); }
        }
        GSYNC();
        if (PH(6)) REP(12) gemm_to_mix(P, lds, (const bf16_t*)(ws + WS_UP), (const bf16_t*)(ws + WS_WDN) + (size_t)layer * DM * DFF, DFF);
        GSYNC();
        if (layer == 0) {
            if (PH(1)) { LAUNDER(); norm_phase(P, lds, false, false, 0, 3, 5, 1, 0, 0, 1, 32, lane, wave); }
            if (DBL == 30) { GSYNC(); LAUNDER(); norm_phase(P, lds, false, false, 0, 3, 5, 1, 0, 0, 1, 32, lane, wave, 0.f); }
            GSYNC();
            if (PH(8)) REP(8) {
                pg8::Gemm g{(const bf16_t*)(ws + WS_H), (const bf16_t*)(ws + WS_WQKV), DM, DM, DM}; pg8::StaticOrder S; S.init(TT, NQKV, G, bid);
                pg8::EpiBf16<2> E{(bf16_t*)(ws + WS_QKV), NQKV, P.in[29], nullptr, -1}; pg8::gemm_phase(lds, g, S, E);
                const int nbusy = (33 * 12) % G;
                if (TAILS && bid >= nbusy) { LAUNDER(); const int widx = (bid - nbusy) * 8 + wave, nw = (G - nbusy) * 8;
                    transpose_range(P, lds, 13856, 17952, widx, 1, nw, lane, wave); }
            }
            GSYNC();
            if (PH(9)) REP(9) { LAUNDER(); for (int it = bid; it < 1024; it += G) attn_prompt_item(P, lds, it, tid, lane, wave); }
            if (PH(10)) REP(10) { LAUNDER(); for (int it = bid; it < 256; it += G) attn_sample_item(P, lds, it, tid, lane, wave); }
            GSYNC();
            if (PH(6)) REP(13) gemm_to_mix(P, lds, (const bf16_t*)(ws + WS_ATTO), (const bf16_t*)(ws + WS_WOA), DM);
            GSYNC();
        } else {
            if (PH(1)) { LAUNDER(); norm_phase(P, lds, false, true, 1, 3, 5, 0, 0, 0, 0, 32, lane, wave); }
        }
    }
}

extern "C" void kernel_launch(void* const* d_in, const int* in_sizes, int n_in, void* d_out, int out_size, void* d_ws, size_t ws_size, hipStream_t stream) {
    static int inited = 0;
    if (!inited) { (void)hipFuncSetAttribute((const void*)hybrid_fwd, hipFuncAttributeMaxDynamicSharedMemorySize, LDS_BYTES); inited = 1; }
    (void)hipMemsetAsync((char*)d_ws + WS_BAR, 0, 16384, stream);
    Params p{};
    for (int i = 0; i < 34; ++i) p.in[i] = (const float*)d_in[i];
    p.out = (float*)d_out; p.ws = (unsigned char*)d_ws;
    void* args[] = {&p};
    (void)hipLaunchCooperativeKernel((const void*)hybrid_fwd, dim3(256), dim3(NTHREADS), args, LDS_BYTES, stream);
}
```

```cpp
#include <hip/hip_runtime.h>
#include <hip/hip_cooperative_groups.h>
namespace cg = cooperative_groups;

#define LAS __attribute__((address_space(3)))
#define DEV __device__ __forceinline__
typedef unsigned short bf16_t;
typedef short bf16x8 __attribute__((ext_vector_type(8)));
typedef short bf16x4 __attribute__((ext_vector_type(4)));
typedef float f32x2 __attribute__((ext_vector_type(2)));
typedef float f32x4 __attribute__((ext_vector_type(4)));
typedef float f32x16 __attribute__((ext_vector_type(16)));
typedef unsigned u32x2 __attribute__((ext_vector_type(2)));
typedef unsigned u32x4 __attribute__((ext_vector_type(4)));

constexpr int TP = 8192, TS = 256, TT = TP + TS, DM = 2048, NPROJ = 10496, DFF = 8192, NQKV = 3072;
constexpr int PC_XBC = 2048, PC_GATE = 6144, PC_XR = 8192;
constexpr float EPSN = 1e-6f;
constexpr size_t MiB = 1u << 20;
constexpr size_t WS_CDEC = 0, WS_ROPE = 1 * MiB, WS_MOD = 2 * MiB, WS_WIN = 6 * MiB, WS_WOH = 47 * MiB, WS_WQKV = 63 * MiB, WS_WOA = 75 * MiB, WS_WUP = 83 * MiB,
                 WS_WDN = 147 * MiB, WS_WLRU = 211 * MiB, WS_DT = 213 * MiB, WS_H = 215 * MiB, WS_A = 248 * MiB, WS_B = 418 * MiB, WS_YMIX = 550 * MiB, WS_MIX = 616 * MiB;
constexpr size_t WS_X16 = 682 * MiB;
constexpr size_t WS_PART = WS_B, WS_AU_U = WS_B + 66 * MiB, WS_QKV = WS_B, WS_ATTO = WS_B + 50 * MiB, WS_CS = WS_MIX, WS_HIN = WS_H, WS_PROJ = WS_A, WS_UP = WS_A;
constexpr size_t O_YP = 0, O_YS = O_YP + (size_t)4 * 2048 * 2048, O_PSC = O_YS + 32 * 8 * 2048, O_PSSM = O_PSC + 4 * 3 * 4096, O_PLC = O_PSSM + (size_t)4 * 32 * 64 * 128,
                 O_PL = O_PLC + 4 * 3 * 2048, O_PK = O_PL + 4 * 2048, O_PV = O_PK + 4 * 128 * 8 * 64, O_SSC = O_PV + 4 * 128 * 8 * 64, O_SSSM = O_SSC + 32 * 3 * 4096,
                 O_SLC = O_SSSM + (size_t)32 * 32 * 64 * 128, O_SL = O_SLC + 32 * 3 * 2048, O_SK = O_SL + 32 * 2048, O_SV = O_SK + (size_t)32 * 128 * 8 * 64;
constexpr int LDS_BYTES = 147456 + 64;
constexpr size_t WS_BAR = 65536;
constexpr int NTHREADS = 512;

#ifndef DBL
#define DBL -1
#endif
#ifndef TAILS
#define TAILS 1
#endif
#define REP(k) for (int rep_ = 0; rep_ < ((DBL) == (k) ? 2 : 1); ++rep_, __syncthreads())
struct Params { const float* in[34]; float* out; unsigned char* ws; };

DEV unsigned f2bf(float f) { unsigned u = __float_as_uint(f); return (u + 0x7fffu + ((u >> 16) & 1u)) >> 16; }
DEV unsigned pk2(float lo, float hi) { return f2bf(lo) | (f2bf(hi) << 16); }
DEV float bf2f(unsigned short b) { return __uint_as_float(((unsigned)b) << 16); }
DEV float bflo(unsigned w) { return __uint_as_float(w << 16); }
DEV float bfhi(unsigned w) { return __uint_as_float(w & 0xffff0000u); }
DEV float sigm(float x) { return 1.f / (1.f + __expf(-x)); }
DEV float siluf(float x) { return x * sigm(x); }
DEV float softplusf(float x) { return x > 20.f ? x : log1pf(__expf(x)); }
DEV float geluf(float x) { return x * sigm(1.5957691216057308f * (x + 0.044715f * x * x * x)); }
DEV float wave_sum(float v) {
#pragma unroll
    for (int o = 1; o < 64; o <<= 1) v += __shfl_xor(v, o);
    return v;
}
DEV void ld8(const bf16_t* p, float (&v)[8]) {
    const u32x4 w = *(const u32x4*)p;
    v[0] = bflo(w.x); v[1] = bfhi(w.x); v[2] = bflo(w.y); v[3] = bfhi(w.y); v[4] = bflo(w.z); v[5] = bfhi(w.z); v[6] = bflo(w.w); v[7] = bfhi(w.w);
}
DEV void ldf8(const float* p, float (&v)[8]) {
    const f32x4 a = *(const f32x4*)p, b = *(const f32x4*)(p + 4);
    v[0] = a.x; v[1] = a.y; v[2] = a.z; v[3] = a.w; v[4] = b.x; v[5] = b.y; v[6] = b.z; v[7] = b.w;
}
DEV u32x4 pack8(const float (&v)[8]) { u32x4 w; w.x = pk2(v[0], v[1]); w.y = pk2(v[2], v[3]); w.z = pk2(v[4], v[5]); w.w = pk2(v[6], v[7]); return w; }
DEV int rowmap(int reg, int h) { return (reg & 3) + 8 * (reg >> 2) + 4 * h; }
#define LDS_WAIT() asm volatile("s_waitcnt lgkmcnt(0)" ::: "memory")

DEV void conv8(const bf16_t* PROJ, int r, int tl, int pcol, const float* hist, int C, const float (&w)[4][8], const float (&bias)[8], float (&o)[8]) {
#pragma unroll
    for (int e = 0; e < 8; ++e) o[e] = bias[e];
#pragma unroll
    for (int d = 0; d < 4; ++d) {
        float v[8];
        if (tl - d >= 0) ld8(PROJ + (size_t)(r - d) * NPROJ + pcol, v);
        else if (hist) ldf8(hist + (size_t)(3 + tl - d) * C, v);
        else {
#pragma unroll
            for (int e = 0; e < 8; ++e) v[e] = 0.f;
        }
#pragma unroll
        for (int e = 0; e < 8; ++e) o[e] += w[3 - d][e] * v[e];
    }
}
DEV void ldconvw(const float* W, const float* B, int C, int c0, float (&w)[4][8], float (&bias)[8]) {
#pragma unroll
    for (int j = 0; j < 4; ++j) ldf8(W + (size_t)j * C + c0, w[j]);
    ldf8(B + c0, bias);
}
DEV void mma_tile(f32x16& acc, const LAS bf16_t* A, int lda, const LAS bf16_t* B, int ldb, int K, int lane) {
    const int r = lane & 31, h = lane >> 5;
    const LAS bf16_t* ap = A + r * lda + 8 * h; const LAS bf16_t* bp = B + r * ldb + 8 * h;
    for (int k = 0; k < K; k += 16) {
        const bf16x8 a = *(const LAS bf16x8*)(ap + k); const bf16x8 b = *(const LAS bf16x8*)(bp + k);
        acc = __builtin_amdgcn_mfma_f32_32x32x16_bf16(a, b, acc, 0, 0, 0);
    }
}
DEV f32x16 zero16() { f32x16 z;
#pragma unroll
    for (int i = 0; i < 16; ++i) z[i] = 0.f;
    return z; }

#define XB_TMO      128
#define XB_XCNT(j)  (256  + 64 * (j))
#define XB_XSUB(j)  (1280 + 64 * (j))
#define XB_XGEN(j)  (2304 + 64 * (j))
#define XB_TOP      3328
#define XB_TOPGEN   3392
#define XCD_BAR_WORDS 3456
#define XB_SPIN_CAP (1u << 18)

__device__ __forceinline__ unsigned xb_ld(unsigned* p)              { return __hip_atomic_load(p, __ATOMIC_RELAXED, __HIP_MEMORY_SCOPE_AGENT); }
__device__ __forceinline__ unsigned xb_add(unsigned* p, unsigned v) { return __hip_atomic_fetch_add(p, v, __ATOMIC_RELAXED, __HIP_MEMORY_SCOPE_AGENT); }
__device__ __forceinline__ unsigned xb_xcc_id() { return (unsigned)__builtin_amdgcn_s_getreg((3 << 11) | 20) & 0xFu; }
#define XB_SPIN(cond, bar) do { unsigned _sp = 0; while (cond) { __builtin_amdgcn_s_sleep(1); \
    if ((++_sp & 255u) == 0u) { if (xb_ld(&(bar)[XB_TMO])) break; if (_sp > XB_SPIN_CAP) { atomicAdd(&(bar)[XB_TMO], 1u); break; } } } } while (0)

struct XcdBarrier {
    unsigned* bar; unsigned x;
    volatile LAS unsigned* st;
};

__device__ __forceinline__ XcdBarrier xcd_barrier_post(unsigned* bar, volatile LAS unsigned* st) {
    XcdBarrier b; b.bar = bar; b.x = xb_xcc_id(); b.st = st;
    if (threadIdx.x == 0) (void)xb_add(&bar[XB_XCNT(b.x)], 1u);
    return b;
}
__device__ __forceinline__ void xcd_barrier_complete(unsigned* bar, unsigned x, unsigned& nloc, unsigned& nx) {
    const unsigned G = gridDim.x * gridDim.y * gridDim.z;
    unsigned sum, cnt, mine, sp = 0u;
    for (;;) {
        sum = 0u; cnt = 0u; mine = 0u;
#pragma unroll
        for (unsigned j = 0; j < 16; ++j) { const unsigned c = xb_ld(&bar[XB_XCNT(j)]); sum += c; cnt += (c > 0u) ? 1u : 0u; mine = (j == x) ? c : mine; }
        if (sum == G) break;
        __builtin_amdgcn_s_sleep(1);
        if ((++sp & 255u) == 0u) { if (xb_ld(&bar[XB_TMO])) break; if (sp > XB_SPIN_CAP) { atomicAdd(&bar[XB_TMO], 1u); break; } }
    }
    nloc = mine > 0u ? mine : 1u; nx = cnt > 0u ? cnt : 1u;
}

__device__ __forceinline__ void xcd_barrier(const XcdBarrier& b) {
    asm volatile("s_waitcnt vmcnt(0)" ::: "memory");
    __syncthreads();
    if (threadIdx.x == 0) {
        unsigned* bar = b.bar;
        __builtin_amdgcn_s_waitcnt(0);
        unsigned nloc = b.st[0], nx = b.st[1];
        if (nloc == 0u) { xcd_barrier_complete(bar, b.x, nloc, nx); b.st[0] = nloc; b.st[1] = nx; }
        const unsigned old = xb_add(&bar[XB_XSUB(b.x)], 1u);
        const unsigned gen = old / nloc;
        if (old + 1u == (gen + 1u) * nloc) {
            __builtin_amdgcn_fence(__ATOMIC_RELEASE, "agent");
            asm volatile("s_waitcnt vmcnt(0)" ::: "memory");
            const unsigned og = xb_add(&bar[XB_TOP], 1u);
            const unsigned tg = og / nx;
            if (og + 1u == (tg + 1u) * nx) xb_add(&bar[XB_TOPGEN], 1u);
            else XB_SPIN(xb_ld(&bar[XB_TOPGEN]) == tg, bar);
            __builtin_amdgcn_fence(__ATOMIC_ACQUIRE, "agent");
            xb_add(&bar[XB_XGEN(b.x)], 1u);
            asm volatile("s_waitcnt vmcnt(0)" ::: "memory");
        } else {
            XB_SPIN(xb_ld(&bar[XB_XGEN(b.x)]) == gen, bar);
            __builtin_amdgcn_fence(__ATOMIC_ACQUIRE, "agent");
            asm volatile("s_waitcnt vmcnt(0)" ::: "memory");
        }
    }
    __syncthreads();
}

namespace pg8 {
constexpr int BM = 256, BK = 64, HALF = 128, HTB = HALF * BK * 2, NXCD = 8, WGM = 8;
__host__ __device__ __forceinline__ int lds_byte(int r, int c) { const int st = (r >> 4) * 2 + (c >> 5), rr = r & 15, cc = c & 31, ob = rr * 64 + cc * 2; return st * 1024 + (ob ^ (((ob >> 9) & 1) << 5)); }
__host__ __device__ __forceinline__ void stage_rc(int b, int& R, int& C) { const int st = b / 1024, sb = b % 1024, swz = sb ^ (((sb >> 9) & 1) << 5); R = (st >> 1) * 16 + swz / 64; C = (st & 1) * 32 + (swz % 64) / 2; }
__host__ __device__ __forceinline__ int perm32(int rho) { const int n = rho >> 4, i = rho & 15; return 8 * (i >> 2) + 4 * n + (i & 3); }
struct Unit { int pm, pn, k0; };
struct Gemm { const bf16_t* A; const bf16_t* Bt; int K, lda, ldb; };
struct StaticOrder {
    int nM, nN, nwg, G, c;
    __device__ void init(int M, int N, int G_, int c_) { nM = M / BM; nN = N / BM; nwg = nM * nN; G = G_; c = c_; }
    __device__ bool next(int i, Unit& u) const {
        const long L = (long)i * G + c; if (L >= nwg) return false;
        int wgid = (int)L; { const int q = nwg / NXCD, r = nwg % NXCD, xcd = wgid % NXCD, off = wgid / NXCD; wgid = (xcd < r ? xcd * (q + 1) : r * (q + 1) + (xcd - r) * q) + off; }
        const int nig = WGM * nN, gid = wgid / nig, fm = gid * WGM, gsz = (nM - fm) < WGM ? (nM - fm) : WGM;
        u.pm = fm + ((wgid % nig) % gsz); u.pn = (wgid % nig) / gsz; u.k0 = 0; return true;
    }
};
struct SplitKOrder {
    int nN, nsplit, Kc, G, c;
    __device__ bool next(int i, Unit& u) const { const long L = (long)i * G + c; if (L >= (long)nN * nsplit) return false; u.pm = 0; u.pn = (int)(L % nN); u.k0 = (int)(L / nN) * Kc; return true; }
};
DEV unsigned cvt_pk_bf16(float lo, float hi) { unsigned r; asm volatile("v_cvt_pk_bf16_f32 %0, %1, %2" : "=v"(r) : "v"(lo), "v"(hi)); return r; }

struct EpiF32 {
    static constexpr bool PERM = false;
    float* C; int ldc; int kc;
    DEV void operator()(const f32x4 (&acc)[2][2][4][2], const Unit& u, int wr, int wc, int fr, int fq) const {
        float* Cb = C + (kc > 0 ? (size_t)(u.k0 / kc) * 256 * ldc : (size_t)0);
        const unsigned base = (unsigned)((u.pm * BM + wr * 64 + fr) * ldc + u.pn * BM + wc * 32 + 4 * fq);
#pragma unroll
        for (int ai = 0; ai < 2; ++ai)
#pragma unroll
            for (int m = 0; m < 4; ++m) { const unsigned o = base + (unsigned)((ai * HALF + m * 16) * ldc);
#pragma unroll
                for (int bj = 0; bj < 2; ++bj)
#pragma unroll
                    for (int n = 0; n < 2; ++n) *(f32x4*)(Cb + o + bj * HALF + n * 16) = acc[ai][bj][m][n];
                asm volatile("" ::: "memory"); }
    }
};
template <int MODE  > struct EpiBf16 {
    static constexpr bool PERM = true;
    bf16_t* O; int ldc; const float* bias; float* DT; int dt_pn;
    DEV void operator()(const f32x4 (&acc)[2][2][4][2], const Unit& u, int wr, int wc, int fr, int fq) const {
        const int row0 = u.pm * BM + wr * 64 + fr; const int col0 = u.pn * BM + wc * 32 + 8 * fq;
        if (MODE == 0 && u.pn == dt_pn) {
            if (wc == 0) {
#pragma unroll
                for (int ai = 0; ai < 2; ++ai)
#pragma unroll
                    for (int m = 0; m < 4; ++m) { float* rowp = DT + (size_t)(row0 + ai * HALF + m * 16) * 32 + 8 * fq;
                        *(f32x4*)(rowp) = acc[ai][0][m][0]; *(f32x4*)(rowp + 4) = acc[ai][0][m][1]; }
            }
            return;
        }
        f32x4 bv[2][2];
#pragma unroll
        for (int bj = 0; bj < 2; ++bj)
#pragma unroll
            for (int n = 0; n < 2; ++n) bv[bj][n] = (MODE == 2) ? *(const f32x4*)(bias + col0 + bj * HALF + 4 * n) : (f32x4){0.f, 0.f, 0.f, 0.f};
#pragma unroll
        for (int ai = 0; ai < 2; ++ai)
#pragma unroll
            for (int m = 0; m < 4; ++m) { bf16_t* rowp = O + (size_t)(row0 + ai * HALF + m * 16) * ldc + col0;
#pragma unroll
                for (int bj = 0; bj < 2; ++bj) { f32x4 v0 = acc[ai][bj][m][0] + bv[bj][0], v1 = acc[ai][bj][m][1] + bv[bj][1];
                    if (MODE == 1) {
#pragma unroll
                        for (int j = 0; j < 4; ++j) { const float a = fmaxf(v0[j], 0.f), b = fmaxf(v1[j], 0.f); v0[j] = a * a; v1[j] = b * b; } }
                    u32x4 w; w.x = cvt_pk_bf16(v0[0], v0[1]); w.y = cvt_pk_bf16(v0[2], v0[3]); w.z = cvt_pk_bf16(v1[0], v1[1]); w.w = cvt_pk_bf16(v1[2], v1[3]);
                    *(u32x4*)(rowp + bj * HALF) = w; } }
    }
};

template <class Epi, class Sched>
DEV void gemm_phase(LAS unsigned char* lds, const Gemm g, const Sched& S, const Epi& E) {
    int tid_l = threadIdx.x; asm volatile("" : "+v"(tid_l));
    const int tid = tid_l, wid = __builtin_amdgcn_readfirstlane(tid >> 6), lane = tid & 63, wr = wid >> 2, wc = wid & 3, fr = lane & 15, fq = lane >> 4;
    const int nt = g.K / BK;
    unsigned voffA[2], voffB[2];
#pragma unroll
    for (int i = 0; i < 2; ++i) { int R, C; stage_rc(tid * 16 + i * 8192, R, C); const int Rb = Epi::PERM ? ((R & ~31) + perm32(R & 31)) : R;
        voffA[i] = (unsigned)(R * g.lda + C) * 2u; voffB[i] = (unsigned)(Rb * g.ldb + C) * 2u; }
    const size_t kstep = (size_t)(BK * 2);
    const size_t hsA = (size_t)HALF * g.lda * 2, hsB = (size_t)HALF * g.ldb * 2;
    const size_t tsA = 2 * hsA, tsB = 2 * hsB;
    const unsigned ldsw = (unsigned)wid * 1024u;
    const int aoff = lds_byte(wr * 64 + fr, fq * 8), boff = lds_byte(wc * 32 + fr, fq * 8);
#define PG8_SA(b, h) (((b) * 2 + (h)) * HTB)
#define PG8_SB(b, h) ((4 + (b) * 2 + (h)) * HTB)
#define PG8_STAGE(bufoff, gbase, voff) do { _Pragma("unroll") for (int _i = 0; _i < 2; ++_i) \
        __builtin_amdgcn_global_load_lds((const unsigned*)((const char*)(gbase) + (voff)[_i]), (LAS unsigned*)(lds + (bufoff) + ldsw + _i * 8192), 16, 0, 0); } while (0)
#define PG8_LDA(dst, b, h) do { _Pragma("unroll") for (int m = 0; m < 4; ++m) _Pragma("unroll") for (int k = 0; k < 2; ++k) dst[m][k] = *(const LAS bf16x8*)(lds + PG8_SA(b, h) + aoff + m * 2048 + k * 1024); } while (0)
#define PG8_LDB(dst, b, h) do { _Pragma("unroll") for (int n = 0; n < 2; ++n) _Pragma("unroll") for (int k = 0; k < 2; ++k) dst[n][k] = *(const LAS bf16x8*)(lds + PG8_SB(b, h) + boff + n * 2048 + k * 1024); } while (0)
#define PG8_MMA(ai, bj, At, Bt) do { __builtin_amdgcn_s_setprio(1); _Pragma("unroll") for (int m = 0; m < 4; ++m) _Pragma("unroll") for (int n = 0; n < 2; ++n) _Pragma("unroll") for (int k = 0; k < 2; ++k) \
        acc[ai][bj][m][n] = __builtin_amdgcn_mfma_f32_16x16x32_bf16(Bt[n][k], At[m][k], acc[ai][bj][m][n], 0, 0, 0); __builtin_amdgcn_s_setprio(0); } while (0)
#define PG8_WAIT_V(n) asm volatile("s_waitcnt vmcnt(" #n ")" ::: "memory")
#define PG8_WAIT_L(n) asm volatile("s_waitcnt lgkmcnt(" #n ")" ::: "memory")
#define PG8_BAR __builtin_amdgcn_s_barrier()
#define PG8_SCHED __builtin_amdgcn_sched_barrier(0)
    Unit cur, nxt; int ui = 0;
    if (!S.next(0, cur)) return;
    f32x4 acc[2][2][4][2];
#pragma unroll
    for (int a = 0; a < 2; ++a)
#pragma unroll
        for (int b = 0; b < 2; ++b)
#pragma unroll
            for (int m = 0; m < 4; ++m)
#pragma unroll
                for (int n = 0; n < 2; ++n) acc[a][b][m][n] = (f32x4){0.f, 0.f, 0.f, 0.f};
    bf16x8 At[4][2], B0[2][2], B1[2][2];
    const char* cA = (const char*)g.A + (size_t)cur.pm * tsA + (size_t)cur.k0 * 2; const char* cB = (const char*)g.Bt + (size_t)cur.pn * tsB + (size_t)cur.k0 * 2;
    PG8_STAGE(PG8_SB(0, 0), cB, voffB); PG8_STAGE(PG8_SA(0, 0), cA, voffA); PG8_STAGE(PG8_SB(0, 1), cB + hsB, voffB); PG8_STAGE(PG8_SA(0, 1), cA + hsA, voffA);
    if (wr == 1) PG8_BAR;
    PG8_WAIT_V(4); PG8_BAR;
    PG8_STAGE(PG8_SB(1, 0), cB + kstep, voffB); PG8_STAGE(PG8_SA(1, 0), cA + kstep, voffA); PG8_STAGE(PG8_SB(1, 1), cB + hsB + kstep, voffB);
    PG8_WAIT_V(6); PG8_BAR;
    for (;;) {
        const bool has_next = S.next(ui + 1, nxt);
        const char* nA = has_next ? (const char*)g.A + (size_t)nxt.pm * tsA + (size_t)nxt.k0 * 2 : cA; const char* nB = has_next ? (const char*)g.Bt + (size_t)nxt.pn * tsB + (size_t)nxt.k0 * 2 : cB;
        for (int t = 0; t < nt; t += 2) {
            const bool last = (t == nt - 2);
            const char* a1 = cA + (size_t)(t + 1) * kstep;
            const char* a2 = last ? nA : cA + (size_t)(t + 2) * kstep; const char* b2 = last ? nB : cB + (size_t)(t + 2) * kstep;
            const char* a3 = a2 + kstep; const char* b3 = b2 + kstep;
            PG8_LDB(B0, 0, 0); PG8_SCHED; PG8_LDA(At, 0, 0); PG8_STAGE(PG8_SA(1, 1), a1 + hsA, voffA);
            PG8_WAIT_L(8); PG8_BAR; PG8_WAIT_L(0); PG8_MMA(0, 0, At, B0); PG8_BAR; PG8_SCHED;
            PG8_LDB(B1, 0, 1); PG8_STAGE(PG8_SB(0, 0), b2, voffB);
            PG8_BAR; PG8_WAIT_L(0); PG8_MMA(0, 1, At, B1); PG8_BAR;
            PG8_LDA(At, 0, 1); PG8_STAGE(PG8_SA(0, 0), a2, voffA);
            PG8_BAR; PG8_WAIT_L(0); PG8_MMA(1, 0, At, B0); PG8_BAR; PG8_SCHED;
            PG8_STAGE(PG8_SB(0, 1), b2 + hsB, voffB);
            PG8_WAIT_V(6); PG8_BAR; PG8_MMA(1, 1, At, B1); PG8_BAR;
            PG8_LDB(B0, 1, 0); PG8_SCHED; PG8_LDA(At, 1, 0); PG8_STAGE(PG8_SA(0, 1), a2 + hsA, voffA);
            PG8_WAIT_L(8); PG8_BAR; PG8_WAIT_L(0); PG8_MMA(0, 0, At, B0); PG8_BAR; PG8_SCHED;
            PG8_LDB(B1, 1, 1); PG8_STAGE(PG8_SB(1, 0), b3, voffB);
            PG8_BAR; PG8_WAIT_L(0); PG8_MMA(0, 1, At, B1); PG8_BAR;
            PG8_LDA(At, 1, 1); PG8_STAGE(PG8_SA(1, 0), a3, voffA);
            PG8_BAR; PG8_WAIT_L(0); PG8_MMA(1, 0, At, B0); PG8_BAR; PG8_SCHED;
            PG8_STAGE(PG8_SB(1, 1), b3 + hsB, voffB);
            PG8_WAIT_V(6); PG8_BAR; PG8_MMA(1, 1, At, B1); PG8_BAR;
        }
        E(acc, cur, wr, wc, fr, fq);
        if (!has_next) break;
#pragma unroll
        for (int a = 0; a < 2; ++a)
#pragma unroll
            for (int b = 0; b < 2; ++b)
#pragma unroll
                for (int m = 0; m < 4; ++m)
#pragma unroll
                    for (int n = 0; n < 2; ++n) acc[a][b][m][n] = (f32x4){0.f, 0.f, 0.f, 0.f};
        cur = nxt; cA = nA; cB = nB; ++ui;
    }
    PG8_WAIT_V(0);
    if (wr == 0) PG8_BAR;
    PG8_BAR;
#undef PG8_SA
#undef PG8_SB
#undef PG8_STAGE
#undef PG8_LDA
#undef PG8_LDB
#undef PG8_MMA
#undef PG8_WAIT_V
#undef PG8_WAIT_L
#undef PG8_BAR
#undef PG8_SCHED
}
}

DEV void mod_item(const Params& P, LAS unsigned char* lds, int item, int tid, int lane, int wave) {
    const int colg = item * 128, layer = colg / 12288, n0 = colg % 12288;
    LAS float* cs = (LAS float*)(lds + wave * 9216);
    LAS float* red = (LAS float*)(lds + 73728);
    float acc[36][2];
#pragma unroll
    for (int s = 0; s < 36; ++s) { acc[s][0] = 0.f; acc[s][1] = 0.f; }
#define MOD_LOADW(dst, kq) do { const float* wr_ = Wu + (size_t)(kq) * 12288; _Pragma("unroll") for (int j_ = 0; j_ < 16; ++j_) dst[j_] = *(const f32x2*)(wr_ + (size_t)j_ * 12288 + voff); } while (0)
#define MOD_COMP(wv, koff) do { _Pragma("unroll") for (int j4_ = 0; j4_ < 4; ++j4_) { _Pragma("unroll") for (int sg = 0; sg < 4; ++sg) { \
        _Pragma("unroll") for (int s = 9 * sg; s < 9 * sg + 9; ++s) { const f32x4 c = *(const LAS f32x4*)(cs + s * 64 + (koff) + 4 * j4_); \
            acc[s][0] += c.x * wv[4 * j4_].x + c.y * wv[4 * j4_ + 1].x + c.z * wv[4 * j4_ + 2].x + c.w * wv[4 * j4_ + 3].x; \
            acc[s][1] += c.x * wv[4 * j4_].y + c.y * wv[4 * j4_ + 1].y + c.z * wv[4 * j4_ + 2].y + c.w * wv[4 * j4_ + 3].y; } \
        _Pragma("unroll") for (int s = 9 * sg; s < 9 * sg + 9; ++s) asm volatile("" : "+v"(acc[s][0]), "+v"(acc[s][1]) :: "memory"); } } } while (0)
    const float* Wu = P.in[10] + (size_t)layer * 2048 * 12288 + n0; const unsigned voff = 2u * (unsigned)lane;
    f32x2 wa[16], wb[16];
    MOD_LOADW(wa, wave * 256);
#pragma nounroll
    for (int sub = 0; sub < 4; ++sub) {
        const int kb = wave * 256 + sub * 64;
#pragma unroll 4
        for (int i = 0; i < 36; ++i) { const float v = (i < 4) ? P.in[8][i * 2048 + kb + lane] : P.in[9][(i - 4) * 2048 + kb + lane]; cs[i * 64 + lane] = siluf(v); }
        LDS_WAIT();
#pragma nounroll
        for (int g2 = 0; g2 < 2; ++g2) {
            MOD_LOADW(wb, kb + 32 * g2 + 16); MOD_COMP(wa, 32 * g2);
            if (kb + 32 * g2 + 32 < 2048) MOD_LOADW(wa, kb + 32 * g2 + 32);
            MOD_COMP(wb, 32 * g2 + 16);
        }
        LDS_WAIT();
    }
#undef MOD_LOADW
#undef MOD_COMP
    __syncthreads();
    float* MOD = (float*)(P.ws + WS_MOD);
#pragma unroll
    for (int half = 0; half < 2; ++half) {
#pragma unroll
        for (int s = 0; s < 18; ++s) *(LAS f32x2*)(red + (wave * 18 + s) * 128 + 2 * lane) = (f32x2){acc[18 * half + s][0], acc[18 * half + s][1]};
        __syncthreads();
        for (int o = tid; o < 18 * 128; o += NTHREADS) { const int s = o >> 7, c = o & 127; float v = 0.f;
#pragma unroll
            for (int w = 0; w < 8; ++w) v += red[(w * 18 + s) * 128 + c];
            MOD[(size_t)(layer * 36 + 18 * half + s) * 12288 + n0 + c] = v + P.in[11][layer * 12288 + n0 + c]; }
        __syncthreads();
    }
}
DEV void transpose_item(const float* W, int ldw, int k0, int n0, int ncols, bf16_t* WT, int ldt, int drow0, LAS float* scr, int lane) {
    if (lane < ncols) {
        float v[64];
        const float* wp = W + (size_t)k0 * ldw + n0 + lane;
#pragma unroll
        for (int kk = 0; kk < 64; ++kk) v[kk] = __builtin_nontemporal_load(wp + (size_t)kk * ldw);
#pragma unroll
        for (int kk = 0; kk < 64; ++kk) scr[kk * 65 + lane] = v[kk];
    }
    LDS_WAIT();
    const int c = lane & 7;
#pragma unroll
    for (int j = 0; j < 8; ++j) { const int n = (lane >> 3) + 8 * j;
        if (n < ncols) { const LAS float* s = scr + (8 * c) * 65 + n;
            u32x4 o; o.x = pk2(s[0], s[65]); o.y = pk2(s[2 * 65], s[3 * 65]); o.z = pk2(s[4 * 65], s[5 * 65]); o.w = pk2(s[6 * 65], s[7 * 65]);
            *(u32x4*)(WT + (size_t)(drow0 + n) * ldt + k0 + 8 * c) = o; } }
    LDS_WAIT();
}
DEV void transpose_range(const Params& P, LAS unsigned char* lds, int lo, int hi, int slot0, int myslots, int nslots, int lane, int wave) {
    unsigned char* ws = P.ws; bf16_t* WIN = (bf16_t*)(ws + WS_WIN);
    LAS float* scr = (LAS float*)(lds + wave * 16640);
    for (int sl = 0; sl < myslots; ++sl)
    for (int it = lo + slot0 + sl; it < hi; it += nslots) {
        int r = it;
        if (r < 3072) { const int kb = r / 96, nb = r % 96; transpose_item(P.in[13], 10272, kb * 64, nb * 64, 64, WIN, 2048, nb * 64, scr, lane); continue; } r -= 3072;
        if (r < 2048) { const int kb = r / 64, nb = r % 64; transpose_item(P.in[13], 10272, kb * 64, 6176 + nb * 64, 64, WIN, 2048, 6144 + nb * 64, scr, lane); continue; } r -= 2048;
        if (r < 32) { transpose_item(P.in[13], 10272, r * 64, 6144, 32, WIN, 2048, 10240, scr, lane); continue; } r -= 32;
        if (r < 2048) { const int kb = r / 32, nb = r % 32; transpose_item(P.in[27], 2048, kb * 64, nb * 64, 64, (bf16_t*)(ws + WS_WOH), 4096, nb * 64, scr, lane); continue; } r -= 2048;
        if (r < 1536) { const int kb = r / 48, nb = r % 48; transpose_item(P.in[28], 3072, kb * 64, nb * 64, 64, (bf16_t*)(ws + WS_WQKV), 2048, nb * 64, scr, lane); continue; } r -= 1536;
        if (r < 1024) { const int kb = r / 32, nb = r % 32; transpose_item(P.in[31], 2048, kb * 64, nb * 64, 64, (bf16_t*)(ws + WS_WOA), 2048, nb * 64, scr, lane); continue; } r -= 1024;
        if (r < 8192) { const int l = r / 4096; r %= 4096; const int kb = r / 128, nb = r % 128;
            transpose_item(P.in[32] + (size_t)l * 2048 * 8192, 8192, kb * 64, nb * 64, 64, (bf16_t*)(ws + WS_WUP) + (size_t)l * 8192 * 2048, 2048, nb * 64, scr, lane); continue; } r -= 8192;
        if (r < 8192) { const int l = r / 4096; r %= 4096; const int kb = r / 32, nb = r % 32;
            transpose_item(P.in[33] + (size_t)l * 8192 * 2048, 2048, kb * 64, nb * 64, 64, (bf16_t*)(ws + WS_WDN) + (size_t)l * 2048 * 8192, 8192, nb * 64, scr, lane); continue; } r -= 8192;
        { const int mat = r / 128; r %= 128; const int blk = r / 16; r %= 16; const int kb = r / 4, nb = r % 4;
            transpose_item((mat ? P.in[24] : P.in[22]) + (size_t)blk * 65536, 256, kb * 64, nb * 64, 64, (bf16_t*)(ws + WS_WLRU) + (size_t)mat * 8 * 65536 + (size_t)blk * 65536, 256, nb * 64, scr, lane); }
    }
}
DEV void phase0(const Params& P, LAS unsigned char* lds, int tid, int lane, int wave) {
    const int G = gridDim.x, bid = blockIdx.x;
    unsigned char* ws = P.ws;
    REP(20) for (int it = bid; it < 192; it += G) mod_item(P, lds, it, tid, lane, wave);
    __syncthreads();
    bf16_t* WIN = (bf16_t*)(ws + WS_WIN);
    REP(21) {
    const int nmod = G > 192 ? 192 : G, nslots = (G - nmod) * 8 * 9 + nmod * 8;
    const int myslots = bid >= nmod ? 9 : 1, slot0 = bid >= nmod ? 9 * ((bid - nmod) * 8 + wave) : (G - nmod) * 72 + (bid * 8 + wave);
#if TAILS
    transpose_range(P, lds, 0, 5152, slot0, myslots, nslots, lane, wave);
    transpose_range(P, lds, 26144, 26400, bid * 8 + wave, 1, G * 8, lane, wave);
    if (G > 192 && bid >= nmod) transpose_range(P, lds, 5152, 7200, (bid - nmod) * 8 + wave, 1, (G - nmod) * 8, lane, wave);
#else
    { const int ns2 = (G - nmod) * 8 * 3 + nmod * 8 * 2, my2 = bid >= nmod ? 3 : 2, s02 = bid >= nmod ? 3 * ((bid - nmod) * 8 + wave) : (G - nmod) * 24 + 2 * (bid * 8 + wave);
      transpose_range(P, lds, 0, 26400, s02, my2, ns2, lane, wave); }
#endif
    }
    const int gt = bid * NTHREADS + tid, NGT = G * NTHREADS;
    for (int q = gt; q < 57344; q += NGT) *((u32x4*)(WIN + (size_t)10272 * 2048) + q) = (u32x4){0u, 0u, 0u, 0u};
    float* ROPE = (float*)(ws + WS_ROPE);
    for (int q = gt; q < 2056 * 32; q += NGT) {
        const int pi = q >> 5, i = q & 31; const int pos = pi < 2048 ? pi : 16384 + (pi - 2048);
        const float invf = powf(10000.0f, -(float)i / 32.0f);
        const float ang = (float)pos * invf;
        const double a = (double)ang; const double n = rint(a * 0.15915494309189535); const float rr = (float)(a - n * 6.283185307179586);
        ROPE[2 * q] = cosf(rr); ROPE[2 * q + 1] = sinf(rr);
    }
}

DEV void norm_phase(const Params& P, LAS unsigned char* lds, bool first, bool last, int l_post, int gpost_idx, int gate_j, int l_pre, int gpre_idx, int sh_j, int sc_j, int nsplit, int lane, int wave, float gscale = 1.f, bool xin = false) {
    const int G = gridDim.x; const int gw = blockIdx.x * 8 + wave, NGW = G * 8;
    float* X = P.out; bf16_t* X16 = (bf16_t*)(P.ws + WS_X16); const bf16_t* MIXB = (const bf16_t*)(P.ws + WS_MIX); bf16_t* H = (bf16_t*)(P.ws + WS_H); const float* MOD = (const float*)(P.ws + WS_MOD);
    const float* gpo = P.in[12] + (size_t)(l_post * 4 + gpost_idx) * DM; const float* gpr = P.in[12] + (size_t)(l_pre * 4 + gpre_idx) * DM;
    const int nrows = first ? TT : TP;
    if (!first) {
    LAS float* red = (LAS float*)lds;
    for (int rs = blockIdx.x; rs < TS; rs += G) {
        const int rr = TP + rs, seq = 4 + (rs >> 3), col = 256 * wave + 4 * lane;
        const float* pp = (const float*)(P.ws + WS_PART) + (size_t)rs * DM + col;
        f32x4 mv = (f32x4){0.f, 0.f, 0.f, 0.f};
#pragma unroll 8
        for (int ks = 0; ks < nsplit; ++ks) mv = mv + *(const f32x4*)(pp + (size_t)ks * 256 * DM);
        f32x4 xv;
        if (xin) xv = *(const f32x4*)(P.in[1] + (size_t)rs * DM + col); else { const u32x2 xw = *(const u32x2*)(X16 + (size_t)rr * DM + col); xv = (f32x4){bflo(xw.x), bfhi(xw.x), bflo(xw.y), bfhi(xw.y)}; }
        const float s1 = wave_sum(mv.x * mv.x + mv.y * mv.y + mv.z * mv.z + mv.w * mv.w);
        if (lane == 0) red[wave] = s1;
        __syncthreads();
        float tot = 0.f;
#pragma unroll
        for (int w = 0; w < 8; ++w) tot += red[w];
        const float rinv = rsqrtf(tot * (1.f / DM) + EPSN);
        const f32x4 g = *(const f32x4*)(gpo + col), ga = *(const f32x4*)(MOD + (size_t)(l_post * 36 + seq) * 12288 + gate_j * DM + col);
        xv = xv + ga * gscale * (mv * rinv * g);
        if (last) *(f32x4*)(X + (size_t)rr * DM + col) = xv; else { u32x2 xw; xw.x = pk2(xv.x, xv.y); xw.y = pk2(xv.z, xv.w); *(u32x2*)(X16 + (size_t)rr * DM + col) = xw; }
        if (!last) {
            const float s2 = wave_sum(xv.x * xv.x + xv.y * xv.y + xv.z * xv.z + xv.w * xv.w);
            if (lane == 0) red[8 + wave] = s2;
            __syncthreads();
            float tot2 = 0.f;
#pragma unroll
            for (int w = 0; w < 8; ++w) tot2 += red[8 + w];
            const float rinv2 = rsqrtf(tot2 * (1.f / DM) + EPSN);
            const float* mbp = MOD + (size_t)(l_pre * 36 + seq) * 12288;
            const f32x4 g2 = *(const f32x4*)(gpr + col), sc = *(const f32x4*)(mbp + sc_j * DM + col), sh = *(const f32x4*)(mbp + sh_j * DM + col);
            const f32x4 h = xv * rinv2 * g2 * (sc + 1.f) + sh;
            u32x2 w; w.x = pk2(h.x, h.y); w.y = pk2(h.z, h.w);
            *(u32x2*)(H + (size_t)rr * DM + col) = w;
        }
        __syncthreads();
    }
    }
#define NORM_LOADRAW(XF, XH, MH, rowi) do { const int r_ = (rowi); const float* xs_ = r_ < TP ? P.in[0] + (size_t)r_ * DM : P.in[1] + (size_t)(r_ - TP) * DM; \
        _Pragma("unroll") for (int j = 0; j < 8; ++j) { \
            if (first || xin) XF[j] = *(const f32x4*)(xs_ + 4 * lane + 256 * j); else XH[j] = *(const u32x2*)(X16 + (size_t)r_ * DM + 4 * lane + 256 * j); \
            if (!first) MH[j] = *(const u32x2*)(MIXB + (size_t)r_ * DM + 4 * lane + 256 * j); } } while (0)
#define NORM_COPYRAW(XFd, XHd, MHd, XFs, XHs, MHs) do { _Pragma("unroll") for (int j = 0; j < 8; ++j) { if (first || xin) XFd[j] = XFs[j]; else XHd[j] = XHs[j]; if (!first) MHd[j] = MHs[j]; } } while (0)
    f32x4 xa[8], ma[8];
    f32x4 xfB[8], xfC[8]; u32x2 xhB[8], xhC[8], mhB[8], mhC[8];
    int r = gw;
    if (r < nrows) NORM_LOADRAW(xfB, xhB, mhB, r);
    if (r + NGW < nrows) NORM_LOADRAW(xfC, xhC, mhC, r + NGW); else NORM_COPYRAW(xfC, xhC, mhC, xfB, xhB, mhB);
    for (; r < nrows; r += NGW) {
#pragma unroll
        for (int j = 0; j < 8; ++j) {
            if (first || xin) xa[j] = xfB[j]; else xa[j] = (f32x4){bflo(xhB[j].x), bfhi(xhB[j].x), bflo(xhB[j].y), bfhi(xhB[j].y)};
            if (first) ma[j] = xa[j]; else ma[j] = (f32x4){bflo(mhB[j].x), bfhi(mhB[j].x), bflo(mhB[j].y), bfhi(mhB[j].y)}; }
        NORM_COPYRAW(xfB, xhB, mhB, xfC, xhC, mhC);
        if (r + 2 * NGW < nrows) NORM_LOADRAW(xfC, xhC, mhC, r + 2 * NGW);
        const int seq = r < TP ? (r >> 11) : 4 + ((r - TP) >> 3);
        if (!first) {
            float ss = 0.f;
#pragma unroll
            for (int j = 0; j < 8; ++j) ss += ma[j].x * ma[j].x + ma[j].y * ma[j].y + ma[j].z * ma[j].z + ma[j].w * ma[j].w;
            const float rinv = rsqrtf(wave_sum(ss) * (1.f / DM) + EPSN);
            const float* gt = MOD + (size_t)(l_post * 36 + seq) * 12288 + gate_j * DM;
#pragma unroll
            for (int j = 0; j < 8; ++j) { const f32x4 g = *(const f32x4*)(gpo + 4 * lane + 256 * j), ga = *(const f32x4*)(gt + 4 * lane + 256 * j);
                xa[j] = xa[j] + ga * gscale * (ma[j] * rinv * g);
                if (last) *(f32x4*)(X + (size_t)r * DM + 4 * lane + 256 * j) = xa[j];
                else { u32x2 xw; xw.x = pk2(xa[j].x, xa[j].y); xw.y = pk2(xa[j].z, xa[j].w); *(u32x2*)(X16 + (size_t)r * DM + 4 * lane + 256 * j) = xw; } }
        }
        if (!last) {
            float ss = 0.f;
#pragma unroll
            for (int j = 0; j < 8; ++j) ss += xa[j].x * xa[j].x + xa[j].y * xa[j].y + xa[j].z * xa[j].z + xa[j].w * xa[j].w;
            const float rinv = rsqrtf(wave_sum(ss) * (1.f / DM) + EPSN);
            const float* mbp = MOD + (size_t)(l_pre * 36 + seq) * 12288;
#pragma unroll
            for (int j = 0; j < 8; ++j) { const f32x4 g = *(const f32x4*)(gpr + 4 * lane + 256 * j), sc = *(const f32x4*)(mbp + sc_j * DM + 4 * lane + 256 * j), sh = *(const f32x4*)(mbp + sh_j * DM + 4 * lane + 256 * j);
                const f32x4 h = xa[j] * rinv * g * (sc + 1.f) + sh;
                u32x2 w; w.x = pk2(h.x, h.y); w.y = pk2(h.z, h.w);
                *(u32x2*)(H + (size_t)r * DM + 4 * lane + 256 * j) = w; }
        }
    }
#undef NORM_LOADRAW
#undef NORM_COPYRAW
}

DEV void lru_gate_item(const Params& P, LAS unsigned char* lds, int r0, int nrows  , int kb, int tid, int lane, int wave) {
    LAS bf16_t* XC = (LAS bf16_t*)lds;
    const bf16_t* PROJ = (const bf16_t*)(P.ws + WS_PROJ);
    {
        const int cgp = tid & 31, ch0 = kb * 256 + cgp * 8;
        float w[4][8], bias[8]; ldconvw(P.in[20], P.in[21], 2048, ch0, w, bias);
#pragma unroll 4
        for (int i = 0; i < nrows / 16; ++i) { const int q = tid + NTHREADS * i, row = q >> 5, r = r0 + row; int tl; const float* hist = nullptr;
            if (r < TP) tl = r & 2047; else { const int rs = r - TP; tl = rs & 7; hist = P.in[4] + (size_t)(rs >> 3) * 3 * 2048 + ch0; }
            float o[8]; conv8(PROJ, r, tl, PC_XR + ch0, hist, 2048, w, bias, o);
            *(LAS u32x4*)(XC + row * 264 + cgp * 8) = pack8(o); }
    }
    __syncthreads();
    const int r = lane & 31, h = lane >> 5;
    const int ch = kb * 256 + 32 * wave + r;
    const float ba_ = P.in[23][ch], bx_ = P.in[25][ch], sp = softplusf(-P.in[26][ch]);
    float* Aa = (float*)(P.ws + WS_B); float* Uu = (float*)(P.ws + WS_AU_U);
    const bf16_t* Wa = (const bf16_t*)(P.ws + WS_WLRU) + (size_t)(kb * 256 + 32 * wave + r) * 256 + 8 * h; const bf16_t* Wx = Wa + 8 * 65536;
#pragma nounroll
    for (int mh = 0; mh < nrows / 64; ++mh) {
        f32x16 aa[2], ax[2];
#pragma unroll
        for (int m = 0; m < 2; ++m) { aa[m] = zero16(); ax[m] = zero16(); }
        bf16x8 bA[4], bX[4], nA[4], nX[4];
#pragma unroll
        for (int j = 0; j < 4; ++j) { bA[j] = *(const bf16x8*)(Wa + 16 * j); bX[j] = *(const bf16x8*)(Wx + 16 * j); }
#pragma unroll
        for (int kb4 = 0; kb4 < 4; ++kb4) {
            if (kb4 < 3) {
#pragma unroll
                for (int j = 0; j < 4; ++j) { nA[j] = *(const bf16x8*)(Wa + 64 * (kb4 + 1) + 16 * j); nX[j] = *(const bf16x8*)(Wx + 64 * (kb4 + 1) + 16 * j); } }
#pragma unroll
            for (int j = 0; j < 4; ++j)
#pragma unroll
                for (int m = 0; m < 2; ++m) { const bf16x8 a = *(const LAS bf16x8*)(XC + (64 * mh + 32 * m + r) * 264 + 64 * kb4 + 16 * j + 8 * h);
                    aa[m] = __builtin_amdgcn_mfma_f32_32x32x16_bf16(a, bA[j], aa[m], 0, 0, 0); ax[m] = __builtin_amdgcn_mfma_f32_32x32x16_bf16(a, bX[j], ax[m], 0, 0, 0); }
            if (kb4 < 3) {
#pragma unroll
                for (int j = 0; j < 4; ++j) { bA[j] = nA[j]; bX[j] = nX[j]; } }
        }
#pragma unroll
        for (int m = 0; m < 2; ++m)
#pragma unroll
            for (int reg = 0; reg < 16; ++reg) { const int t = 64 * mh + 32 * m + rowmap(reg, h);
                const float xb = bf2f(XC[t * 264 + 32 * wave + r]);
                const float gr = sigm(aa[m][reg] + ba_), gi = sigm(ax[m][reg] + bx_);
                const float la = -8.0f * gr * sp; const float a = __expf(la); const float mult = sqrtf(fmaxf(-expm1f(2.0f * la), 0.f));
                Aa[(size_t)(r0 + t) * 2048 + ch] = a; Uu[(size_t)(r0 + t) * 2048 + ch] = mult * gi * xb; }
    }
    __syncthreads();
}
DEV void ssd_dt_acs(const Params& P, LAS float* acs, LAS float* dts, LAS float* tmp, int R0, int g, int tid) {
    const int hh = tid >> 7, s = tid & 127, hd = 4 * g + hh;
    const float* DT = (const float*)(P.ws + WS_DT);
    const float dtv = softplusf(DT[(size_t)(R0 + s) * 32 + hd] + P.in[16][hd]);
    const float a = -__expf(P.in[17][hd]);
    tmp[tid] = dtv * a; dts[tid] = dtv;
    __syncthreads();
    float c = 0.f; for (int i = 0; i <= s; ++i) c += tmp[hh * 128 + i];
    acs[tid] = c;
    __syncthreads();
}
DEV void ssd_state_item(const Params& P, LAS unsigned char* lds, int it, int tid, int lane, int wave) {
    const int g = it & 7, c = (it >> 3) & 15, b = it >> 7; const int R0 = b * 2048 + c * 128;
    LAS bf16_t* BT = (LAS bf16_t*)lds;
    LAS bf16_t* XWT = (LAS bf16_t*)(lds + 34816);
    LAS float* acs = (LAS float*)(lds + 52224); LAS float* dts = acs + 512; LAS float* tmp = dts + 512;
    const bf16_t* PROJ = (const bf16_t*)(P.ws + WS_PROJ);
    ssd_dt_acs(P, acs, dts, tmp, R0, g, tid);
    {
        const int cgb = tid & 15, cidx = 2048 + g * 128 + cgb * 8;
        float w[4][8], bias[8]; ldconvw(P.in[14], P.in[15], 4096, cidx, w, bias);
#pragma unroll 4
        for (int i = 0; i < 4; ++i) { const int q = tid + NTHREADS * i, s = q >> 4; float o[8];
            conv8(PROJ, R0 + s, c * 128 + s, PC_XBC + cidx, nullptr, 4096, w, bias, o);
#pragma unroll
            for (int e = 0; e < 8; ++e) BT[(cgb * 8 + e) * 136 + s] = (bf16_t)f2bf(siluf(o[e])); }
    }
    float* CS = (float*)(P.ws + WS_CS); float* CDEC = (float*)(P.ws + WS_CDEC);
    for (int hh = 0; hh < 4; ++hh) {
        const int hd = 4 * g + hh;
        {
            const int cgp = tid & 7, cidx = hd * 64 + cgp * 8;
            float w[4][8], bias[8]; ldconvw(P.in[14], P.in[15], 4096, cidx, w, bias);
            const float alast = acs[hh * 128 + 127];
#pragma unroll 2
            for (int i = 0; i < 2; ++i) { const int q = tid + NTHREADS * i, s = q >> 3; float o[8];
                conv8(PROJ, R0 + s, c * 128 + s, PC_XBC + cidx, nullptr, 4096, w, bias, o);
                const float sc = dts[hh * 128 + s] * __expf(alast - acs[hh * 128 + s]);
#pragma unroll
                for (int e = 0; e < 8; ++e) XWT[(cgp * 8 + e) * 136 + s] = (bf16_t)f2bf(siluf(o[e]) * sc); }
        }
        __syncthreads();
        const int pt = wave >> 2, nt = wave & 3;
        f32x16 acc = zero16();
        mma_tile(acc, XWT + 32 * pt * 136, 136, BT + 32 * nt * 136, 136, 128, lane);
        float* dst = CS + ((size_t)((b * 16 + c) * 32 + hd)) * 8192;
#pragma unroll
        for (int reg = 0; reg < 16; ++reg) dst[(32 * pt + rowmap(reg, lane >> 5)) * 128 + 32 * nt + (lane & 31)] = acc[reg];
        if (tid == 0) CDEC[(b * 16 + c) * 32 + hd] = __expf(acs[hh * 128 + 127]);
        __syncthreads();
    }
}
DEV void phase3(const Params& P, LAS unsigned char* lds, int tid, int lane, int wave) {
    const int G = gridDim.x, bid = blockIdx.x;
    REP(14) { for (int it = bid; it < 512; it += G) lru_gate_item(P, lds, (it >> 3) * 128, 128, it & 7, tid, lane, wave);
              for (int it = bid; it < 32; it += G) lru_gate_item(P, lds, TP + (it >> 3) * 64, 64, it & 7, tid, lane, wave); }
    REP(15) for (int it = bid; it < 512; it += G) ssd_state_item(P, lds, it, tid, lane, wave);
    const bf16_t* PROJ = (const bf16_t*)(P.ws + WS_PROJ);
    const int gt = bid * NTHREADS + tid, NGT = G * NTHREADS;
    for (int q = gt; q < 49152 + 24576 + 393216 + 196608; q += NGT) {
        int r = q;
        if (r < 49152) { const int b = r / 12288, j = (r / 4096) % 3, cc = r % 4096; P.out[O_PSC + r] = bf2f(PROJ[(size_t)(b * 2048 + 2045 + j) * NPROJ + PC_XBC + cc]); continue; } r -= 49152;
        if (r < 24576) { const int b = r / 6144, j = (r / 2048) % 3, cc = r % 2048; P.out[O_PLC + r] = bf2f(PROJ[(size_t)(b * 2048 + 2045 + j) * NPROJ + PC_XR + cc]); continue; } r -= 24576;
        if (r < 393216) { const int b = r / 12288, j = (r / 4096) % 3, cc = r % 4096; P.out[O_SSC + r] = bf2f(PROJ[(size_t)(TP + b * 8 + 5 + j) * NPROJ + PC_XBC + cc]); continue; } r -= 393216;
        { const int b = r / 6144, j = (r / 2048) % 3, cc = r % 2048; P.out[O_SLC + r] = bf2f(PROJ[(size_t)(TP + b * 8 + 5 + j) * NPROJ + PC_XR + cc]); }
    }
}

DEV void lru_scan_item(const Params& P, LAS unsigned char* lds, int it, int tid) {
    const int b = it >> 6, cgp = it & 63, cl = tid & 31, ch = cgp * 32 + cl, seg = tid >> 5;
    const size_t rbase = (size_t)b * 2048 + seg * 128;
    const float* Aa = (const float*)(P.ws + WS_B) + rbase * 2048 + ch; const float* Uu = (const float*)(P.ws + WS_AU_U) + rbase * 2048 + ch;
    LAS float* sA = (LAS float*)lds; LAS float* sH = sA + 512;
    float p1 = 1.f, h1 = 0.f, p2 = 1.f, h2 = 0.f;
#pragma unroll 16
    for (int t = 0; t < 64; ++t) { const float a1 = Aa[(size_t)t * 2048], u1 = Uu[(size_t)t * 2048], a2 = Aa[(size_t)(64 + t) * 2048], u2 = Uu[(size_t)(64 + t) * 2048];
        h1 = a1 * h1 + u1; p1 *= a1; h2 = a2 * h2 + u2; p2 *= a2; }
    sA[seg * 32 + cl] = p1 * p2; sH[seg * 32 + cl] = p2 * h1 + h2;
    __syncthreads();
    float hin = 0.f;
    for (int s = 0; s < seg; ++s) hin = sA[s * 32 + cl] * hin + sH[s * 32 + cl];
    const bf16_t* GATE = (const bf16_t*)(P.ws + WS_PROJ) + rbase * NPROJ + PC_GATE + ch;
    bf16_t* Y = (bf16_t*)(P.ws + WS_YMIX) + rbase * 4096 + 2048 + ch;
    float g1 = hin, g2 = p1 * hin + h1;
#pragma unroll 16
    for (int t = 0; t < 64; ++t) { const float a1 = Aa[(size_t)t * 2048], u1 = Uu[(size_t)t * 2048], a2 = Aa[(size_t)(64 + t) * 2048], u2 = Uu[(size_t)(64 + t) * 2048];
        const float z1 = bf2f(GATE[(size_t)t * NPROJ]), z2 = bf2f(GATE[(size_t)(64 + t) * NPROJ]);
        g1 = a1 * g1 + u1; g2 = a2 * g2 + u2;
        Y[(size_t)t * 4096] = (bf16_t)f2bf(g1 * geluf(z1)); Y[(size_t)(64 + t) * 4096] = (bf16_t)f2bf(g2 * geluf(z2)); }
    const float h = g2;
    if (seg == 15) P.out[O_PL + b * 2048 + ch] = h;
    __syncthreads();
}
DEV void phase4(const Params& P, LAS unsigned char* lds, int tid, int lane, int wave) {
    const int G = gridDim.x, bid = blockIdx.x;
    REP(22) for (int it = bid; it < 256; it += G) lru_scan_item(P, lds, it, tid);
    const int gt = bid * NTHREADS + tid, NGT = G * NTHREADS;
    for (int q = gt; q < 65536; q += NGT) { const int b = q >> 11, ch = q & 2047; float h = P.in[5][q];
        const size_t r0 = (size_t)TP + b * 8;
#pragma unroll
        for (int t = 0; t < 8; ++t) { const float a = ((const float*)(P.ws + WS_B))[(r0 + t) * 2048 + ch], u = ((const float*)(P.ws + WS_AU_U))[(r0 + t) * 2048 + ch]; h = a * h + u;
            ((bf16_t*)(P.ws + WS_YMIX))[(r0 + t) * 4096 + 2048 + ch] = (bf16_t)f2bf(h * geluf(bf2f(((const bf16_t*)(P.ws + WS_PROJ))[(r0 + t) * NPROJ + PC_GATE + ch]))); }
        P.out[O_SL + q] = h; }
    const f32x4* CS4 = (const f32x4*)(P.ws + WS_CS); const float* CDEC = (const float*)(P.ws + WS_CDEC); u32x2* HIN = (u32x2*)(P.ws + WS_HIN);
    REP(23) for (int q = gt; q < 262144; q += NGT) { const int b = q >> 16, rem = q & 65535, hd = rem >> 11, e4 = rem & 2047;
        f32x4 h = (f32x4){0.f, 0.f, 0.f, 0.f};
        f32x4 csv[16]; float decv[16];
#pragma unroll
        for (int c = 0; c < 16; ++c) { const int idx = (b * 16 + c) * 32 + hd; decv[c] = CDEC[idx]; csv[c] = CS4[(size_t)idx * 2048 + e4]; }
#pragma unroll
        for (int c = 0; c < 16; ++c) { const int idx = (b * 16 + c) * 32 + hd;
            u32x2 w; w.x = pk2(h.x, h.y); w.y = pk2(h.z, h.w); HIN[(size_t)idx * 2048 + e4] = w;
            h = h * decv[c] + csv[c]; }
        *(f32x4*)(P.out + O_PSSM + (size_t)(b * 32 + hd) * 8192 + e4 * 4) = h; }
}

DEV void ssd_out_item(const Params& P, LAS unsigned char* lds, int it, int tid, int lane, int wave) {
    const int g = it & 7, c = (it >> 3) & 15, b = it >> 7; const int R0 = b * 2048 + c * 128;
    LAS bf16_t* Cs = (LAS bf16_t*)lds; LAS bf16_t* Bs = (LAS bf16_t*)(lds + 34816); LAS bf16_t* Ms = (LAS bf16_t*)(lds + 69632);
    LAS bf16_t* XT = (LAS bf16_t*)(lds + 104448); LAS bf16_t* Hs = (LAS bf16_t*)(lds + 121856);
    LAS float* acs = (LAS float*)(lds + 139264); LAS float* dts = acs + 512; LAS float* ssq = dts + 512; LAS float* tmp = (LAS float*)Ms;
    const bf16_t* PROJ = (const bf16_t*)(P.ws + WS_PROJ);
    ssd_dt_acs(P, acs, dts, tmp, R0, g, tid);
    {
        const int cgb = tid & 15;
#pragma unroll
        for (int mat = 0; mat < 2; ++mat) { const int cidx = 2048 + mat * 1024 + g * 128 + cgb * 8;
            float w[4][8], bias[8]; ldconvw(P.in[14], P.in[15], 4096, cidx, w, bias);
            LAS bf16_t* dstm = mat ? Cs : Bs;
#pragma unroll 4
            for (int i = 0; i < 4; ++i) { const int q = tid + NTHREADS * i, s = q >> 4; float o[8];
                conv8(PROJ, R0 + s, c * 128 + s, PC_XBC + cidx, nullptr, 4096, w, bias, o);
#pragma unroll
                for (int e = 0; e < 8; ++e) o[e] = siluf(o[e]);
                *(LAS u32x4*)(dstm + s * 136 + cgb * 8) = pack8(o); } }
    }
    __syncthreads();
    const int tt = wave >> 1;
    f32x16 cb[2];
#pragma unroll
    for (int j = 0; j < 2; ++j) { const int st = 2 * (wave & 1) + j; cb[j] = zero16();
        if (st <= tt) mma_tile(cb[j], Cs + 32 * tt * 136, 136, Bs + 32 * st * 136, 136, 128, lane); }
    const int pt = wave & 1;
    f32x16 yv[4];
#pragma unroll
    for (int k = 0; k < 4; ++k) yv[k] = zero16();
    for (int hh = 0; hh < 4; ++hh) {
        const int hd = 4 * g + hh;
        int lane_l = lane, tid_l = tid; asm volatile("" : "+v"(lane_l), "+v"(tid_l));
        const int r = lane_l & 31, h = lane_l >> 5;
        const u32x4* hsrc = (const u32x4*)((const bf16_t*)(P.ws + WS_HIN) + ((size_t)((b * 16 + c) * 32 + hd)) * 8192);
        const u32x4 hpre0 = hsrc[tid_l], hpre1 = hsrc[tid_l + NTHREADS];
        unsigned short zv[16];
        { const bf16_t* zp = PROJ + (size_t)(R0 + 32 * tt + 4 * h) * NPROJ + hd * 64 + 32 * pt + r;
#pragma unroll
          for (int reg = 0; reg < 16; ++reg) zv[reg] = zp[(size_t)((reg & 3) + 8 * (reg >> 2)) * NPROJ]; }
        __builtin_amdgcn_sched_barrier(0);
#pragma unroll
        for (int j = 0; j < 2; ++j) { const int st = 2 * (wave & 1) + j; const int s = 32 * st + r; const float as = acs[hh * 128 + s], ds = dts[hh * 128 + s];
#pragma unroll
            for (int reg = 0; reg < 16; ++reg) { const int t = 32 * tt + rowmap(reg, h);
                const float v = (s <= t) ? cb[j][reg] * __expf(acs[hh * 128 + t] - as) * ds : 0.f;
                Ms[t * 136 + s] = (bf16_t)f2bf(v); } }
        __builtin_amdgcn_sched_barrier(0);
        {
            const int cgp = tid_l & 7, cidx = hd * 64 + cgp * 8;
            float w[4][8], bias[8]; ldconvw(P.in[14], P.in[15], 4096, cidx, w, bias);
#pragma unroll 2
            for (int i = 0; i < 2; ++i) { const int q = tid_l + NTHREADS * i, s = q >> 3; float o[8];
                conv8(PROJ, R0 + s, c * 128 + s, PC_XBC + cidx, nullptr, 4096, w, bias, o);
#pragma unroll
                for (int e = 0; e < 8; ++e) XT[(cgp * 8 + e) * 136 + s] = (bf16_t)f2bf(siluf(o[e])); }
            { const int q0 = tid_l, q1 = tid_l + NTHREADS; *(LAS u32x4*)(Hs + (q0 >> 4) * 136 + (q0 & 15) * 8) = hpre0; *(LAS u32x4*)(Hs + (q1 >> 4) * 136 + (q1 & 15) * 8) = hpre1; }
        }
        __builtin_amdgcn_sched_barrier(0);
        __syncthreads();
        __builtin_amdgcn_sched_barrier(0);
        f32x16 ad = zero16(), ao = zero16();
        mma_tile(ad, Ms + 32 * tt * 136, 136, XT + 32 * pt * 136, 136, 32 * (tt + 1), lane_l);
        mma_tile(ao, Cs + 32 * tt * 136, 136, Hs + 32 * pt * 136, 136, 128, lane_l);
        const float dsk = P.in[18][hd];
        const int p = 32 * pt + r;
#pragma unroll
        for (int reg = 0; reg < 16; ++reg) { const int t = 32 * tt + rowmap(reg, h);
            float y = ad[reg] + __expf(acs[hh * 128 + t]) * ao[reg] + dsk * bf2f(XT[p * 136 + t]);
            const float z = bf2f(zv[reg]);
            ad[reg] = y * siluf(z); }
#pragma unroll
        for (int k = 0; k < 4; ++k) yv[k] = (hh == k) ? ad : yv[k];
        __syncthreads();
    }
    int lane_m = lane; asm volatile("" : "+v"(lane_m));
    const int r = lane_m & 31, h = lane_m >> 5;
#pragma unroll
    for (int reg = 0; reg < 16; ++reg) { float s = 0.f;
#pragma unroll
        for (int hh = 0; hh < 4; ++hh) s += yv[hh][reg] * yv[hh][reg];
#pragma unroll
        for (int o = 1; o < 32; o <<= 1) s += __shfl_xor(s, o);
        if (r == 0) ssq[pt * 128 + 32 * tt + rowmap(reg, h)] = s; }
    __syncthreads();
    bf16_t* Y = (bf16_t*)(P.ws + WS_YMIX);
#pragma unroll
    for (int reg = 0; reg < 16; ++reg) { const int t = 32 * tt + rowmap(reg, h);
        const float rinv = rsqrtf((ssq[t] + ssq[128 + t]) * (1.f / 256.f) + EPSN);
#pragma unroll
        for (int hh = 0; hh < 4; ++hh) { const int ch = (4 * g + hh) * 64 + 32 * pt + r;
            Y[(size_t)(R0 + t) * 4096 + ch] = (bf16_t)f2bf(yv[hh][reg] * rinv * P.in[19][ch]); } }
    __syncthreads();
}
DEV void ssd_sample_item(const Params& P, LAS unsigned char* lds, int it, int tid, int lane, int wave) {
    const int b = it >> 3, g = it & 7; const int R0 = TP + b * 8;
    LAS float* xs = (LAS float*)lds;
    LAS float* Bv = xs + 2048;
    LAS float* Cv = Bv + 1024;
    LAS float* dtv = Cv + 1024;
    LAS float* yv = dtv + 32;
    const bf16_t* PROJ = (const bf16_t*)(P.ws + WS_PROJ);
    {
        const int cc = tid; const int cidx = cc < 256 ? g * 256 + cc : (cc < 384 ? 2048 + g * 128 + (cc - 256) : 3072 + g * 128 + (cc - 384));
        const float w0 = P.in[14][cidx], w1 = P.in[14][4096 + cidx], w2 = P.in[14][8192 + cidx], w3 = P.in[14][12288 + cidx], bias = P.in[15][cidx];
        const float* hist = P.in[2] + (size_t)b * 3 * 4096 + cidx;
        float x0 = hist[0], x1 = hist[4096], x2 = hist[8192];
        LAS float* dst = cc < 256 ? xs + cc : (cc < 384 ? Bv + (cc - 256) : Cv + (cc - 384)); const int dstride = cc < 256 ? 256 : 128;
#pragma unroll
        for (int t = 0; t < 8; ++t) { const float x3 = bf2f(PROJ[(size_t)(R0 + t) * NPROJ + PC_XBC + cidx]);
            dst[t * dstride] = siluf(bias + w0 * x0 + w1 * x1 + w2 * x2 + w3 * x3); x0 = x1; x1 = x2; x2 = x3; }
        if (tid < 32) { const int hh = tid >> 3, t = tid & 7, hd = 4 * g + hh; dtv[tid] = softplusf(((const float*)(P.ws + WS_DT))[(size_t)(R0 + t) * 32 + hd] + P.in[16][hd]); }
    }
    __syncthreads();
    const int p = tid >> 3, n0 = (tid & 7) * 16;
    for (int hh = 0; hh < 4; ++hh) {
        const int hd = 4 * g + hh; const float a = -__expf(P.in[17][hd]), dsk = P.in[18][hd];
        const size_t sidx = ((size_t)(b * 32 + hd) * 64 + p) * 128 + n0;
        float hst[16];
#pragma unroll
        for (int i = 0; i < 4; ++i) { const f32x4 v = *(const f32x4*)(P.in[3] + sidx + 4 * i); hst[4 * i] = v.x; hst[4 * i + 1] = v.y; hst[4 * i + 2] = v.z; hst[4 * i + 3] = v.w; }
#pragma unroll
        for (int t = 0; t < 8; ++t) { const float dt = dtv[hh * 8 + t], dec = __expf(dt * a), xv = xs[t * 256 + hh * 64 + p], xdt = xv * dt; float yp = 0.f;
#pragma unroll
            for (int i = 0; i < 16; ++i) { hst[i] = hst[i] * dec + xdt * Bv[t * 128 + n0 + i]; yp += Cv[t * 128 + n0 + i] * hst[i]; }
            yp += __shfl_xor(yp, 1); yp += __shfl_xor(yp, 2); yp += __shfl_xor(yp, 4);
            if ((tid & 7) == 0) yv[t * 256 + hh * 64 + p] = yp + dsk * xv; }
#pragma unroll
        for (int i = 0; i < 4; ++i) *(f32x4*)(P.out + O_SSSM + sidx + 4 * i) = (f32x4){hst[4 * i], hst[4 * i + 1], hst[4 * i + 2], hst[4 * i + 3]};
    }
    __syncthreads();
    {
        const int t = wave; float v[4]; float ss = 0.f;
#pragma unroll
        for (int i = 0; i < 4; ++i) { const int ch = lane + 64 * i; const float z = bf2f(PROJ[(size_t)(R0 + t) * NPROJ + g * 256 + ch]); v[i] = yv[t * 256 + ch] * siluf(z); ss += v[i] * v[i]; }
        const float rinv = rsqrtf(wave_sum(ss) * (1.f / 256.f) + EPSN);
#pragma unroll
        for (int i = 0; i < 4; ++i) { const int ch = g * 256 + lane + 64 * i; ((bf16_t*)(P.ws + WS_YMIX))[(size_t)(R0 + t) * 4096 + ch] = (bf16_t)f2bf(v[i] * rinv * P.in[19][ch]); }
    }
    __syncthreads();
}
DEV void phase5(const Params& P, LAS unsigned char* lds, int tid, int lane, int wave) {
    const int G = gridDim.x, bid = blockIdx.x;
    const int gt = bid * NTHREADS + tid, NGT = G * NTHREADS;
#if !defined(ONLY) || ONLY == 5
    for (int it = bid; it < 512; it += G) ssd_out_item(P, lds, it, tid, lane, wave);
#endif
#if !defined(ONLY) || ONLY == 11
    for (int it = bid; it < 256; it += G) ssd_sample_item(P, lds, it, tid, lane, wave);
#endif
}

DEV void rope_stage(const bf16_t* src, const float* ropep  , int c, float scale, LAS bf16_t* dst, float* fout, bool zero) {
    float lo[8], hi[8], o1[8], o2[8];
    if (zero) {
#pragma unroll
        for (int e = 0; e < 8; ++e) { o1[e] = 0.f; o2[e] = 0.f; }
    } else {
        ld8(src + 8 * c, lo); ld8(src + 32 + 8 * c, hi);
        float csA[8], csB[8]; ldf8(ropep + 16 * c, csA); ldf8(ropep + 16 * c + 8, csB);
#pragma unroll
        for (int e = 0; e < 8; ++e) { const float co = e < 4 ? csA[2 * e] : csB[2 * e - 8], si = e < 4 ? csA[2 * e + 1] : csB[2 * e - 7]; o1[e] = (lo[e] * co - hi[e] * si) * scale; o2[e] = (hi[e] * co + lo[e] * si) * scale; }
    }
    *(LAS u32x4*)(dst + 8 * c) = pack8(o1); *(LAS u32x4*)(dst + 32 + 8 * c) = pack8(o2);
    if (fout) {
#pragma unroll
        for (int e = 0; e < 8; ++e) { fout[8 * c + e] = o1[e]; fout[32 + 8 * c + e] = o2[e]; } }
}
DEV void attn_prompt_item(const Params& P, LAS unsigned char* lds, int it, int tid, int lane, int wave) {
    const int hp = it & 1, qb = (it >> 1) & 15, kvh = (it >> 5) & 7, b = it >> 8;
    LAS bf16_t* Ks = (LAS bf16_t*)lds;
    LAS bf16_t* VT = (LAS bf16_t*)(lds + 36864);
    LAS bf16_t* Qs = (LAS bf16_t*)(lds + 70656);
    const bf16_t* QKV = (const bf16_t*)(P.ws + WS_QKV); const float* ROPE = (const float*)(P.ws + WS_ROPE);
    const bool wr_state = (qb == 15 && hp == 0);
    for (int i = 0; i < 2; ++i) { const int q = tid + NTHREADS * i, jj = q >> 2, c = q & 3; const int pos = qb * 128 - 128 + jj; const bool zero = pos < 0;
        const int posc = zero ? 0 : pos;
        float* fo = (wr_state && jj >= 128) ? P.out + O_PK + ((size_t)(b * 128 + (jj - 128)) * 8 + kvh) * 64 : nullptr;
        rope_stage(QKV + (size_t)(b * 2048 + posc) * NQKV + 2048 + kvh * 64, ROPE + (size_t)posc * 64, c, 1.0f, Ks + jj * 72, fo, zero); }
    for (int i = 0; i < 4; ++i) { const int q = tid + NTHREADS * i, jj = q >> 3, c = q & 7; const int pos = qb * 128 - 128 + jj; float v[8];
        if (pos < 0) {
#pragma unroll
            for (int e = 0; e < 8; ++e) v[e] = 0.f;
        } else ld8(QKV + (size_t)(b * 2048 + pos) * NQKV + 2560 + kvh * 64 + 8 * c, v);
#pragma unroll
        for (int e = 0; e < 8; ++e) VT[(8 * c + e) * 264 + jj] = (bf16_t)f2bf(v[e]);
        if (wr_state && jj >= 128) { float* fo = P.out + O_PV + ((size_t)(b * 128 + (jj - 128)) * 8 + kvh) * 64 + 8 * c;
#pragma unroll
            for (int e = 0; e < 8; ++e) fo[e] = v[e]; } }
    for (int i = 0; i < 2; ++i) { const int q = tid + NTHREADS * i, qr = q >> 2, c = q & 3; const int hsel = qr >> 7, qi = qr & 127, head = kvh * 4 + hp * 2 + hsel, pos = qb * 128 + qi;
        rope_stage(QKV + (size_t)(b * 2048 + pos) * NQKV + head * 64, ROPE + (size_t)pos * 64, c, 0.125f, Qs + qr * 72, nullptr, false); }
    __syncthreads();
    const int r = lane & 31, h = lane >> 5;
    const int hsel = wave >> 2, q0 = 32 * (wave & 3), head = kvh * 4 + hp * 2 + hsel;
    f32x16 st[5];
#pragma unroll
    for (int kt = 0; kt < 5; ++kt) { st[kt] = zero16(); mma_tile(st[kt], Ks + (q0 + 32 * kt) * 72, 72, Qs + (hsel * 128 + q0) * 72, 72, 64, lane); }
    const float sink = P.in[30][head];
    float m = sink;
#pragma unroll
    for (int kt = 0; kt < 5; ++kt)
#pragma unroll
        for (int reg = 0; reg < 16; ++reg) { const int dk = 32 * kt + rowmap(reg, h); const bool valid = (dk > r) && (dk <= r + 128);
            st[kt][reg] = valid ? st[kt][reg] : -1e30f; m = fmaxf(m, st[kt][reg]); }
    m = fmaxf(m, __shfl_xor(m, 32));
    float l = 0.f;
#pragma unroll
    for (int kt = 0; kt < 5; ++kt)
#pragma unroll
        for (int reg = 0; reg < 16; ++reg) { const float p = __expf(st[kt][reg] - m); st[kt][reg] = p; l += p; }
    l += __shfl_xor(l, 32);
    l += __expf(sink - m);
    const float linv = 1.f / l;
    bf16_t* O = (bf16_t*)(P.ws + WS_ATTO) + (size_t)(b * 2048 + qb * 128 + q0 + r) * 2048 + head * 64;
#pragma unroll
    for (int dt = 0; dt < 2; ++dt) {
        f32x16 ao = zero16();
#pragma unroll
        for (int kt = 0; kt < 5; ++kt)
#pragma unroll
            for (int s = 0; s < 2; ++s) {
                u32x4 pb; pb.x = pk2(st[kt][8 * s], st[kt][8 * s + 1]); pb.y = pk2(st[kt][8 * s + 2], st[kt][8 * s + 3]); pb.z = pk2(st[kt][8 * s + 4], st[kt][8 * s + 5]); pb.w = pk2(st[kt][8 * s + 6], st[kt][8 * s + 7]);
                const LAS bf16_t* vp = VT + (32 * dt + r) * 264 + q0 + 32 * kt + 16 * s + 4 * h;
                const u32x2 v0 = *(const LAS u32x2*)vp, v1 = *(const LAS u32x2*)(vp + 8);
                u32x4 va; va.x = v0.x; va.y = v0.y; va.z = v1.x; va.w = v1.y;
                ao = __builtin_amdgcn_mfma_f32_32x32x16_bf16(__builtin_bit_cast(bf16x8, va), __builtin_bit_cast(bf16x8, pb), ao, 0, 0, 0);
            }
#pragma unroll
        for (int gq = 0; gq < 4; ++gq) { u32x2 w; w.x = pk2(ao[4 * gq] * linv, ao[4 * gq + 1] * linv); w.y = pk2(ao[4 * gq + 2] * linv, ao[4 * gq + 3] * linv);
            *(u32x2*)(O + 32 * dt + 8 * gq + 4 * h) = w; }
    }
    __syncthreads();
}
DEV void attn_sample_item(const Params& P, LAS unsigned char* lds, int it, int tid, int lane, int wave) {
    const int b = it >> 3, kvh = it & 7;
    LAS float* Kf = (LAS float*)lds;
    LAS float* Vf = Kf + 136 * 65;
    LAS float* Qf = Vf + 136 * 64;
    LAS float* Sc = Qf + 32 * 65;
    const bf16_t* QKV = (const bf16_t*)(P.ws + WS_QKV); const float* ROPE = (const float*)(P.ws + WS_ROPE);
    for (int q = tid; q < 136 * 32; q += NTHREADS) { const int jj = q >> 5, d = q & 31; float k1, k2, v1, v2;
        if (jj < 128) { const size_t o = ((size_t)(b * 128 + jj) * 8 + kvh) * 64; k1 = P.in[6][o + d]; k2 = P.in[6][o + 32 + d]; v1 = P.in[7][o + d]; v2 = P.in[7][o + 32 + d]; }
        else { const int t = jj - 128; const bf16_t* row = QKV + (size_t)(TP + b * 8 + t) * NQKV; const float a = bf2f(row[2048 + kvh * 64 + d]), c2 = bf2f(row[2048 + kvh * 64 + 32 + d]);
            const float co = ROPE[((size_t)(2048 + t) * 32 + d) * 2], si = ROPE[((size_t)(2048 + t) * 32 + d) * 2 + 1];
            k1 = a * co - c2 * si; k2 = c2 * co + a * si; v1 = bf2f(row[2560 + kvh * 64 + d]); v2 = bf2f(row[2560 + kvh * 64 + 32 + d]); }
        Kf[jj * 65 + d] = k1; Kf[jj * 65 + 32 + d] = k2; Vf[jj * 64 + d] = v1; Vf[jj * 64 + 32 + d] = v2;
        if (jj >= 8) { const size_t o = ((size_t)(b * 128 + (jj - 8)) * 8 + kvh) * 64; P.out[O_SK + o + d] = k1; P.out[O_SK + o + 32 + d] = k2; P.out[O_SV + o + d] = v1; P.out[O_SV + o + 32 + d] = v2; } }
    for (int q = tid; q < 32 * 32; q += NTHREADS) { const int qr = q >> 5, d = q & 31, hq = qr >> 3, t = qr & 7, head = kvh * 4 + hq; const bf16_t* row = QKV + (size_t)(TP + b * 8 + t) * NQKV + head * 64;
        const float a = bf2f(row[d]), c2 = bf2f(row[32 + d]); const float co = ROPE[((size_t)(2048 + t) * 32 + d) * 2], si = ROPE[((size_t)(2048 + t) * 32 + d) * 2 + 1];
        Qf[qr * 65 + d] = (a * co - c2 * si) * 0.125f; Qf[qr * 65 + 32 + d] = (c2 * co + a * si) * 0.125f; }
    __syncthreads();
    const int qr = tid >> 4, kl = tid & 15, t = qr & 7, head = kvh * 4 + (qr >> 3);
    const float sink = P.in[30][head];
    float m = sink;
    for (int i = 0; i < 9; ++i) { const int jj = kl + 16 * i; if (jj < 136) { float s = 0.f;
#pragma unroll 16
            for (int d = 0; d < 64; ++d) s += Qf[qr * 65 + d] * Kf[jj * 65 + d];
            const bool valid = jj < 128 ? (jj >= t + 1) : ((jj - 128) <= t);
            s = valid ? s : -1e30f; Sc[qr * 136 + jj] = s; m = fmaxf(m, s); } }
    m = fmaxf(m, __shfl_xor(m, 1)); m = fmaxf(m, __shfl_xor(m, 2)); m = fmaxf(m, __shfl_xor(m, 4)); m = fmaxf(m, __shfl_xor(m, 8));
    float l = 0.f;
    for (int i = 0; i < 9; ++i) { const int jj = kl + 16 * i; if (jj < 136) { const float p = __expf(Sc[qr * 136 + jj] - m); Sc[qr * 136 + jj] = p; l += p; } }
    l += __shfl_xor(l, 1); l += __shfl_xor(l, 2); l += __shfl_xor(l, 4); l += __shfl_xor(l, 8);
    l += __expf(sink - m);
    __syncthreads();
    f32x4 o = (f32x4){0.f, 0.f, 0.f, 0.f};
    for (int jj = 0; jj < 136; ++jj) { const float p = Sc[qr * 136 + jj]; const f32x4 v = *(const LAS f32x4*)(Vf + jj * 64 + 4 * kl); o = o + v * p; }
    const float linv = 1.f / l;
    u32x2 w; w.x = pk2(o.x * linv, o.y * linv); w.y = pk2(o.z * linv, o.w * linv);
    *(u32x2*)((bf16_t*)(P.ws + WS_ATTO) + (size_t)(TP + b * 8 + t) * 2048 + head * 64 + 4 * kl) = w;
    __syncthreads();
}

DEV void gemm_to_mix(const Params& P, LAS unsigned char* lds, const bf16_t* A, const bf16_t* Bt, int K) {
    const int G = gridDim.x, bid = blockIdx.x;
    { pg8::Gemm g{A + (size_t)TP * K, Bt, 256, K, K}; pg8::SplitKOrder S{8, K / 256, 256, G, bid}; pg8::EpiF32 E{(float*)(P.ws + WS_PART), DM, 256}; pg8::gemm_phase(lds, g, S, E); }
    { pg8::Gemm g{A, Bt, K, K, K}; pg8::StaticOrder S; S.init(TP, DM, G, bid); pg8::EpiBf16<3> E{(bf16_t*)(P.ws + WS_MIX), DM, nullptr, nullptr, -1}; pg8::gemm_phase(lds, g, S, E); }
}

__global__ void __launch_bounds__(NTHREADS, 2) hybrid_fwd(Params P) {
    extern __shared__ __attribute__((aligned(16))) unsigned char lds_raw[];
    LAS unsigned char* lds = (LAS unsigned char*)lds_raw;
    cg::grid_group grid = cg::this_grid();
    const int tid0 = threadIdx.x;
    const int G = gridDim.x, bid = blockIdx.x;
    unsigned char* ws = P.ws;
    if (tid0 < 16) ((LAS unsigned*)(lds + 147456))[tid0] = 0u;
    __syncthreads();
    const XcdBarrier bar = xcd_barrier_post((unsigned*)(ws + WS_BAR), (volatile LAS unsigned*)(lds + 147456));
    if (G == 0x7ffffff) grid.sync();
#define GSYNC() xcd_barrier(bar)

#define LAUNDER() int tid = tid0; asm volatile("" : "+v"(tid)); const int lane = tid & 63, wave = __builtin_amdgcn_readfirstlane(tid >> 6)
#ifndef ONLY
#define PH(k) true
#else
#define PH(k) ((k) == ONLY)
#endif
    REP(16) { for (int i_ = 0; i_ < ((DBL) == 16 ? 10 : 0); ++i_) GSYNC(); }
    if (PH(0)) REP(0) { LAUNDER(); phase0(P, lds, tid, lane, wave); }
    GSYNC();
    if (PH(1)) REP(1) { LAUNDER(); norm_phase(P, lds, true, false, 0, 0, 0,   0, 0,   0,   1, 0, lane, wave); }
    GSYNC();
    if (PH(2)) REP(2) {
        pg8::Gemm g{(const bf16_t*)(ws + WS_H), (const bf16_t*)(ws + WS_WIN), DM, DM, DM}; pg8::StaticOrder S; S.init(TT, NPROJ, G, bid);
        pg8::EpiBf16<0> E{(bf16_t*)(ws + WS_PROJ), NPROJ, nullptr, (float*)(ws + WS_DT), 40}; pg8::gemm_phase(lds, g, S, E);
        const int nbusy = (33 * 41) % G;
        if (TAILS && bid >= nbusy) { LAUNDER(); const int widx = (bid - nbusy) * 8 + wave, nw = (G - nbusy) * 8;
            if (G <= 192) transpose_range(P, lds, 5152, 7200, widx, 1, nw, lane, wave);
            transpose_range(P, lds, 9760, 13856, widx, 1, nw, lane, wave); }
    }
    GSYNC();
    if (PH(3)) REP(3) { LAUNDER(); phase3(P, lds, tid, lane, wave); }
    GSYNC();
    if (PH(4)) REP(4) { LAUNDER(); phase4(P, lds, tid, lane, wave); }
    GSYNC();
    if (PH(5) || PH(11)) REP(5) { LAUNDER(); phase5(P, lds, tid, lane, wave); }
    GSYNC();
    if (PH(6)) REP(6) gemm_to_mix(P, lds, (const bf16_t*)(ws + WS_YMIX), (const bf16_t*)(ws + WS_WOH), 4096);
    GSYNC();
    for (int layer = 0; layer < 2; ++layer) {
        if (PH(1)) { LAUNDER(); if (layer == 0) norm_phase(P, lds, false, false, 0, 1, 2, 0, 2, 3, 4, 16, lane, wave, 1.f, true); else norm_phase(P, lds, false, false, 1, 1, 2, 1, 2, 3, 4, 8, lane, wave, 1.f, false); }
        if (DBL == 30) { GSYNC(); LAUNDER(); norm_phase(P, lds, false, false, layer, 1, 2, layer, 2, 3, 4, layer == 0 ? 16 : 8, lane, wave, 0.f, false); }
        GSYNC();
        if (PH(7)) REP(7) {
            pg8::Gemm g{(const bf16_t*)(ws + WS_H), (const bf16_t*)(ws + WS_WUP) + (size_t)layer * DFF * DM, DM, DM, DM}; pg8::StaticOrder S; S.init(TT, DFF, G, bid);
            pg8::EpiBf16<1> E{(bf16_t*)(ws + WS_UP), DFF, nullptr, nullptr, -1}; pg8::gemm_phase(lds, g, S, E);
            const int nbusy = (33 * 32) % G;
            if (TAILS && bid >= nbusy) { LAUNDER(); const int widx = (bid - nbusy) * 8 + wave, nw = (G - nbusy) * 8;
                if (layer == 0) { transpose_range(P, lds, 17952, 22048, widx, 1, nw, lane, wave); transpose_range(P, lds, 7200, 9760, widx, 1, nw, lane, wave); }
                else transpose_range(P, lds, 22048, 26144, widx, 1, nw, lane, wave); }
        }
        GSYNC();
        if (PH(6)) REP(12) gemm_to_mix(P, lds, (const bf16_t*)(ws + WS_UP), (const bf16_t*)(ws + WS_WDN) + (size_t)layer * DM * DFF, DFF);
        GSYNC();
        if (layer == 0) {
            if (PH(1)) { LAUNDER(); norm_phase(P, lds, false, false, 0, 3, 5, 1, 0, 0, 1, 32, lane, wave); }
            if (DBL == 30) { GSYNC(); LAUNDER(); norm_phase(P, lds, false, false, 0, 3, 5, 1, 0, 0, 1, 32, lane, wave, 0.f); }
            GSYNC();
            if (PH(8)) REP(8) {
                pg8::Gemm g{(const bf16_t*)(ws + WS_H), (const bf16_t*)(ws + WS_WQKV), DM, DM, DM}; pg8::StaticOrder S; S.init(TT, NQKV, G, bid);
                pg8::EpiBf16<2> E{(bf16_t*)(ws + WS_QKV), NQKV, P.in[29], nullptr, -1}; pg8::gemm_phase(lds, g, S, E);
                const int nbusy = (33 * 12) % G;
                if (TAILS && bid >= nbusy) { LAUNDER(); const int widx = (bid - nbusy) * 8 + wave, nw = (G - nbusy) * 8;
                    transpose_range(P, lds, 13856, 17952, widx, 1, nw, lane, wave); }
            }
            GSYNC();
            if (PH(9)) REP(9) { LAUNDER(); for (int it = bid; it < 1024; it += G) attn_prompt_item(P, lds, it, tid, lane, wave); }
            if (PH(10)) REP(10) { LAUNDER(); for (int it = bid; it < 256; it += G) attn_sample_item(P, lds, it, tid, lane, wave); }
            GSYNC();
            if (PH(6)) REP(13) gemm_to_mix(P, lds, (const bf16_t*)(ws + WS_ATTO), (const bf16_t*)(ws + WS_WOA), DM);
            GSYNC();
        } else {
            if (PH(1)) { LAUNDER(); norm_phase(P, lds, false, true, 1, 3, 5, 0, 0, 0, 0, 32, lane, wave); }
        }
    }
}

extern "C" void kernel_launch(void* const* d_in, const int* in_sizes, int n_in, void* d_out, int out_size, void* d_ws, size_t ws_size, hipStream_t stream) {
    static int inited = 0;
    if (!inited) { (void)hipFuncSetAttribute((const void*)hybrid_fwd, hipFuncAttributeMaxDynamicSharedMemorySize, LDS_BYTES); inited = 1; }
    (void)hipMemsetAsync((char*)d_ws + WS_BAR, 0, 16384, stream);
    Params p{};
    for (int i = 0; i < 34; ++i) p.in[i] = (const float*)d_in[i];
    p.out = (float*)d_out; p.ws = (unsigned char*)d_ws;
    void* args[] = {&p};
    (void)hipLaunchCooperativeKernel((const void*)hybrid_fwd, dim3(256), dim3(NTHREADS), args, LDS_BYTES, stream);
}
```
